# Optimizing an MI355X kernel written in HIP

```python
import jax
import jax.numpy as jnp
from jax import lax
import numpy as np

D_MODEL = 1024
BATCH = 4
SEQ = 8192
DEPTH = 2

N_A_LAYERS = DEPTH // 2
N_B_LAYERS = DEPTH - N_A_LAYERS
HEAD_DIM = 64
N_HEADS = D_MODEL // HEAD_DIM
DECAY_LORA = 64
AAA_LORA = 64
GATE_LORA = 128
GN_EPS = 64e-5
LN_EPS = 1e-5
QK_EPS = 1e-6
Q_BLOCK = 128
SCORE_SCALE = HEAD_DIM ** -0.5
N_EXPERTS = 256
TOP_K = 8
N_GROUPS = 8
TOPK_GROUPS = 4
D_EXPERT = 256
ROUTE_SCALE = 2.5
EXPERT_BLOCK = 64
ALPHA = (2.0 * DEPTH) ** 0.25
BETA = (8.0 * DEPTH) ** -0.25

kernel_name = 'yoco_rwkv7_fox_moe_block'


def layer_norm(x, g, b):
    xf = x.astype(jnp.float32)
    mu = jnp.mean(xf, -1, keepdims=True)
    var = jnp.mean(jnp.square(xf - mu), -1, keepdims=True)
    return ((xf - mu) * lax.rsqrt(var + LN_EPS) * g + b).astype(x.dtype)


def rms_norm(x, g):
    xf = x.astype(jnp.float32)
    return (xf * lax.rsqrt(jnp.mean(xf * xf, -1, keepdims=True) + QK_EPS) * g).astype(x.dtype)


def swiglu(x, w_gate, w_up, w_down):
    return (jax.nn.silu(x @ w_gate) * (x @ w_up)) @ w_down


def rwkv7_recurrence(r, decay, k, v, a, b):
    bsz, _, h, n = r.shape
    def step(S, inp):
        r_t, w_t, k_t, v_t, a_t, b_t = inp
        sa = jnp.einsum('bhvk,bhk->bhv', S, a_t)
        S = S * w_t[:, :, None, :] + sa[..., None] * b_t[:, :, None, :] + v_t[..., None] * k_t[:, :, None, :]
        return S, jnp.einsum('bhvk,bhk->bhv', S, r_t)
    S0 = jnp.zeros((bsz, h, n, n), jnp.float32)
    xs = tuple(jnp.moveaxis(t.astype(jnp.float32), 1, 0) for t in (r, decay, k, v, a, b))
    _, y = lax.scan(step, S0, xs)
    return jnp.moveaxis(y, 0, 1)


def rwkv7_time_mix(h, mu, w_rkv, w_o, w0, w1, w2, a0, a1, a2, g1, g2, k_k, k_a, r_k, lnx_g, lnx_b):
    bsz, t, d = h.shape
    heads = lambda z: z.reshape(bsz, t, N_HEADS, HEAD_DIM)
    xx = jnp.pad(h, ((0, 0), (1, 0), (0, 0)))[:, :-1] - h
    xr, xw, xk, xv, xa, xg = (h + xx * mu[i] for i in range(6))
    r = xr @ w_rkv[0]
    k = xk @ w_rkv[1]
    v = xv @ w_rkv[2]
    w = -jax.nn.softplus(-(w0 + jnp.tanh(xw @ w1) @ w2)) - 0.5
    a = jax.nn.sigmoid(a0 + (xa @ a1) @ a2)
    g = jax.nn.sigmoid(xg @ g1) @ g2
    kk = heads(k * k_k).astype(jnp.float32)
    kk = kk * lax.rsqrt(jnp.maximum(jnp.sum(kk * kk, -1, keepdims=True), 1e-24))
    k = k * (1 + (a - 1) * k_a)
    decay = jnp.exp(-jnp.exp(w.astype(jnp.float32)))
    y = rwkv7_recurrence(heads(r), heads(decay), heads(k), heads(v), -kk, kk * heads(a).astype(jnp.float32))
    mean = jnp.mean(y, -1, keepdims=True)
    var = jnp.mean(jnp.square(y - mean), -1, keepdims=True)
    y = ((y - mean) * lax.rsqrt(var + GN_EPS)).reshape(bsz, t, d) * lnx_g + lnx_b
    bonus = jnp.sum(heads(r) * heads(k) * r_k, -1, keepdims=True) * heads(v)
    y = (y.astype(h.dtype) + bonus.reshape(bsz, t, d)) * g
    return y @ w_o


def shared_kv(x_kv, kv_w, f_b, k_norm_g):
    bsz, t, d = x_kv.shape
    proj = x_kv @ kv_w
    k = rms_norm(proj[..., :d].reshape(bsz, t, N_HEADS, HEAD_DIM), k_norm_g)
    v = proj[..., d:2 * d].reshape(bsz, t, N_HEADS, HEAD_DIM)
    log_f = jax.nn.log_sigmoid((proj[..., 2 * d:] + f_b).astype(jnp.float32))
    F = jnp.cumsum(log_f, axis=1)
    return k, v, F


def fox_attention(h, w_qg, q_norm_g, w_o, k, v, F):
    bsz, t, d = h.shape
    nb = t // Q_BLOCK
    qg = h @ w_qg
    q = rms_norm(qg[..., :d].reshape(bsz, t, N_HEADS, HEAD_DIM), q_norm_g)
    gate = jax.nn.sigmoid(qg[..., d:])
    q_blocks = q.reshape(bsz, nb, Q_BLOCK, N_HEADS, HEAD_DIM).transpose(1, 0, 3, 2, 4).astype(jnp.float32)
    F_blocks = F.reshape(bsz, nb, Q_BLOCK, N_HEADS).transpose(1, 0, 3, 2)
    kf = k.transpose(0, 2, 1, 3).astype(jnp.float32)
    vf = v.transpose(0, 2, 1, 3).astype(jnp.float32)
    Fk = F.transpose(0, 2, 1)
    kpos = jnp.arange(t)
    def block(args):
        i, q_i, F_i = args
        s = jnp.einsum('bhqd,bhkd->bhqk', q_i, kf) * SCORE_SCALE + (F_i[..., None] - Fk[:, :, None, :])
        qpos = i * Q_BLOCK + jnp.arange(Q_BLOCK)
        s = jnp.where(kpos[None, :] <= qpos[:, None], s, -jnp.inf)
        p = jax.nn.softmax(s, axis=-1)
        return jnp.einsum('bhqk,bhkd->bhqd', p, vf)
    o = lax.map(block, (jnp.arange(nb), q_blocks, F_blocks))
    o = o.transpose(1, 0, 3, 2, 4).reshape(bsz, t, d).astype(h.dtype)
    return (o * gate) @ w_o


def routed_experts(h, router, router_bias, w_gate, w_up, w_down):
    t, d = h.shape
    n = t * TOP_K
    scores = jax.nn.sigmoid((h @ router).astype(jnp.float32))
    choice = scores + router_bias.astype(jnp.float32)
    grp = choice.reshape(t, N_GROUPS, N_EXPERTS // N_GROUPS)
    grp_score = jnp.sum(lax.top_k(grp, 2)[0], -1)
    _, top_grp = lax.top_k(grp_score, TOPK_GROUPS)
    grp_mask = jnp.sum(jax.nn.one_hot(top_grp, N_GROUPS, dtype=jnp.float32), 1) > 0
    expert_mask = jnp.repeat(grp_mask, N_EXPERTS // N_GROUPS, axis=1)
    _, idx = lax.top_k(jnp.where(expert_mask, choice, -jnp.inf), TOP_K)
    gw = jnp.take_along_axis(scores, idx, axis=1)
    gw = gw / jnp.sum(gw, -1, keepdims=True) * ROUTE_SCALE
    flat_e = idx.reshape(n)
    order = jnp.argsort(flat_e)
    e_sorted = flat_e[order]
    tok = order // TOP_K
    counts = jnp.bincount(flat_e, length=N_EXPERTS)
    padded = (counts + EXPERT_BLOCK - 1) // EXPERT_BLOCK * EXPERT_BLOCK
    pad_end = jnp.cumsum(padded)
    pad_start = pad_end - padded
    start = jnp.cumsum(counts) - counts
    dest = pad_start[e_sorted] + jnp.arange(n) - start[e_sorted]
    n_blocks = (n + N_EXPERTS * (EXPERT_BLOCK - 1) + EXPERT_BLOCK - 1) // EXPERT_BLOCK
    buf = jnp.zeros((n_blocks * EXPERT_BLOCK, d), h.dtype).at[dest].set(h[tok])
    block_expert = jnp.minimum(jnp.searchsorted(pad_end, jnp.arange(n_blocks) * EXPERT_BLOCK, side='right'), N_EXPERTS - 1)
    def expert_block(args):
        xb, e = args
        return swiglu(xb, w_gate[e], w_up[e], w_down[e])
    out = lax.map(expert_block, (buf.reshape(n_blocks, EXPERT_BLOCK, d), block_expert))
    out = out.reshape(n_blocks * EXPERT_BLOCK, d)[dest]
    weights = gw.reshape(n)[order].astype(h.dtype)
    return jnp.zeros((t, d), h.dtype).at[tok].add(out * weights[:, None])


def moe_ffn(h, router, router_bias, w_gate, w_up, w_down, s_gate, s_up, s_down):
    routed = lax.map(lambda hb: routed_experts(hb, router, router_bias, w_gate, w_up, w_down), h)
    return routed + swiglu(h, s_gate, s_up, s_down)


def setup_inputs(seed: int = 0) -> dict:
    key = jax.random.key(seed)
    ks = iter(jax.random.split(key, 40))
    nrm = lambda shape, scale: jax.random.normal(next(ks), shape, jnp.float32) * scale
    D, H, N, E, F = D_MODEL, N_HEADS, HEAD_DIM, N_EXPERTS, D_EXPERT
    A, Bn, L = N_A_LAYERS, N_B_LAYERS, DEPTH
    s = D ** -0.5
    return {
        'x': nrm((BATCH, SEQ, D), 1.0),
        'c': nrm((BATCH, D), 1.0),
        'ada_w': nrm((L, D, 6 * D), 0.1 * s),
        'ada_b': nrm((L, 6 * D), 0.02),
        'ln_g': 1.0 + nrm((L, 2, D), 0.02),
        'ln_b': nrm((L, 2, D), 0.02),
        'rwkv_mu': jax.random.uniform(next(ks), (A, 6, D), jnp.float32),
        'rwkv_w_rkv': nrm((A, 3, D, D), s),
        'rwkv_w_o': nrm((A, D, D), s * BETA),
        'rwkv_w0': nrm((A, D), 0.5),
        'rwkv_w1': nrm((A, D, DECAY_LORA), s),
        'rwkv_w2': nrm((A, DECAY_LORA, D), 0.1 * DECAY_LORA ** -0.5),
        'rwkv_a0': nrm((A, D), 0.1),
        'rwkv_a1': nrm((A, D, AAA_LORA), s),
        'rwkv_a2': nrm((A, AAA_LORA, D), 0.1 * AAA_LORA ** -0.5),
        'rwkv_g1': nrm((A, D, GATE_LORA), s),
        'rwkv_g2': nrm((A, GATE_LORA, D), GATE_LORA ** -0.5),
        'rwkv_k_k': 0.85 + nrm((A, D), 0.02),
        'rwkv_k_a': 1.0 + nrm((A, D), 0.02),
        'rwkv_r_k': nrm((A, H, N), 0.1),
        'rwkv_lnx_g': 1.0 + nrm((A, D), 0.02),
        'rwkv_lnx_b': nrm((A, D), 0.02),
        'kv_w': nrm((D, 2 * D + H), s),
        'f_b': 2.0 + nrm((H,), 0.1),
        'k_norm_g': 1.0 + nrm((N,), 0.02),
        'fox_w_qg': nrm((Bn, D, 2 * D), s),
        'fox_q_norm_g': 1.0 + nrm((Bn, N), 0.02),
        'fox_w_o': nrm((Bn, D, D), s * BETA),
        'moe_router': nrm((L, D, E), s),
        'moe_router_bias': nrm((L, E), 0.01),
        'moe_w_gate': nrm((L, E, D, F), s),
        'moe_w_up': nrm((L, E, D, F), s),
        'moe_w_down': nrm((L, E, F, D), F ** -0.5 * BETA),
        'shared_w_gate': nrm((L, D, F), s),
        'shared_w_up': nrm((L, D, F), s),
        'shared_w_down': nrm((L, F, D), F ** -0.5 * BETA),
    }


def reference(x, c, ada_w, ada_b, ln_g, ln_b, rwkv_mu, rwkv_w_rkv, rwkv_w_o, rwkv_w0, rwkv_w1, rwkv_w2,
              rwkv_a0, rwkv_a1, rwkv_a2, rwkv_g1, rwkv_g2, rwkv_k_k, rwkv_k_a, rwkv_r_k, rwkv_lnx_g, rwkv_lnx_b,
              kv_w, f_b, k_norm_g, fox_w_qg, fox_q_norm_g, fox_w_o, moe_router, moe_router_bias,
              moe_w_gate, moe_w_up, moe_w_down, shared_w_gate, shared_w_up, shared_w_down):
    mod = jnp.einsum('bd,lde->lbe', jax.nn.silu(c), ada_w) + ada_b[:, None, :]
    k_sh = v_sh = F_sh = None
    for l in range(DEPTH):
        shift_t, scale_t, gate_t, shift_c, scale_c, gate_c = (m[:, None, :] for m in jnp.split(mod[l], 6, axis=-1))
        h = x * (1 + scale_t) + shift_t
        if l < N_A_LAYERS:
            y = rwkv7_time_mix(h, rwkv_mu[l], rwkv_w_rkv[l], rwkv_w_o[l], rwkv_w0[l], rwkv_w1[l], rwkv_w2[l],
                               rwkv_a0[l], rwkv_a1[l], rwkv_a2[l], rwkv_g1[l], rwkv_g2[l], rwkv_k_k[l],
                               rwkv_k_a[l], rwkv_r_k[l], rwkv_lnx_g[l], rwkv_lnx_b[l])
        else:
            j = l - N_A_LAYERS
            if j == 0:
                k_sh, v_sh, F_sh = shared_kv(x, kv_w, f_b, k_norm_g)
            y = fox_attention(h, fox_w_qg[j], fox_q_norm_g[j], fox_w_o[j], k_sh, v_sh, F_sh)
        x = layer_norm(ALPHA * x + (1 + gate_t) * y, ln_g[l, 0], ln_b[l, 0])
        h = x * (1 + scale_c) + shift_c
        y = moe_ffn(h, moe_router[l], moe_router_bias[l], moe_w_gate[l], moe_w_up[l], moe_w_down[l],
                    shared_w_gate[l], shared_w_up[l], shared_w_down[l])
        x = layer_norm(ALPHA * x + (1 + gate_c) * y, ln_g[l, 1], ln_b[l, 1])
    return x
```

```cpp
#include <hip/hip_runtime.h>
#include <cstdio>
#include <cstdint>
#include <cstring>
#include <cmath>
namespace nv {
constexpr int D = 1024, NB = 4, T = 8192, H = 16, HD = 64, NE = 256, FX = 256;
constexpr float ALPHA = 1.4142135623730951f;
constexpr size_t MiB = 1u << 20;

__device__ __forceinline__ float sigmoidf_(float x) { return 1.f / (1.f + __expf(-x)); }
__device__ __forceinline__ float softplusf_(float x) { return x > 20.f ? x : log1pf(__expf(x)); }
__device__ __forceinline__ float siluf_(float x) { return x / (1.f + __expf(-x)); }
__device__ __forceinline__ float wsum(float v) {
#pragma unroll
    for (int o = 1; o < 64; o <<= 1) v += __shfl_xor(v, o);
    return v;
}

struct NG {
    int M, N, K;
    int amode; const float* A; int lda; const float* ash; const float* asc; const float* amu; const int* list; const int* cnt;
    int bmode; const float* B0; const float* B1; int ldb; int bsplit; size_t bstride;
    int emode; float* C; float* C2; float* C3; int ldc; const float* ev0; const float* eres; const float* egate; const float* egw;
};

__device__ __forceinline__ float4 ng_a4(const NG& p, int e, int m, int k) {
    float4 z = make_float4(0.f, 0.f, 0.f, 0.f);
    if (m >= p.M && p.amode < 3) return z;
    switch (p.amode) {
    case 0: return *(const float4*)(p.A + (size_t)m * p.lda + k);
    case 1: { float4 x = *(const float4*)(p.A + (size_t)m * p.lda + k); float4 sh = *(const float4*)(p.ash + k), sc = *(const float4*)(p.asc + k);
        return make_float4(x.x * (1.f + sc.x) + sh.x, x.y * (1.f + sc.y) + sh.y, x.z * (1.f + sc.z) + sh.z, x.w * (1.f + sc.w) + sh.w); }
    case 2: { float4 x = *(const float4*)(p.A + (size_t)m * p.lda + k); float4 sh = *(const float4*)(p.ash + k), sc = *(const float4*)(p.asc + k), mu = *(const float4*)(p.amu + k);
        float4 h = make_float4(x.x * (1.f + sc.x) + sh.x, x.y * (1.f + sc.y) + sh.y, x.z * (1.f + sc.z) + sh.z, x.w * (1.f + sc.w) + sh.w);
        float4 hp = z;
        if (m > 0) { float4 xp = *(const float4*)(p.A + (size_t)(m - 1) * p.lda + k); hp = make_float4(xp.x * (1.f + sc.x) + sh.x, xp.y * (1.f + sc.y) + sh.y, xp.z * (1.f + sc.z) + sh.z, xp.w * (1.f + sc.w) + sh.w); }
        return make_float4(h.x + (hp.x - h.x) * mu.x, h.y + (hp.y - h.y) * mu.y, h.z + (hp.z - h.z) * mu.z, h.w + (hp.w - h.w) * mu.w); }
    case 3: { const int c = p.cnt[e]; if (m >= c) return z; const int row = p.list[(size_t)e * T + m] >> 3;
        float4 x = *(const float4*)(p.A + (size_t)row * p.lda + k); float4 sh = *(const float4*)(p.ash + k), sc = *(const float4*)(p.asc + k);
        return make_float4(x.x * (1.f + sc.x) + sh.x, x.y * (1.f + sc.y) + sh.y, x.z * (1.f + sc.z) + sh.z, x.w * (1.f + sc.w) + sh.w); }
    case 4: { const int c = p.cnt[e]; if (m >= c) return z; const int tk = p.list[(size_t)e * T + m];
        float4 g = *(const float4*)(p.A + (size_t)tk * p.lda + k), u = *(const float4*)(p.A + (size_t)tk * p.lda + FX + k);
        return make_float4(siluf_(g.x) * u.x, siluf_(g.y) * u.y, siluf_(g.z) * u.z, siluf_(g.w) * u.w); }
    default: { if (m >= p.M) return z; float4 g = *(const float4*)(p.A + (size_t)m * p.lda + k), u = *(const float4*)(p.A + (size_t)m * p.lda + FX + k);
        return make_float4(siluf_(g.x) * u.x, siluf_(g.y) * u.y, siluf_(g.z) * u.z, siluf_(g.w) * u.w); }
    }
}
__device__ __forceinline__ float4 ng_b4(const NG& p, int e, int k, int n) {
    if (n >= p.N) return make_float4(0.f, 0.f, 0.f, 0.f);
    if (p.bmode == 0) return *(const float4*)(p.B0 + (size_t)e * p.bstride + (size_t)k * p.ldb + n);
    if (n < p.bsplit) return *(const float4*)(p.B0 + (size_t)e * p.bstride + (size_t)k * p.ldb + n);
    return *(const float4*)(p.B1 + (size_t)e * p.bstride + (size_t)k * p.ldb + (n - p.bsplit));
}
__device__ __forceinline__ void ng_store(const NG& p, int e, int m, int n, float acc) {
    if (n >= p.N) return;
    switch (p.emode) {
    case 0: if (m < p.M) p.C[(size_t)m * p.ldc + n] = acc; break;
    case 1: if (m < p.M) p.C[(size_t)m * p.ldc + n] = tanhf(acc); break;
    case 2: if (m < p.M) p.C[(size_t)m * p.ldc + n] = sigmoidf_(acc); break;
    case 3: if (m < p.M) { const float w = -softplusf_(-(p.ev0[n] + acc)) - 0.5f; p.C[(size_t)m * p.ldc + n] = -__expf(w); } break;
    case 4: if (m < p.M) p.C[(size_t)m * p.ldc + n] = sigmoidf_(p.ev0[n] + acc); break;
    case 5: if (m < p.M) p.C[(size_t)m * p.ldc + n] = ALPHA * p.eres[(size_t)m * p.ldc + n] + (1.f + p.egate[n]) * acc; break;
    case 6: { const int c = p.cnt[e]; if (m < c) { const int tk = p.list[(size_t)e * T + m]; atomicAdd(&p.C[(size_t)(tk >> 3) * p.ldc + n], p.egw[tk] * acc); } } break;
    case 7: if (m < p.M) p.C[(size_t)m * p.ldc + n] += acc; break;
    case 8: if (m < p.M) { if (n < 1024) p.C[(size_t)m * 1024 + n] = acc; else if (n < 2048) p.C2[(size_t)m * 1024 + n - 1024] = acc; else p.C3[(size_t)m * 16 + n - 2048] = -softplusf_(-(acc + p.ev0[n - 2048])); } break;
    case 9: if (m < p.M) { if (n < 1024) p.C[(size_t)m * 1024 + n] = acc; else p.C2[(size_t)m * 1024 + n - 1024] = sigmoidf_(acc); } break;
    default: { const int c = p.cnt[e]; if (m < c) { const int tk = p.list[(size_t)e * T + m]; p.C[(size_t)tk * p.ldc + n] = acc; } } break;
    }
}

__global__ void __launch_bounds__(256) k_gemm(NG p) {
    __shared__ float As[16][68];
    __shared__ float Bs[16][68];
    const int e = blockIdx.z, m0 = blockIdx.y * 64, n0 = blockIdx.x * 64;
    if (p.cnt && (p.amode == 3 || p.amode == 4)) { if (m0 >= p.cnt[e]) return; }
    const int tid = threadIdx.x, tx = tid & 15, ty = tid >> 4;
    float acc[4][4];
#pragma unroll
    for (int i = 0; i < 4; ++i)
#pragma unroll
        for (int j = 0; j < 4; ++j) acc[i][j] = 0.f;
    const int ar = tid >> 2, ak = (tid & 3) * 4, bk = tid >> 4, bn = (tid & 15) * 4;
    for (int k0 = 0; k0 < p.K; k0 += 16) {
        const float4 a = ng_a4(p, e, m0 + ar, k0 + ak);
        const float4 b = ng_b4(p, e, k0 + bk, n0 + bn);
        __syncthreads();
        As[ak + 0][ar] = a.x; As[ak + 1][ar] = a.y; As[ak + 2][ar] = a.z; As[ak + 3][ar] = a.w;
        *(float4*)&Bs[bk][bn] = b;
        __syncthreads();
#pragma unroll
        for (int kk = 0; kk < 16; ++kk) {
            const float4 av = *(const float4*)&As[kk][ty * 4];
            const float4 bv = *(const float4*)&Bs[kk][tx * 4];
            const float aa[4] = {av.x, av.y, av.z, av.w}; const float bb[4] = {bv.x, bv.y, bv.z, bv.w};
#pragma unroll
            for (int i = 0; i < 4; ++i)
#pragma unroll
                for (int j = 0; j < 4; ++j) acc[i][j] += aa[i] * bb[j];
        }
    }
#pragma unroll
    for (int i = 0; i < 4; ++i)
#pragma unroll
        for (int j = 0; j < 4; ++j) ng_store(p, e, m0 + ty * 4 + i, n0 + tx * 4 + j, acc[i][j]);
}

__global__ void k_mod(const float* c, const float* ada_w, const float* ada_b, float* mod) {
    const int i = blockIdx.x * blockDim.x + threadIdx.x; if (i >= 2 * NB * 6 * D) return;
    const int n = i % (6 * D), b = (i / (6 * D)) % NB, l = i / (6 * D * NB);
    float s = 0.f;
    for (int k = 0; k < D; ++k) s += siluf_(c[b * D + k]) * ada_w[((size_t)l * D + k) * 6 * D + n];
    mod[i] = s + ada_b[l * 6 * D + n];
}
__global__ void k_prep0(const float* K, const float* A, const float* k_k, const float* k_a, float* KK, float* KP) {
    const int w = (blockIdx.x * blockDim.x + threadIdx.x) >> 6, lane = threadIdx.x & 63; if (w >= T * H) return;
    const int t = w / H, h = w % H; const size_t o = (size_t)t * D + h * HD + lane; const int c = h * HD + lane;
    const float k = K[o], a = A[o]; float kk = k * k_k[c]; const float ss = wsum(kk * kk);
    kk *= rsqrtf(fmaxf(ss, 1e-24f)); KK[o] = kk; KP[o] = k * (1.f + (a - 1.f) * k_a[c]);
}
__global__ void __launch_bounds__(64) k_scan(const float* R, const float* LW, const float* KP, const float* V, const float* KK, const float* A, float* Y) {
    __shared__ float sh[2][5][64];
    const int h = blockIdx.x, lane = threadIdx.x; const size_t col = h * HD + lane;
    float S[64];
#pragma unroll
    for (int d = 0; d < 64; ++d) S[d] = 0.f;
    float nr = R[col], nw = __expf(LW[col]), nk = KP[col], nkk = KK[col], na = A[col], nv = V[col];
    for (int t = 0; t < T; ++t) {
        const int bsel = t & 1;
        sh[bsel][0][lane] = nr; sh[bsel][1][lane] = nw; sh[bsel][2][lane] = nk; sh[bsel][3][lane] = nkk; sh[bsel][4][lane] = nkk * na;
        const float vme = nv;
        if (t + 1 < T) { const size_t o = (size_t)(t + 1) * D + col; nr = R[o]; nw = __expf(LW[o]); nk = KP[o]; nkk = KK[o]; na = A[o]; nv = V[o]; }
        __syncthreads();
        float sa = 0.f;
#pragma unroll
        for (int d = 0; d < 64; ++d) sa -= S[d] * sh[bsel][3][d];
        float y = 0.f;
#pragma unroll
        for (int d = 0; d < 64; ++d) { S[d] = S[d] * sh[bsel][1][d] + sa * sh[bsel][4][d] + vme * sh[bsel][2][d]; y += S[d] * sh[bsel][0][d]; }
        Y[(size_t)t * D + col] = y;
    }
}
__global__ void k_post0(const float* Y, const float* R, const float* KP, const float* V, const float* G, const float* r_k, const float* lnx_g, const float* lnx_b, float* Z) {
    const int w = (blockIdx.x * blockDim.x + threadIdx.x) >> 6, lane = threadIdx.x & 63; if (w >= T * H) return;
    const int t = w / H, h = w % H; const size_t o = (size_t)t * D + h * HD + lane; const int c = h * HD + lane;
    const float y = Y[o]; const float mean = wsum(y) * (1.f / 64.f); const float dv = y - mean; const float var = wsum(dv * dv) * (1.f / 64.f);
    const float gn = dv * rsqrtf(var + 64e-5f) * lnx_g[c] + lnx_b[c];
    const float bonus = wsum(R[o] * KP[o] * r_k[c]) * V[o];
    Z[o] = (gn + bonus) * G[o];
}
__global__ void __launch_bounds__(256) k_ln(const float* in, const float* X1, const float* gate, const float* g, const float* b, float* out, int mode) {
    __shared__ float red[8];
    const int row = blockIdx.x, tid = threadIdx.x;
    float v[4]; float s = 0.f;
#pragma unroll
    for (int j = 0; j < 4; ++j) { const int c = tid + 256 * j; float x = in[(size_t)row * D + c]; if (mode) x = ALPHA * X1[(size_t)row * D + c] + (1.f + gate[c]) * x; v[j] = x; s += x; }
    s = wsum(s); if ((tid & 63) == 0) red[tid >> 6] = s; __syncthreads();
    const float mean = (red[0] + red[1] + red[2] + red[3]) * (1.f / D); float q = 0.f;
#pragma unroll
    for (int j = 0; j < 4; ++j) { v[j] -= mean; q += v[j] * v[j]; }
    q = wsum(q); if ((tid & 63) == 0) red[4 + (tid >> 6)] = q; __syncthreads();
    const float rstd = rsqrtf((red[4] + red[5] + red[6] + red[7]) * (1.f / D) + 1e-5f);
#pragma unroll
    for (int j = 0; j < 4; ++j) { const int c = tid + 256 * j; out[(size_t)row * D + c] = v[j] * rstd * g[c] + b[c]; }
}
__global__ void k_route(const float* logits, const float* rbias, int* idx, float* gw, int* cnt, int* list) {
    const int t = blockIdx.x * blockDim.x + threadIdx.x; if (t >= T) return;
    const float* lg = logits + (size_t)t * NE;
    float gs[8];
#pragma unroll
    for (int g = 0; g < 8; ++g) { float m1 = -INFINITY, m2 = -INFINITY;
        for (int j = 0; j < 32; ++j) { const float c = sigmoidf_(lg[g * 32 + j]) + rbias[g * 32 + j]; if (c > m1) { m2 = m1; m1 = c; } else if (c > m2) m2 = c; }
        gs[g] = m1 + m2; }
    unsigned gmask = 0;
#pragma unroll
    for (int g = 0; g < 8; ++g) { int rank = 0;
#pragma unroll
        for (int g2 = 0; g2 < 8; ++g2) rank += (gs[g2] > gs[g] || (gs[g2] == gs[g] && g2 < g)) ? 1 : 0;
        if (rank < 4) gmask |= 1u << g; }
    int ch[8]; float sc[8]; float ssum = 0.f;
#pragma unroll
    for (int k = 0; k < 8; ++k) { float best = -INFINITY; int bi = -1; float bs = 0.f;
        for (int e = 0; e < NE; ++e) { if (!((gmask >> (e >> 5)) & 1u)) continue; bool used = false;
#pragma unroll
            for (int k2 = 0; k2 < 8; ++k2) if (k2 < k && ch[k2] == e) used = true;
            if (used) continue; const float s = sigmoidf_(lg[e]); const float c = s + rbias[e]; if (c > best) { best = c; bi = e; bs = s; } }
        ch[k] = bi; sc[k] = bs; ssum += bs; }
#pragma unroll
    for (int k = 0; k < 8; ++k) { idx[t * 8 + k] = ch[k]; gw[t * 8 + k] = sc[k] / ssum * 2.5f; const int pos = atomicAdd(&cnt[ch[k]], 1); list[(size_t)ch[k] * T + pos] = t * 8 + k; }
}
__global__ void k_rms(const float* X, const float* g, float* O) {
    const int w = (blockIdx.x * blockDim.x + threadIdx.x) >> 6, lane = threadIdx.x & 63; if (w >= T * H) return;
    const size_t o = (size_t)(w / H) * D + (w % H) * HD + lane; const float x = X[o]; const float ss = wsum(x * x) * (1.f / 64.f);
    O[o] = x * rsqrtf(ss + 1e-6f) * g[lane];
}
__global__ void __launch_bounds__(64) k_fcum(const float* logf, float* F) {
    const int h = blockIdx.x, lane = threadIdx.x; float s = 0.f;
    for (int i = 0; i < 128; ++i) s += logf[(size_t)(lane * 128 + i) * 16 + h];
    float inc = s;
#pragma unroll
    for (int o = 1; o < 64; o <<= 1) { const float u = __shfl_up(inc, o); if (lane >= o) inc += u; }
    float run = inc - s;
    for (int i = 0; i < 128; ++i) { run += logf[(size_t)(lane * 128 + i) * 16 + h]; F[(size_t)h * T + lane * 128 + i] = run; }
}
__global__ void __launch_bounds__(64) k_attn(const float* QN, const float* KN, const float* V, const float* F, const float* GATE, float* OG) {
    const int h = blockIdx.y, i = blockIdx.x * 64 + threadIdx.x;
    float q[64], o[64];
#pragma unroll
    for (int d = 0; d < 64; ++d) { q[d] = QN[(size_t)i * D + h * HD + d] * 0.125f; o[d] = 0.f; }
    const float Fi = F[(size_t)h * T + i]; float m = -INFINITY, l = 0.f;
    const int jmax = blockIdx.x * 64 + 63;
    for (int j = 0; j <= jmax; ++j) {
        const float* kr = KN + (size_t)j * D + h * HD; const float* vr = V + (size_t)j * D + h * HD;
        float s = 0.f;
#pragma unroll
        for (int d = 0; d < 64; ++d) s += q[d] * kr[d];
        s += Fi - F[(size_t)h * T + j];
        if (j <= i) { const float mn = fmaxf(m, s); const float corr = __expf(m - mn), p = __expf(s - mn); l = l * corr + p;
#pragma unroll
            for (int d = 0; d < 64; ++d) o[d] = o[d] * corr + p * vr[d];
            m = mn; }
    }
    const float il = 1.f / l;
#pragma unroll
    for (int d = 0; d < 64; ++d) OG[(size_t)i * D + h * HD + d] = o[d] * il * GATE[(size_t)i * D + h * HD + d];
}

struct In { const float* p[36]; };
constexpr size_t W_MOD = 0, W_CNT = 1 * MiB, W_IDX = 2 * MiB, W_GW = 3 * MiB, W_LOGF = 4 * MiB, W_F = 5 * MiB, W_T1 = 6 * MiB  , W_T2 = 8 * MiB, W_T3 = 10 * MiB  ,
    W_LOGITS = 14 * MiB  , W_LIST = 22 * MiB  , W_SGU = 30 * MiB  , W_GU = 46 * MiB  , W_BUF = 174 * MiB;
constexpr size_t TD = (size_t)T * D * 4;
enum { B_R, B_K, B_V, B_LW, B_A, B_G, B_KP, B_KK, B_Y, B_Z, B_PRE, B_X1, B_YM, B_X2, B_KN, B_QN, B_GATE, B_OG, B_KRAW, B_QRAW, B_NBUF };
constexpr size_t W_END = W_BUF + (size_t)B_NBUF * TD;

static NG ng0() { NG p; memset(&p, 0, sizeof(p)); return p; }
static void gemm(hipStream_t s, const NG& p, int mt, int ez) { dim3 g((p.N + 63) / 64, mt, ez); hipLaunchKernelGGL(k_gemm, g, dim3(256), 0, s, p); }

static void moe(hipStream_t s, const In& in, char* ws, int l, const float* modb, const float* X1, float* out) {
    float* LOGITS = (float*)(ws + W_LOGITS); int* CNT = (int*)(ws + W_CNT); int* IDX = (int*)(ws + W_IDX); float* GW = (float*)(ws + W_GW); int* LIST = (int*)(ws + W_LIST);
    float* GU = (float*)(ws + W_GU); float* SGU = (float*)(ws + W_SGU); float* YM = (float*)(ws + W_BUF + B_YM * TD);
    const float* sh = modb + 3 * D; const float* sc = modb + 4 * D; const float* gt = modb + 5 * D;
    { NG p = ng0(); p.M = T; p.N = NE; p.K = D; p.amode = 1; p.A = X1; p.lda = D; p.ash = sh; p.asc = sc; p.bmode = 0; p.B0 = in.p[28] + (size_t)l * D * NE; p.ldb = NE; p.emode = 0; p.C = LOGITS; p.ldc = NE; gemm(s, p, T / 64, 1); }
    hipMemsetAsync(CNT, 0, NE * 4, s);
    hipLaunchKernelGGL(k_route, dim3(T / 64), dim3(64), 0, s, LOGITS, in.p[29] + l * NE, IDX, GW, CNT, LIST);
    hipMemsetAsync(YM, 0, TD, s);
    { NG p = ng0(); p.M = T; p.N = 2 * FX; p.K = D; p.amode = 3; p.A = X1; p.lda = D; p.ash = sh; p.asc = sc; p.list = LIST; p.cnt = CNT; p.bmode = 1; p.B0 = in.p[30] + (size_t)l * NE * D * FX; p.B1 = in.p[31] + (size_t)l * NE * D * FX; p.ldb = FX; p.bsplit = FX; p.bstride = (size_t)D * FX;
      p.emode = 10; p.C = GU; p.ldc = 2 * FX; gemm(s, p, T / 64, NE); }
    { NG p = ng0(); p.M = T; p.N = D; p.K = FX; p.amode = 4; p.A = GU; p.lda = 2 * FX; p.list = LIST; p.cnt = CNT; p.bmode = 0; p.B0 = in.p[32] + (size_t)l * NE * FX * D; p.ldb = D; p.bstride = (size_t)FX * D;
      p.emode = 6; p.C = YM; p.ldc = D; p.egw = GW; gemm(s, p, T / 64, NE); }
    { NG p = ng0(); p.M = T; p.N = 2 * FX; p.K = D; p.amode = 1; p.A = X1; p.lda = D; p.ash = sh; p.asc = sc; p.bmode = 1; p.B0 = in.p[33] + (size_t)l * D * FX; p.B1 = in.p[34] + (size_t)l * D * FX; p.ldb = FX; p.bsplit = FX;
      p.emode = 0; p.C = SGU; p.ldc = 2 * FX; gemm(s, p, T / 64, 1); }
    { NG p = ng0(); p.M = T; p.N = D; p.K = FX; p.amode = 5; p.A = SGU; p.lda = 2 * FX; p.bmode = 0; p.B0 = in.p[35] + (size_t)l * FX * D; p.ldb = D; p.emode = 7; p.C = YM; p.ldc = D; gemm(s, p, T / 64, 1); }
    hipLaunchKernelGGL(k_ln, dim3(T), dim3(256), 0, s, YM, X1, gt, in.p[4] + (l * 2 + 1) * D, in.p[5] + (l * 2 + 1) * D, out, 1);
}

static void forward_batch(hipStream_t s, const In& in, char* ws, int b, float* out) {
    float* MOD = (float*)(ws + W_MOD);
    auto buf = [&](int i) { return (float*)(ws + W_BUF + (size_t)i * TD); };
    const float* x0 = in.p[0] + (size_t)b * T * D;
    { const float* m = MOD + (size_t)(0 * NB + b) * 6 * D; const float* sh = m; const float* sc = m + D; const float* gt = m + 2 * D;
      auto mixg = [&](int mi, const float* Bw, int N, int ldb, int emode, float* C, int ldc, const float* ev0) {
          NG p = ng0(); p.M = T; p.N = N; p.K = D; p.amode = 2; p.A = x0; p.lda = D; p.ash = sh; p.asc = sc; p.amu = in.p[6] + mi * D; p.bmode = 0; p.B0 = Bw; p.ldb = ldb; p.emode = emode; p.C = C; p.ldc = ldc; p.ev0 = ev0; gemm(s, p, T / 64, 1); };
      mixg(0, in.p[7] + 0 * (size_t)D * D, D, D, 0, buf(B_R), D, nullptr);
      mixg(2, in.p[7] + 1 * (size_t)D * D, D, D, 0, buf(B_K), D, nullptr);
      mixg(3, in.p[7] + 2 * (size_t)D * D, D, D, 0, buf(B_V), D, nullptr);
      float* T1 = (float*)(ws + W_T1); float* T2 = (float*)(ws + W_T2); float* T3 = (float*)(ws + W_T3);
      mixg(1, in.p[10], 64, 64, 1, T1, 64, nullptr);
      mixg(4, in.p[13], 64, 64, 0, T2, 64, nullptr);
      mixg(5, in.p[15], 128, 128, 2, T3, 128, nullptr);
      { NG p = ng0(); p.M = T; p.N = D; p.K = 64; p.amode = 0; p.A = T1; p.lda = 64; p.B0 = in.p[11]; p.ldb = D; p.emode = 3; p.C = buf(B_LW); p.ldc = D; p.ev0 = in.p[9]; gemm(s, p, T / 64, 1); }
      { NG p = ng0(); p.M = T; p.N = D; p.K = 64; p.amode = 0; p.A = T2; p.lda = 64; p.B0 = in.p[14]; p.ldb = D; p.emode = 4; p.C = buf(B_A); p.ldc = D; p.ev0 = in.p[12]; gemm(s, p, T / 64, 1); }
      { NG p = ng0(); p.M = T; p.N = D; p.K = 128; p.amode = 0; p.A = T3; p.lda = 128; p.B0 = in.p[16]; p.ldb = D; p.emode = 0; p.C = buf(B_G); p.ldc = D; gemm(s, p, T / 64, 1); }
      hipLaunchKernelGGL(k_prep0, dim3(T * H / 4), dim3(256), 0, s, buf(B_K), buf(B_A), in.p[17], in.p[18], buf(B_KK), buf(B_KP));
      hipLaunchKernelGGL(k_scan, dim3(H), dim3(64), 0, s, buf(B_R), buf(B_LW), buf(B_KP), buf(B_V), buf(B_KK), buf(B_A), buf(B_Y));
      hipLaunchKernelGGL(k_post0, dim3(T * H / 4), dim3(256), 0, s, buf(B_Y), buf(B_R), buf(B_KP), buf(B_V), buf(B_G), in.p[19], in.p[20], in.p[21], buf(B_Z));
      { NG p = ng0(); p.M = T; p.N = D; p.K = D; p.amode = 0; p.A = buf(B_Z); p.lda = D; p.B0 = in.p[8]; p.ldb = D; p.emode = 5; p.C = buf(B_PRE); p.ldc = D; p.eres = x0; p.egate = gt; gemm(s, p, T / 64, 1); }
      hipLaunchKernelGGL(k_ln, dim3(T), dim3(256), 0, s, buf(B_PRE), (const float*)nullptr, (const float*)nullptr, in.p[4] + 0 * D, in.p[5] + 0 * D, buf(B_X1), 0);
      moe(s, in, ws, 0, m, buf(B_X1), buf(B_X2));
    }
    { const float* m = MOD + (size_t)(1 * NB + b) * 6 * D; const float* sh = m; const float* sc = m + D; const float* gt = m + 2 * D;
      float* LOGF = (float*)(ws + W_LOGF); float* F = (float*)(ws + W_F);
      { NG p = ng0(); p.M = T; p.N = 2 * D + H; p.K = D; p.amode = 0; p.A = buf(B_X2); p.lda = D; p.B0 = in.p[22]; p.ldb = 2 * D + H; p.emode = 8; p.C = buf(B_KRAW); p.C2 = buf(B_V); p.C3 = LOGF; p.ev0 = in.p[23]; gemm(s, p, T / 64, 1); }
      hipLaunchKernelGGL(k_rms, dim3(T * H / 4), dim3(256), 0, s, buf(B_KRAW), in.p[24], buf(B_KN));
      hipLaunchKernelGGL(k_fcum, dim3(H), dim3(64), 0, s, LOGF, F);
      { NG p = ng0(); p.M = T; p.N = 2 * D; p.K = D; p.amode = 1; p.A = buf(B_X2); p.lda = D; p.ash = sh; p.asc = sc; p.B0 = in.p[25]; p.ldb = 2 * D; p.emode = 9; p.C = buf(B_QRAW); p.C2 = buf(B_GATE); gemm(s, p, T / 64, 1); }
      hipLaunchKernelGGL(k_rms, dim3(T * H / 4), dim3(256), 0, s, buf(B_QRAW), in.p[26], buf(B_QN));
      hipLaunchKernelGGL(k_attn, dim3(T / 64, H), dim3(64), 0, s, buf(B_QN), buf(B_KN), buf(B_V), F, buf(B_GATE), buf(B_OG));
      { NG p = ng0(); p.M = T; p.N = D; p.K = D; p.amode = 0; p.A = buf(B_OG); p.lda = D; p.B0 = in.p[27]; p.ldb = D; p.emode = 5; p.C = buf(B_PRE); p.ldc = D; p.eres = buf(B_X2); p.egate = gt; gemm(s, p, T / 64, 1); }
      hipLaunchKernelGGL(k_ln, dim3(T), dim3(256), 0, s, buf(B_PRE), (const float*)nullptr, (const float*)nullptr, in.p[4] + 2 * D, in.p[5] + 2 * D, buf(B_X1), 0);
      moe(s, in, ws, 1, m, buf(B_X1), out);
    }
}
static void forward_all(hipStream_t s, void* const* d_in, float* d_out, char* ws) {
    In in; for (int i = 0; i < 36; ++i) in.p[i] = (const float*)d_in[i];
    hipLaunchKernelGGL(k_mod, dim3(2 * NB * 6 * D / 256), dim3(256), 0, s, in.p[1], in.p[2], in.p[3], (float*)(ws + W_MOD));
    for (int b = 0; b < NB; ++b) forward_batch(s, in, ws, b, d_out + (size_t)b * T * D);
}
}
extern "C" void kernel_launch(void* const* d_in, const int* in_sizes, int n_in, void* d_out, int out_size, void* d_ws, size_t ws_size, hipStream_t stream) {
    if (n_in != 36 || ws_size < nv::W_END) { fprintf(stderr, "kernel_launch: unexpected n_in %d / ws %zu\n", n_in, ws_size); return; }
    nv::forward_all(stream, d_in, (float*)d_out, (char*)d_ws);
}
```

```cpp
#define FK_EXPERTS 1
#define FK_PH_HI 23
#include <hip/hip_runtime.h>
#include <hip/hip_bf16.h>
#include <cstdio>
#include <cstdint>
#include <cstring>
#include <cmath>
namespace pg8 {
#define PG8_LAS __attribute__((address_space(3)))
typedef unsigned short bf16_t;
typedef short bf16x8 __attribute__((ext_vector_type(8)));
typedef float f32x4 __attribute__((ext_vector_type(4)));
typedef unsigned u32x4 __attribute__((ext_vector_type(4)));
constexpr int BM = 256, BK = 64, HALF = 128, HTB = HALF * BK * 2  , STAGE_BYTES = 8 * HTB, NXCD = 8, WGM = 8;

__host__ __device__ __forceinline__ int lds_byte(int r, int c) { const int st = (r >> 4) * 2 + (c >> 5), rr = r & 15, cc = c & 31, ob = rr * 64 + cc * 2; return st * 1024 + (ob ^ (((ob >> 9) & 1) << 5)); }
__host__ __device__ __forceinline__ void stage_rc(int b, int& R, int& C) { const int st = b / 1024, sb = b % 1024, swz = sb ^ (((sb >> 9) & 1) << 5); R = (st >> 1) * 16 + swz / 64; C = (st & 1) * 32 + (swz % 64) / 2; }
__host__ __device__ __forceinline__ int perm32(int rho) { const int n = rho >> 4, i = rho & 15; return 8 * (i >> 2) + 4 * n + (i & 3); }

struct Unit { int pm, pn; };
struct Gemm { const bf16_t* A; const bf16_t* Bt; int M, N, K; int asel_div; size_t asel_stride; };

struct StaticOrder {
    int nM, nN, nwg, G, c;
    __host__ __device__ void init(int M, int N, int G_, int c_) { nM = M / BM; nN = N / BM; nwg = nM * nN; G = G_; c = c_; }
    __host__ __device__ bool next(int i, Unit& u) const {
        const long L = (long)i * G + c; if (L >= nwg) return false;
        int wgid = (int)L; { const int q = nwg / NXCD, r = nwg % NXCD, xcd = wgid % NXCD, off = wgid / NXCD; wgid = (xcd < r ? xcd * (q + 1) : r * (q + 1) + (xcd - r) * q) + off; }
        const int nig = WGM * nN, gid = wgid / nig, fm = gid * WGM, gsz = (nM - fm) < WGM ? (nM - fm) : WGM;
        u.pm = fm + ((wgid % nig) % gsz); u.pn = (wgid % nig) / gsz; return true;
    }
    __device__ __forceinline__ void a_ready(const Unit&) const {}
    __device__ __forceinline__ void done(const Unit&) const {}
};

typedef float f32x2c_t __attribute__((ext_vector_type(2))); typedef __bf16 bf16x2c_t __attribute__((ext_vector_type(2)));
__device__ __forceinline__ unsigned cvt_pk_bf16(float lo, float hi) { f32x2c_t v = {lo, hi}; bf16x2c_t b = __builtin_convertvector(v, bf16x2c_t); return __builtin_bit_cast(unsigned, b); }
typedef float f32x2 __attribute__((ext_vector_type(2)));
__device__ __forceinline__ f32x2 gelu_pk(f32x2 v) {
    const f32x2 av = __builtin_elementwise_abs(v), d = av * 0.2316418882f + 1.0f;
    f32x2 t; t.x = __builtin_amdgcn_rcpf(d.x); t.y = __builtin_amdgcn_rcpf(d.y);
    f32x2 q = t * 0.5307027145f + (-0.7265760135f); q = q * t + 0.7107068705f; q = q * t + (-0.142248368f); q = q * t + 0.127414796f; q = q * t;
    const f32x2 s = (v * v) * (-0.72134752044f);
    f32x2 e; e.x = __builtin_amdgcn_exp2f(s.x); e.y = __builtin_amdgcn_exp2f(s.y);
    const f32x2 m = v * (q * e), r = v - m;
    f32x2 o; o.x = v.x < 0.f ? m.x : r.x; o.y = v.y < 0.f ? m.y : r.y; return o;
}

template <int ACT  > struct EpiBf16 {
    static constexpr bool PERM = true, AFTER_DRAIN = false; static_assert(ACT == 0 || ACT == 1, "EpiBf16: ACT is 0 (none) or 1 (gelu_pk)");
    bf16_t* O; int ldc; const float* bias; int split_cols; size_t split_stride; float scale0;
    __device__ __forceinline__ void operator()(const f32x4 (&acc)[2][2][4][2], const Unit& u, int wr, int wc, int fr, int fq) const {
        const int row0 = u.pm * BM + wr * 64 + fr; int colt = u.pn * BM; bf16_t* base = O;
        float sc = 1.f; if (split_cols) { const int t = colt / split_cols; base += (size_t)t * split_stride; colt -= t * split_cols; if (t == 0) sc = scale0; }
        const int col0 = colt + wc * 32 + 8 * fq, bcol0 = u.pn * BM + wc * 32 + 8 * fq;
        f32x4 bv[2][2];
#pragma unroll
        for (int bj = 0; bj < 2; ++bj)
#pragma unroll
            for (int n = 0; n < 2; ++n) bv[bj][n] = bias ? *(const f32x4*)(bias + bcol0 + bj * HALF + 4 * n) : (f32x4){0.f, 0.f, 0.f, 0.f};
#pragma unroll
        for (int ai = 0; ai < 2; ++ai)
#pragma unroll
            for (int m = 0; m < 4; ++m) { bf16_t* rowp = base + (size_t)(row0 + ai * HALF + m * 16) * ldc + col0;
#pragma unroll
                for (int bj = 0; bj < 2; ++bj) { f32x4 v0 = acc[ai][bj][m][0] + bv[bj][0], v1 = acc[ai][bj][m][1] + bv[bj][1];
                    if (ACT == 1) { f32x2 a = gelu_pk((f32x2){v0[0], v0[1]}), b = gelu_pk((f32x2){v0[2], v0[3]}), c = gelu_pk((f32x2){v1[0], v1[1]}), d = gelu_pk((f32x2){v1[2], v1[3]});
                        v0 = (f32x4){a.x, a.y, b.x, b.y}; v1 = (f32x4){c.x, c.y, d.x, d.y}; }
                    v0 = v0 * sc; v1 = v1 * sc; u32x4 w; w.x = cvt_pk_bf16(v0[0], v0[1]); w.y = cvt_pk_bf16(v0[2], v0[3]); w.z = cvt_pk_bf16(v1[0], v1[1]); w.w = cvt_pk_bf16(v1[2], v1[3]);
                    *(u32x4*)(rowp + bj * HALF) = w; } }
    }
};

struct PanelStats {
    unsigned* xbuf;
    unsigned* cnt;
    unsigned* tmo;
    int ntn; float eps;
    unsigned code;
    __device__ __forceinline__ bool run(const f32x4 (&v)[2][2][4][2], const Unit& u, int wr, int wc, int fr, int fq, PG8_LAS unsigned char* lds, int wid, int lane) const {
        typedef float f32x2v __attribute__((ext_vector_type(2)));
        PG8_LAS f32x2v* P = (PG8_LAS f32x2v*)lds;
        PG8_LAS f32x2v* S = (PG8_LAS f32x2v*)(lds + 8192);
        PG8_LAS unsigned* flag = (PG8_LAS unsigned*)(lds + 8192 + 2048);
#pragma unroll
        for (int ai = 0; ai < 2; ++ai)
#pragma unroll
            for (int m = 0; m < 4; ++m) {
                float s = 0.f;
#pragma unroll
                for (int bj = 0; bj < 2; ++bj)
#pragma unroll
                    for (int n = 0; n < 2; ++n) { const f32x4 x = v[ai][bj][m][n]; s += (x[0] + x[1]) + (x[2] + x[3]); }
                s += __shfl_xor(s, 16); s += __shfl_xor(s, 32);
                const float mw = s * (1.0f / 64.0f); float q = 0.f;
#pragma unroll
                for (int bj = 0; bj < 2; ++bj)
#pragma unroll
                    for (int n = 0; n < 2; ++n) { const f32x4 d = v[ai][bj][m][n] - mw; q += (d[0] * d[0] + d[1] * d[1]) + (d[2] * d[2] + d[3] * d[3]); }
                q += __shfl_xor(q, 16); q += __shfl_xor(q, 32);
                if (fq == 0) P[(ai * HALF + wr * 64 + m * 16 + fr) * 4 + wc] = (f32x2v){mw, q};
            }
        asm volatile("s_waitcnt lgkmcnt(0)" ::: "memory"); __builtin_amdgcn_s_barrier(); asm volatile("" ::: "memory");
#if defined(BROKEN_EXCHANGE_NO_WAIT)
#warning BROKEN CONTROL BUILD: the row-statistics exchange does not wait; results are wrong by design
        if (blockIdx.x >= 64) { const long long t0_ = clock64(); while (clock64() - t0_ < 60000) __builtin_amdgcn_s_sleep(8); }
#endif
        const int row = wid * 32 + (lane & 31);
        if (lane < 32) {
            const f32x2v a = P[row * 4 + 0], b = P[row * 4 + 1], c = P[row * 4 + 2], d = P[row * 4 + 3];
            const float mt = (a.x + b.x + c.x + d.x) * 0.25f;
            const float da = a.x - mt, db = b.x - mt, dc = c.x - mt, dd = d.x - mt;
            const float m2 = (a.y + b.y) + (c.y + d.y) + 64.0f * ((da * da + db * db) + (dc * dc + dd * dd));
            unsigned long long* slot = (unsigned long long*)xbuf + ((size_t)(u.pm * BM + row) * 4 + u.pn);
            __hip_atomic_store(slot, ((unsigned long long)__float_as_uint(m2) << 32) | __float_as_uint(mt), __ATOMIC_RELAXED, __HIP_MEMORY_SCOPE_AGENT);
        }
        asm volatile("s_waitcnt vmcnt(0)" ::: "memory");
        if (lane == 0) __hip_atomic_fetch_add(cnt + 64 * u.pm, 1u, __ATOMIC_RELAXED, __HIP_MEMORY_SCOPE_AGENT);
        if (wid == 0) {
            bool dead = false; const unsigned long long t0 = __builtin_amdgcn_s_memrealtime(); const unsigned want = 8u * (unsigned)ntn;
            for (;;) {
#if defined(BROKEN_EXCHANGE_NO_WAIT)
                break;
#endif
                if ((unsigned)__builtin_amdgcn_readfirstlane(__hip_atomic_load(cnt + 64 * u.pm, __ATOMIC_RELAXED, __HIP_MEMORY_SCOPE_AGENT)) >= want) break;
                if (__builtin_amdgcn_s_memrealtime() - t0 > 2000000ull) {
                    if (lane == 0) { unsigned expect = 0u; __hip_atomic_compare_exchange_strong(tmo + 1, &expect, code | (unsigned)(u.pm & 0xff), __ATOMIC_RELAXED, __ATOMIC_RELAXED, __HIP_MEMORY_SCOPE_AGENT);
                                     __hip_atomic_store(tmo, 1u, __ATOMIC_RELAXED, __HIP_MEMORY_SCOPE_AGENT); }
                    dead = true; break; }
                __builtin_amdgcn_s_sleep(2);
            }
            __builtin_amdgcn_fence(__ATOMIC_ACQUIRE, "agent");
            if (lane == 0) flag[0] = dead ? 1u : 0u;
        }
        asm volatile("s_waitcnt vmcnt(0) lgkmcnt(0)" ::: "memory"); __builtin_amdgcn_s_barrier(); asm volatile("" ::: "memory");
        const bool bad = flag[0] != 0u;
        if (lane < 32) {
            const unsigned long long* slot = (const unsigned long long*)xbuf + (size_t)(u.pm * BM + row) * 4; float mt[4], m2[4]; float ms = 0.f;
#pragma unroll
            for (int t = 0; t < 4; ++t) { if (t < ntn) { const unsigned long long w = __hip_atomic_load(slot + t, __ATOMIC_RELAXED, __HIP_MEMORY_SCOPE_AGENT); mt[t] = __uint_as_float((unsigned)w); m2[t] = __uint_as_float((unsigned)(w >> 32)); } else { mt[t] = 0.f; m2[t] = 0.f; } ms += mt[t]; }
            const float mean = ms / (float)ntn; float q = 0.f;
#pragma unroll
            for (int t = 0; t < 4; ++t) if (t < ntn) { const float dm = mt[t] - mean; q += m2[t] + 256.0f * dm * dm; }
            S[row] = (f32x2v){mean, 1.0f / sqrtf(q / (256.0f * (float)ntn) + eps)};
        }
        asm volatile("s_waitcnt lgkmcnt(0)" ::: "memory"); __builtin_amdgcn_s_barrier(); asm volatile("" ::: "memory");
        return bad;
    }
};
struct EpiLnRes {
    static constexpr bool PERM = false, AFTER_DRAIN = true;
    const float* base; float* out; int ldc; const float* bias; PanelStats st; unsigned poison;
    __device__ __forceinline__ void fused(f32x4 (&acc)[2][2][4][2], const Unit& u, int wr, int wc, int fr, int fq, PG8_LAS unsigned char* lds, int wid, int lane) const {
        typedef float f32x2v __attribute__((ext_vector_type(2)));
        const PG8_LAS f32x2v* S = (const PG8_LAS f32x2v*)(lds + 8192);
        const int col0 = u.pn * BM + wc * 32 + 4 * fq;
#pragma unroll
        for (int bj = 0; bj < 2; ++bj)
#pragma unroll
            for (int n = 0; n < 2; ++n) { const f32x4 bv = bias ? *(const f32x4*)(bias + col0 + bj * HALF + n * 16) : (f32x4){0.f, 0.f, 0.f, 0.f};
#pragma unroll
                for (int ai = 0; ai < 2; ++ai)
#pragma unroll
                    for (int m = 0; m < 4; ++m) acc[ai][bj][m][n] += bv; }
        f32x4 pre[4][2][2];
#pragma unroll
        for (int m = 0; m < 4; ++m) { const size_t off = (size_t)(u.pm * BM + wr * 64 + m * 16 + fr) * ldc + col0;
#pragma unroll
            for (int bj = 0; bj < 2; ++bj)
#pragma unroll
                for (int n = 0; n < 2; ++n) pre[m][bj][n] = *(const f32x4*)(base + off + bj * HALF + n * 16); }
        const bool bad = st.run(acc, u, wr, wc, fr, fq, lds, wid, lane) || poison != 0u;
        const float qnan = __builtin_nanf("");
#pragma unroll
        for (int ai = 0; ai < 2; ++ai)
#pragma unroll
            for (int m = 0; m < 4; ++m) { const int r = ai * HALF + wr * 64 + m * 16 + fr; const f32x2v sr = S[r]; const size_t off = (size_t)(u.pm * BM + r) * ldc + col0;
#pragma unroll
                for (int bj = 0; bj < 2; ++bj)
#pragma unroll
                    for (int n = 0; n < 2; ++n) { const f32x4 bs = ai == 0 ? pre[m][bj][n] : *(const f32x4*)(base + off + bj * HALF + n * 16); f32x4 o = bs + (acc[ai][bj][m][n] - sr.x) * sr.y;
                        if (bad) o = (f32x4){qnan, qnan, qnan, qnan}; *(f32x4*)(out + off + bj * HALF + n * 16) = o; }
                if (m & 1) asm volatile("" ::: "memory"); }
    }
};
struct EpiLnResLn {
    static constexpr bool PERM = false, AFTER_DRAIN = true;
    const float* base; float* out; bf16_t* xn; int ldc; const float* bias; PanelStats st1, st2; unsigned poison;
    __device__ __forceinline__ void fused(f32x4 (&acc)[2][2][4][2], const Unit& u, int wr, int wc, int fr, int fq, PG8_LAS unsigned char* lds, int wid, int lane) const {
        typedef float f32x2v __attribute__((ext_vector_type(2))); typedef unsigned u32x2v __attribute__((ext_vector_type(2)));
        const PG8_LAS f32x2v* S = (const PG8_LAS f32x2v*)(lds + 8192);
        const int col0 = u.pn * BM + wc * 32 + 4 * fq;
#pragma unroll
        for (int bj = 0; bj < 2; ++bj)
#pragma unroll
            for (int n = 0; n < 2; ++n) { const f32x4 bv = bias ? *(const f32x4*)(bias + col0 + bj * HALF + n * 16) : (f32x4){0.f, 0.f, 0.f, 0.f};
#pragma unroll
                for (int ai = 0; ai < 2; ++ai)
#pragma unroll
                    for (int m = 0; m < 4; ++m) acc[ai][bj][m][n] += bv; }
        bool bad = st1.run(acc, u, wr, wc, fr, fq, lds, wid, lane) || poison != 0u;
        const float qnan = __builtin_nanf("");
#pragma unroll
        for (int ai = 0; ai < 2; ++ai)
#pragma unroll
            for (int m = 0; m < 4; ++m) { const int r = ai * HALF + wr * 64 + m * 16 + fr; const f32x2v sr = S[r]; const size_t off = (size_t)(u.pm * BM + r) * ldc + col0;
#pragma unroll
                for (int bj = 0; bj < 2; ++bj)
#pragma unroll
                    for (int n = 0; n < 2; ++n) { const f32x4 bs = *(const f32x4*)(base + off + bj * HALF + n * 16); acc[ai][bj][m][n] = bs + (acc[ai][bj][m][n] - sr.x) * sr.y; }
                asm volatile("" : "+v"(acc[ai][0][m][0]), "+v"(acc[ai][0][m][1]), "+v"(acc[ai][1][m][0]), "+v"(acc[ai][1][m][1]));
                if (m & 1) asm volatile("" ::: "memory"); }
        const bool bad1 = bad;
        bad = st2.run(acc, u, wr, wc, fr, fq, lds, wid, lane) || bad;
#pragma unroll
        for (int ai = 0; ai < 2; ++ai)
#pragma unroll
            for (int m = 0; m < 4; ++m) { const int r = ai * HALF + wr * 64 + m * 16 + fr; const f32x2v sr = S[r]; const size_t off = (size_t)(u.pm * BM + r) * ldc + col0;
#pragma unroll
                for (int bj = 0; bj < 2; ++bj)
#pragma unroll
                    for (int n = 0; n < 2; ++n) { const f32x4 x1 = acc[ai][bj][m][n]; *(f32x4*)(out + off + bj * HALF + n * 16) = bad1 ? (f32x4){qnan, qnan, qnan, qnan} : x1;
                        const f32x4 o = (x1 - sr.x) * sr.y; u32x2v w; w.x = cvt_pk_bf16(o[0], o[1]); w.y = cvt_pk_bf16(o[2], o[3]);
                        if (bad) { w.x = 0x7fc07fc0u; w.y = 0x7fc07fc0u; } *(u32x2v*)(xn + off + bj * HALF + n * 16) = w; }
                asm volatile("" ::: "memory"); }
    }
};

template <class Epi, class Sched, bool ALIGN_EPI = false, bool SP2 = false>
__device__ __forceinline__ void gemm_phase(PG8_LAS unsigned char* lds, const Gemm g, const Sched& S, const Epi& E, const int wid_in) {
    int lane_; asm volatile("v_mbcnt_lo_u32_b32 %0, -1, 0\n\tv_mbcnt_hi_u32_b32 %0, -1, %0" : "=v"(lane_));
    const int wid = __builtin_amdgcn_readfirstlane(wid_in), lane = lane_, tid = wid * 64 + lane, wr = wid >> 2, wc = wid & 3, fr = lane & 15, fq = lane >> 4;
    const int K = g.K, nt = K / BK;
    unsigned voffA[2], voffB[2];
#pragma unroll
    for (int i = 0; i < 2; ++i) { int R, C; stage_rc(tid * 16 + i * 8192, R, C); const int Rb = Epi::PERM ? ((R & ~31) + perm32(R & 31)) : R;
        voffA[i] = (unsigned)(R * K + C) * 2u; voffB[i] = (unsigned)(Rb * K + C) * 2u; }
    const size_t kstep = (size_t)(BK * 2);
    const size_t hstep = (size_t)HALF * K * 2;
    const size_t tstep = 2 * hstep;
    const unsigned ldsw = (unsigned)wid * 1024u;
    const int aoff = lds_byte(wr * 64 + fr, fq * 8), boff = lds_byte(wc * 32 + fr, fq * 8);
#define PG8_SA(b, h) (((b) * 2 + (h)) * HTB)
#define PG8_SB(b, h) ((4 + (b) * 2 + (h)) * HTB)
#define PG8_STAGE(bufoff, gbase, voff) do { _Pragma("unroll") for (int _i = 0; _i < 2; ++_i) \
        __builtin_amdgcn_global_load_lds((const unsigned*)((const char*)(gbase) + (voff)[_i]), (PG8_LAS unsigned*)(lds + (bufoff) + ldsw + _i * 8192), 16, 0, 0); } while (0)
#define PG8_LDA(dst, b, h) do { _Pragma("unroll") for (int m = 0; m < 4; ++m) _Pragma("unroll") for (int k = 0; k < 2; ++k) dst[m][k] = *(const PG8_LAS bf16x8*)(lds + PG8_SA(b, h) + aoff + m * 2048 + k * 1024); } while (0)
#define PG8_LDB(dst, b, h) do { _Pragma("unroll") for (int n = 0; n < 2; ++n) _Pragma("unroll") for (int k = 0; k < 2; ++k) dst[n][k] = *(const PG8_LAS bf16x8*)(lds + PG8_SB(b, h) + boff + n * 2048 + k * 1024); } while (0)
#define PG8_MMA(ai, bj, At, Bt) do { __builtin_amdgcn_s_setprio(1); _Pragma("unroll") for (int m = 0; m < 4; ++m) _Pragma("unroll") for (int n = 0; n < 2; ++n) _Pragma("unroll") for (int k = 0; k < 2; ++k) \
        acc[ai][bj][m][n] = __builtin_amdgcn_mfma_f32_16x16x32_bf16(Bt[n][k], At[m][k], acc[ai][bj][m][n], 0, 0, 0); __builtin_amdgcn_s_setprio(0); } while (0)
#define PG8_WAIT_V(n) asm volatile("s_waitcnt vmcnt(" #n ")" ::: "memory")
#define PG8_WAIT_L(n) asm volatile("s_waitcnt lgkmcnt(" #n ")" ::: "memory")
#define PG8_BAR __builtin_amdgcn_s_barrier()
#define PG8_SCHED __builtin_amdgcn_sched_barrier(0)
    Unit cur, nxt; int ui = 0;
    if (!S.next(0, cur)) return;
    f32x4 acc[2][2][4][2];
#pragma unroll
    for (int a = 0; a < 2; ++a)
#pragma unroll
        for (int b = 0; b < 2; ++b)
#pragma unroll
            for (int m = 0; m < 4; ++m)
#pragma unroll
                for (int n = 0; n < 2; ++n) acc[a][b][m][n] = (f32x4){0.f, 0.f, 0.f, 0.f};
    bf16x8 At[4][2], B0[2][2], B1[2][2];
    const char* cA = (const char*)g.A + (size_t)cur.pm * tstep + (size_t)(cur.pn / g.asel_div) * g.asel_stride; const char* cB = (const char*)g.Bt + (size_t)cur.pn * tstep;
    S.a_ready(cur);
    if constexpr (SP2) {
        PG8_STAGE(PG8_SB(0, 0), cB, voffB); PG8_STAGE(PG8_SB(0, 1), cB + hstep, voffB); PG8_STAGE(PG8_SA(0, 0), cA, voffA); PG8_STAGE(PG8_SA(0, 1), cA + hstep, voffA);
        if (wr == 1) PG8_BAR;
        PG8_WAIT_V(2); PG8_BAR;
        PG8_STAGE(PG8_SB(1, 0), cB + kstep, voffB); PG8_STAGE(PG8_SA(1, 0), cA + kstep, voffA); PG8_STAGE(PG8_SB(1, 1), cB + hstep + kstep, voffB);
        PG8_WAIT_V(6); PG8_BAR;
    } else {
        PG8_STAGE(PG8_SB(0, 0), cB, voffB); PG8_STAGE(PG8_SA(0, 0), cA, voffA); PG8_STAGE(PG8_SB(0, 1), cB + hstep, voffB); PG8_STAGE(PG8_SA(0, 1), cA + hstep, voffA);
        if (wr == 1) PG8_BAR;
        PG8_WAIT_V(4); PG8_BAR;
        PG8_STAGE(PG8_SB(1, 0), cB + kstep, voffB); PG8_STAGE(PG8_SA(1, 0), cA + kstep, voffA); PG8_STAGE(PG8_SB(1, 1), cB + hstep + kstep, voffB);
        PG8_WAIT_V(6); PG8_BAR;
    }
    for (;;) {
        const bool has_next = S.next(ui + 1, nxt);
        const char* nA = has_next ? (const char*)g.A + (size_t)nxt.pm * tstep + (size_t)(nxt.pn / g.asel_div) * g.asel_stride : cA; const char* nB = has_next ? (const char*)g.Bt + (size_t)nxt.pn * tstep : cB;
        for (int t = 0; t < nt; t += 2) {
            const bool last = (t == nt - 2);
            const char* a1 = cA + (size_t)(t + 1) * kstep;
            const char* a2 = last ? nA : cA + (size_t)(t + 2) * kstep; const char* b2 = last ? nB : cB + (size_t)(t + 2) * kstep;
            const char* a3 = a2 + kstep; const char* b3 = b2 + kstep;
            if (last && has_next) S.a_ready(nxt);
            if constexpr (SP2) {
            PG8_LDB(B0, 0, 0); PG8_LDB(B1, 0, 1); PG8_SCHED; PG8_LDA(At, 0, 0); PG8_STAGE(PG8_SA(1, 1), a1 + hstep, voffA);
            PG8_WAIT_V(8); PG8_WAIT_L(0); PG8_BAR; PG8_MMA(0, 0, At, B0); PG8_MMA(0, 1, At, B1); PG8_BAR; PG8_SCHED;
            PG8_LDA(At, 0, 1); PG8_STAGE(PG8_SB(0, 0), b2, voffB); PG8_STAGE(PG8_SB(0, 1), b2 + hstep, voffB); PG8_STAGE(PG8_SA(0, 0), a2, voffA);
            PG8_WAIT_V(8); PG8_WAIT_L(0); PG8_BAR; PG8_MMA(1, 0, At, B0); PG8_MMA(1, 1, At, B1); PG8_BAR; PG8_SCHED;
            PG8_LDB(B0, 1, 0); PG8_LDB(B1, 1, 1); PG8_SCHED; PG8_LDA(At, 1, 0); PG8_STAGE(PG8_SA(0, 1), a2 + hstep, voffA);
            PG8_WAIT_V(8); PG8_WAIT_L(0); PG8_BAR; PG8_MMA(0, 0, At, B0); PG8_MMA(0, 1, At, B1); PG8_BAR; PG8_SCHED;
            PG8_LDA(At, 1, 1); PG8_STAGE(PG8_SB(1, 0), b3, voffB); PG8_STAGE(PG8_SB(1, 1), b3 + hstep, voffB); PG8_STAGE(PG8_SA(1, 0), a3, voffA);
            PG8_WAIT_V(8); PG8_WAIT_L(0); PG8_BAR; PG8_MMA(1, 0, At, B0); PG8_MMA(1, 1, At, B1); PG8_BAR; PG8_SCHED;
            } else {
            PG8_LDB(B0, 0, 0); PG8_SCHED; PG8_LDA(At, 0, 0); PG8_STAGE(PG8_SA(1, 1), a1 + hstep, voffA);
            PG8_WAIT_L(8); PG8_BAR; PG8_WAIT_L(0); PG8_MMA(0, 0, At, B0); PG8_BAR; PG8_SCHED;
            PG8_LDB(B1, 0, 1); PG8_STAGE(PG8_SB(0, 0), b2, voffB);
            PG8_BAR; PG8_WAIT_L(0); PG8_MMA(0, 1, At, B1); PG8_BAR;
            PG8_LDA(At, 0, 1); PG8_STAGE(PG8_SA(0, 0), a2, voffA);
            PG8_BAR; PG8_WAIT_L(0); PG8_MMA(1, 0, At, B0); PG8_BAR; PG8_SCHED;
            PG8_STAGE(PG8_SB(0, 1), b2 + hstep, voffB);
            PG8_WAIT_V(6); PG8_BAR; PG8_MMA(1, 1, At, B1); PG8_BAR;
            PG8_LDB(B0, 1, 0); PG8_SCHED; PG8_LDA(At, 1, 0); PG8_STAGE(PG8_SA(0, 1), a2 + hstep, voffA);
            PG8_WAIT_L(8); PG8_BAR; PG8_WAIT_L(0); PG8_MMA(0, 0, At, B0); PG8_BAR; PG8_SCHED;
            PG8_LDB(B1, 1, 1); PG8_STAGE(PG8_SB(1, 0), b3, voffB);
            PG8_BAR; PG8_WAIT_L(0); PG8_MMA(0, 1, At, B1); PG8_BAR;
            PG8_LDA(At, 1, 1); PG8_STAGE(PG8_SA(1, 0), a3, voffA);
            PG8_BAR; PG8_WAIT_L(0); PG8_MMA(1, 0, At, B0); PG8_BAR; PG8_SCHED;
            PG8_STAGE(PG8_SB(1, 1), b3 + hstep, voffB);
            PG8_WAIT_V(6); PG8_BAR; PG8_MMA(1, 1, At, B1); PG8_BAR;
            }
        }
        if constexpr (ALIGN_EPI) { if (wr == 0) PG8_BAR; }
        if constexpr (!Epi::AFTER_DRAIN) { E(acc, cur, wr, wc, fr, fq); S.done(cur); }
        if (!has_next) break;
#pragma unroll
        for (int a = 0; a < 2; ++a)
#pragma unroll
            for (int b = 0; b < 2; ++b)
#pragma unroll
                for (int m = 0; m < 4; ++m)
#pragma unroll
                    for (int n = 0; n < 2; ++n) acc[a][b][m][n] = (f32x4){0.f, 0.f, 0.f, 0.f};
        cur = nxt; cA = nA; cB = nB; ++ui;
        if constexpr (ALIGN_EPI) { if (wr == 1) PG8_BAR; }
    }
    PG8_WAIT_V(0);
    if constexpr (!ALIGN_EPI) { if (wr == 0) PG8_BAR; }
    PG8_BAR;
    if constexpr (Epi::AFTER_DRAIN) { E.fused(acc, cur, wr, wc, fr, fq, lds, wid, lane); S.done(cur); }
#undef PG8_SA
#undef PG8_SB
#undef PG8_STAGE
#undef PG8_LDA
#undef PG8_LDB
#undef PG8_MMA
#undef PG8_WAIT_V
#undef PG8_WAIT_L
#undef PG8_BAR
#undef PG8_SCHED
}
}
namespace pg8 {
template <class Epi, class Sched, bool ALIGN_EPI = false, bool SP2 = false>
__device__ __forceinline__ void gemm_phase_g(PG8_LAS unsigned char* lds, const Gemm g, const Sched& S, const Epi& E, const int wid_in) {
    int lane_; asm volatile("v_mbcnt_lo_u32_b32 %0, -1, 0\n\tv_mbcnt_hi_u32_b32 %0, -1, %0" : "=v"(lane_));
    const int wid = __builtin_amdgcn_readfirstlane(wid_in), lane = lane_, tid = wid * 64 + lane, wr = wid >> 2, wc = wid & 3, fr = lane & 15, fq = lane >> 4;
    const int K = g.K, nt = K / BK;
    unsigned voffB[2]; int RA[2], CA[2];
#pragma unroll
    for (int i = 0; i < 2; ++i) { int R, C; stage_rc(tid * 16 + i * 8192, R, C); const int Rb = Epi::PERM ? ((R & ~31) + perm32(R & 31)) : R;
        RA[i] = R; CA[i] = C * 2; voffB[i] = (unsigned)(Rb * K + C) * 2u; }
    unsigned vAc[2][2], vAn[2][2];
    const size_t kstep = (size_t)(BK * 2);
    const size_t hstep = (size_t)HALF * K * 2;
    const size_t tstep = 2 * hstep;
    const unsigned ldsw = (unsigned)wid * 1024u;
    const int aoff = lds_byte(wr * 64 + fr, fq * 8), boff = lds_byte(wc * 32 + fr, fq * 8);
#define PG8_SA(b, h) (((b) * 2 + (h)) * HTB)
#define PG8_SB(b, h) ((4 + (b) * 2 + (h)) * HTB)
#define PG8_STAGE(bufoff, gbase, voff) do { _Pragma("unroll") for (int _i = 0; _i < 2; ++_i) \
        __builtin_amdgcn_global_load_lds((const unsigned*)((const char*)(gbase) + (voff)[_i]), (PG8_LAS unsigned*)(lds + (bufoff) + ldsw + _i * 8192), 16, 0, 0); } while (0)
#define PG8_STAGE_A(bufoff, va, h_, kb_) do { _Pragma("unroll") for (int _i = 0; _i < 2; ++_i) \
        __builtin_amdgcn_global_load_lds((const unsigned*)((const char*)g.A + (size_t)(kb_) + (va)[h_][_i]), (PG8_LAS unsigned*)(lds + (bufoff) + ldsw + _i * 8192), 16, 0, 0); } while (0)
#define PG8_LDA(dst, b, h) do { _Pragma("unroll") for (int m = 0; m < 4; ++m) _Pragma("unroll") for (int k = 0; k < 2; ++k) dst[m][k] = *(const PG8_LAS bf16x8*)(lds + PG8_SA(b, h) + aoff + m * 2048 + k * 1024); } while (0)
#define PG8_LDB(dst, b, h) do { _Pragma("unroll") for (int n = 0; n < 2; ++n) _Pragma("unroll") for (int k = 0; k < 2; ++k) dst[n][k] = *(const PG8_LAS bf16x8*)(lds + PG8_SB(b, h) + boff + n * 2048 + k * 1024); } while (0)
#define PG8_MMA(ai, bj, At, Bt) do { __builtin_amdgcn_s_setprio(1); _Pragma("unroll") for (int m = 0; m < 4; ++m) _Pragma("unroll") for (int n = 0; n < 2; ++n) _Pragma("unroll") for (int k = 0; k < 2; ++k) \
        acc[ai][bj][m][n] = __builtin_amdgcn_mfma_f32_16x16x32_bf16(Bt[n][k], At[m][k], acc[ai][bj][m][n], 0, 0, 0); __builtin_amdgcn_s_setprio(0); } while (0)
#define PG8_WAIT_V(n) asm volatile("s_waitcnt vmcnt(" #n ")" ::: "memory")
#define PG8_WAIT_L(n) asm volatile("s_waitcnt lgkmcnt(" #n ")" ::: "memory")
#define PG8_BAR __builtin_amdgcn_s_barrier()
#define PG8_SCHED __builtin_amdgcn_sched_barrier(0)
    typename Sched::UnitT cur, nxt; int ui = 0;
    if (!S.next(0, cur)) return;
    f32x4 acc[2][2][4][2];
#pragma unroll
    for (int a = 0; a < 2; ++a)
#pragma unroll
        for (int b = 0; b < 2; ++b)
#pragma unroll
            for (int m = 0; m < 4; ++m)
#pragma unroll
                for (int n = 0; n < 2; ++n) acc[a][b][m][n] = (f32x4){0.f, 0.f, 0.f, 0.f};
    bf16x8 At[4][2], B0[2][2], B1[2][2];
    const char* cB = S.bbase(cur) + (size_t)cur.pn * tstep;
    S.a_ready(cur);
#pragma unroll
    for (int h_ = 0; h_ < 2; ++h_)
#pragma unroll
        for (int i_ = 0; i_ < 2; ++i_) { vAc[h_][i_] = S.a_off(cur, h_ * HALF + RA[i_]) + (unsigned)CA[i_]; vAn[h_][i_] = vAc[h_][i_]; }
    if constexpr (SP2) {
        PG8_STAGE(PG8_SB(0, 0), cB, voffB); PG8_STAGE(PG8_SB(0, 1), cB + hstep, voffB); PG8_STAGE_A(PG8_SA(0, 0), vAc, 0, 0); PG8_STAGE_A(PG8_SA(0, 1), vAc, 1, 0);
        if (wr == 1) PG8_BAR;
        PG8_WAIT_V(2); PG8_BAR;
        PG8_STAGE(PG8_SB(1, 0), cB + kstep, voffB); PG8_STAGE_A(PG8_SA(1, 0), vAc, 0, kstep); PG8_STAGE(PG8_SB(1, 1), cB + hstep + kstep, voffB);
        PG8_WAIT_V(6); PG8_BAR;
    } else {
        PG8_STAGE(PG8_SB(0, 0), cB, voffB); PG8_STAGE_A(PG8_SA(0, 0), vAc, 0, 0); PG8_STAGE(PG8_SB(0, 1), cB + hstep, voffB); PG8_STAGE_A(PG8_SA(0, 1), vAc, 1, 0);
        if (wr == 1) PG8_BAR;
        PG8_WAIT_V(4); PG8_BAR;
        PG8_STAGE(PG8_SB(1, 0), cB + kstep, voffB); PG8_STAGE_A(PG8_SA(1, 0), vAc, 0, kstep); PG8_STAGE(PG8_SB(1, 1), cB + hstep + kstep, voffB);
        PG8_WAIT_V(6); PG8_BAR;
    }
    for (;;) {
        const bool has_next = S.next(ui + 1, nxt);
        const char* nB = has_next ? S.bbase(nxt) + (size_t)nxt.pn * tstep : cB;
        if (has_next) {
#pragma unroll
            for (int h_ = 0; h_ < 2; ++h_)
#pragma unroll
                for (int i_ = 0; i_ < 2; ++i_) vAn[h_][i_] = S.a_off(nxt, h_ * HALF + RA[i_]) + (unsigned)CA[i_]; }
        for (int t = 0; t < nt; t += 2) {
            const bool last = (t == nt - 2);
            const size_t k1 = (size_t)(t + 1) * kstep, k2 = last ? 0 : (size_t)(t + 2) * kstep, k3 = k2 + kstep;
            unsigned vA2[2][2];
#pragma unroll
            for (int h_ = 0; h_ < 2; ++h_)
#pragma unroll
                for (int i_ = 0; i_ < 2; ++i_) vA2[h_][i_] = last ? vAn[h_][i_] : vAc[h_][i_];
            const char* b2 = last ? nB : cB + (size_t)(t + 2) * kstep; const char* b3 = b2 + kstep;
            if (last && has_next) S.a_ready(nxt);
            if constexpr (SP2) {
            PG8_LDB(B0, 0, 0); PG8_LDB(B1, 0, 1); PG8_SCHED; PG8_LDA(At, 0, 0); PG8_STAGE_A(PG8_SA(1, 1), vAc, 1, k1);
            PG8_WAIT_V(8); PG8_WAIT_L(0); PG8_BAR; PG8_MMA(0, 0, At, B0); PG8_MMA(0, 1, At, B1); PG8_BAR; PG8_SCHED;
            PG8_LDA(At, 0, 1); PG8_STAGE(PG8_SB(0, 0), b2, voffB); PG8_STAGE(PG8_SB(0, 1), b2 + hstep, voffB); PG8_STAGE_A(PG8_SA(0, 0), vA2, 0, k2);
            PG8_WAIT_V(8); PG8_WAIT_L(0); PG8_BAR; PG8_MMA(1, 0, At, B0); PG8_MMA(1, 1, At, B1); PG8_BAR; PG8_SCHED;
            PG8_LDB(B0, 1, 0); PG8_LDB(B1, 1, 1); PG8_SCHED; PG8_LDA(At, 1, 0); PG8_STAGE_A(PG8_SA(0, 1), vA2, 1, k2);
            PG8_WAIT_V(8); PG8_WAIT_L(0); PG8_BAR; PG8_MMA(0, 0, At, B0); PG8_MMA(0, 1, At, B1); PG8_BAR; PG8_SCHED;
            PG8_LDA(At, 1, 1); PG8_STAGE(PG8_SB(1, 0), b3, voffB); PG8_STAGE(PG8_SB(1, 1), b3 + hstep, voffB); PG8_STAGE_A(PG8_SA(1, 0), vA2, 0, k3);
            PG8_WAIT_V(8); PG8_WAIT_L(0); PG8_BAR; PG8_MMA(1, 0, At, B0); PG8_MMA(1, 1, At, B1); PG8_BAR; PG8_SCHED;
            } else {
            PG8_LDB(B0, 0, 0); PG8_SCHED; PG8_LDA(At, 0, 0); PG8_STAGE_A(PG8_SA(1, 1), vAc, 1, k1);
            PG8_WAIT_L(8); PG8_BAR; PG8_WAIT_L(0); PG8_MMA(0, 0, At, B0); PG8_BAR; PG8_SCHED;
            PG8_LDB(B1, 0, 1); PG8_STAGE(PG8_SB(0, 0), b2, voffB);
            PG8_BAR; PG8_WAIT_L(0); PG8_MMA(0, 1, At, B1); PG8_BAR;
            PG8_LDA(At, 0, 1); PG8_STAGE_A(PG8_SA(0, 0), vA2, 0, k2);
            PG8_BAR; PG8_WAIT_L(0); PG8_MMA(1, 0, At, B0); PG8_BAR; PG8_SCHED;
            PG8_STAGE(PG8_SB(0, 1), b2 + hstep, voffB);
            PG8_WAIT_V(6); PG8_BAR; PG8_MMA(1, 1, At, B1); PG8_BAR;
            PG8_LDB(B0, 1, 0); PG8_SCHED; PG8_LDA(At, 1, 0); PG8_STAGE_A(PG8_SA(0, 1), vA2, 1, k2);
            PG8_WAIT_L(8); PG8_BAR; PG8_WAIT_L(0); PG8_MMA(0, 0, At, B0); PG8_BAR; PG8_SCHED;
            PG8_LDB(B1, 1, 1); PG8_STAGE(PG8_SB(1, 0), b3, voffB);
            PG8_BAR; PG8_WAIT_L(0); PG8_MMA(0, 1, At, B1); PG8_BAR;
            PG8_LDA(At, 1, 1); PG8_STAGE_A(PG8_SA(1, 0), vA2, 0, k3);
            PG8_BAR; PG8_WAIT_L(0); PG8_MMA(1, 0, At, B0); PG8_BAR; PG8_SCHED;
            PG8_STAGE(PG8_SB(1, 1), b3 + hstep, voffB);
            PG8_WAIT_V(6); PG8_BAR; PG8_MMA(1, 1, At, B1); PG8_BAR;
            }
        }
        if constexpr (ALIGN_EPI) { if (wr == 0) PG8_BAR; }
        if constexpr (!Epi::AFTER_DRAIN) { E(acc, cur, wr, wc, fr, fq); S.done(cur); }
        if (!has_next) break;
#pragma unroll
        for (int a = 0; a < 2; ++a)
#pragma unroll
            for (int b = 0; b < 2; ++b)
#pragma unroll
                for (int m = 0; m < 4; ++m)
#pragma unroll
                    for (int n = 0; n < 2; ++n) acc[a][b][m][n] = (f32x4){0.f, 0.f, 0.f, 0.f};
        cur = nxt; cB = nB; ++ui;
#pragma unroll
        for (int h_ = 0; h_ < 2; ++h_)
#pragma unroll
            for (int i_ = 0; i_ < 2; ++i_) vAc[h_][i_] = vAn[h_][i_];
        if constexpr (ALIGN_EPI) { if (wr == 1) PG8_BAR; }
    }
    PG8_WAIT_V(0);
    if constexpr (!ALIGN_EPI) { if (wr == 0) PG8_BAR; }
    PG8_BAR;
    if constexpr (Epi::AFTER_DRAIN) { E.fused(acc, cur, wr, wc, fr, fq, lds, wid, lane); S.done(cur); }
#undef PG8_SA
#undef PG8_SB
#undef PG8_STAGE
#undef PG8_STAGE_A
#undef PG8_LDA
#undef PG8_LDB
#undef PG8_MMA
#undef PG8_WAIT_V
#undef PG8_WAIT_L
#undef PG8_BAR
#undef PG8_SCHED
}
}
__device__ __forceinline__ int hw_lane() { int l; asm volatile("v_mbcnt_lo_u32_b32 %0, -1, 0\n\tv_mbcnt_hi_u32_b32 %0, -1, %0" : "=v"(l)); return l; }
#define GAS __attribute__((address_space(1)))
#define LAS __attribute__((address_space(3)))
typedef unsigned short bf16;
typedef unsigned v4u __attribute__((ext_vector_type(4)));
typedef float f32x4 __attribute__((ext_vector_type(4)));
typedef short bf16x8 __attribute__((ext_vector_type(8)));
typedef GAS unsigned gu32;
typedef GAS unsigned long long gu64;
#define RLX_AGENT __ATOMIC_RELAXED, __HIP_MEMORY_SCOPE_AGENT
#define LDS_WAIT() asm volatile("s_waitcnt lgkmcnt(0)" ::: "memory")
#define VM_WAIT() asm volatile("s_waitcnt vmcnt(0)" ::: "memory")
__device__ __forceinline__ unsigned long long rt() { return __builtin_amdgcn_s_memrealtime(); }
__device__ __forceinline__ unsigned f2bf(float f) { unsigned u = __builtin_bit_cast(unsigned, f); return (u + 0x7fffu + ((u >> 16) & 1u)) >> 16; }
__device__ __forceinline__ unsigned pk2(float lo, float hi) { return f2bf(lo) | (f2bf(hi) << 16); }

#define XB_TMO      128
#define XB_XCNT(j)  (256  + 64 * (j))
#define XB_XSUB(j)  (1280 + 64 * (j))
#define XB_XGEN(j)  (2304 + 64 * (j))
#define XB_TOP      3328
#define XB_TOPGEN   3392
#define XCD_BAR_WORDS 3456
#define XB_SPIN_CAP (1u << 18)

__device__ __forceinline__ unsigned xb_ld(unsigned* p)              { return __hip_atomic_load(p, __ATOMIC_RELAXED, __HIP_MEMORY_SCOPE_AGENT); }
__device__ __forceinline__ unsigned xb_add(unsigned* p, unsigned v) { return __hip_atomic_fetch_add(p, v, __ATOMIC_RELAXED, __HIP_MEMORY_SCOPE_AGENT); }
__device__ __forceinline__ unsigned xb_xcc_id() { return (unsigned)__builtin_amdgcn_s_getreg((3 << 11) | 20) & 0xFu; }
#define XB_SPIN(cond, bar) do { unsigned _sp = 0; while (cond) { __builtin_amdgcn_s_sleep(1); \
    if ((++_sp & 255u) == 0u) { if (xb_ld(&(bar)[XB_TMO])) break; if (_sp > XB_SPIN_CAP) { atomicAdd(&(bar)[XB_TMO], 1u); break; } } } } while (0)

struct XcdBarrier {
    unsigned* bar; unsigned x;
    volatile LAS unsigned* st;
};

__device__ __forceinline__ XcdBarrier xcd_barrier_post(unsigned* bar, volatile LAS unsigned* st) {
    XcdBarrier b; b.bar = bar; b.x = xb_xcc_id(); b.st = st;
    if (threadIdx.x == 0) (void)xb_add(&bar[XB_XCNT(b.x)], 1u);
    return b;
}
__device__ __forceinline__ void xcd_barrier_complete(unsigned* bar, unsigned x, unsigned& nloc, unsigned& nx) {
    const unsigned G = gridDim.x * gridDim.y * gridDim.z;
    unsigned sum, cnt, mine, sp = 0u;
    for (;;) {
        sum = 0u; cnt = 0u; mine = 0u;
#pragma unroll
        for (unsigned j = 0; j < 16; ++j) { const unsigned c = xb_ld(&bar[XB_XCNT(j)]); sum += c; cnt += (c > 0u) ? 1u : 0u; mine = (j == x) ? c : mine; }
        if (sum == G) break;
        __builtin_amdgcn_s_sleep(1);
        if ((++sp & 255u) == 0u) { if (xb_ld(&bar[XB_TMO])) break; if (sp > XB_SPIN_CAP) { atomicAdd(&bar[XB_TMO], 1u); break; } }
    }
    nloc = mine > 0u ? mine : 1u; nx = cnt > 0u ? cnt : 1u;
}

__device__ __forceinline__ void xcd_barrier(const XcdBarrier& b, const bool is_t0) {
    asm volatile("s_waitcnt vmcnt(0)" ::: "memory");
    __syncthreads();
    if (is_t0) {
        unsigned* bar = b.bar;
        __builtin_amdgcn_s_waitcnt(0);
        unsigned nloc = b.st[0], nx = b.st[1];
        if (nloc == 0u) { xcd_barrier_complete(bar, b.x, nloc, nx); b.st[0] = nloc; b.st[1] = nx; }
        const unsigned old = xb_add(&bar[XB_XSUB(b.x)], 1u);
        const unsigned gen = old / nloc;
        if (old + 1u == (gen + 1u) * nloc) {
            __builtin_amdgcn_fence(__ATOMIC_RELEASE, "agent");
            asm volatile("s_waitcnt vmcnt(0)" ::: "memory");
            const unsigned og = xb_add(&bar[XB_TOP], 1u);
            const unsigned tg = og / nx;
            if (og + 1u == (tg + 1u) * nx) xb_add(&bar[XB_TOPGEN], 1u);
            else XB_SPIN(xb_ld(&bar[XB_TOPGEN]) == tg, bar);
            __builtin_amdgcn_fence(__ATOMIC_ACQUIRE, "agent");
            xb_add(&bar[XB_XGEN(b.x)], 1u);
            asm volatile("s_waitcnt vmcnt(0)" ::: "memory");
        } else {
            XB_SPIN(xb_ld(&bar[XB_XGEN(b.x)]) == gen, bar);
            __builtin_amdgcn_fence(__ATOMIC_ACQUIRE, "agent");
            asm volatile("s_waitcnt vmcnt(0)" ::: "memory");
        }
    }
    __syncthreads();
}

namespace fk {
using pg8::bf16_t; using pg8::f32x4; using pg8::u32x4; using pg8::Unit; using pg8::BM; using pg8::HALF;
constexpr int NWAVES = 8, NTHR = 512;
constexpr int NB = 4, T = 8192, D = 1024, H = 16, HD = 64, M = NB * T, NE = 256, FX = 256;
constexpr float ALPHA = 1.4142135623730951f, LN_EPS = 1e-5f;
constexpr size_t MiB = 1u << 20;
constexpr size_t WS_CTL = 0, CTL_ZERO_BYTES = 1 * MiB;
constexpr size_t WS_MOD = 1 * MiB;
constexpr size_t WS_WRKV = 2 * MiB, WS_B1T = 8 * MiB, WS_B2T = 9 * MiB, WS_WO0 = 11 * MiB, WS_RT0 = 13 * MiB, WS_SGU0 = 15 * MiB, WS_SD0 = 16 * MiB,
                 WS_KVT = 17 * MiB, WS_QGT = 21 * MiB, WS_WO1 = 25 * MiB, WS_RT1 = 27 * MiB, WS_SGU1 = 29 * MiB, WS_SD1 = 30 * MiB;
constexpr size_t WS_EGU = 32 * MiB, EGU_L = 256 * MiB, WS_ED = 544 * MiB, ED_L = 128 * MiB;
constexpr size_t WS_XR = 800 * MiB, WS_XK = 864 * MiB, WS_XV = 928 * MiB, WS_HX = 992 * MiB;
constexpr size_t WS_R = 1120 * MiB, WS_K = 1184 * MiB, WS_V = 1248 * MiB, WS_L1 = 1312 * MiB, WS_LW = 1328 * MiB, WS_A = 1456 * MiB, WS_G = 1520 * MiB, WS_BONUS = 1584 * MiB;
constexpr size_t WS_PT = 800 * MiB, WS_RTL = 864 * MiB, WS_Q = 928 * MiB, WS_YL = 992 * MiB, WS_Y = 1056 * MiB, WS_Z = 1120 * MiB, WS_PRE = 1328 * MiB;
constexpr size_t WS_X1 = 1600 * MiB, WS_H2 = 1728 * MiB, WS_LOGITS = 1792 * MiB, WS_IDX = 1824 * MiB, WS_GW = 1825 * MiB, WS_LIST = 1826 * MiB, WS_HB = 1858 * MiB;
constexpr size_t WS_ACT = 800 * MiB, WS_ACTS = 928 * MiB, WS_OUTROW = 944 * MiB, WS_YS = 1456 * MiB, WS_XB = 1520 * MiB;
constexpr size_t WS_KN = 800 * MiB, WS_VV = 864 * MiB, WS_QN = 928 * MiB, WS_GATE = 992 * MiB, WS_LOGF = 1586 * MiB, WS_FLOC = 1588 * MiB, WS_FTOT = 1590 * MiB, WS_O = 1064 * MiB;
constexpr size_t WS_FAST_END = 1922 * MiB;
constexpr int CW_TMO = 0, CW_CODE = 1, CW_BAR = 4096, CW_CNT = 16384  , CW_DBG = 32768;
constexpr int RING_BYTES = 131072, LDSCTL_OFF = RING_BYTES, MISC_OFF = LDSCTL_OFF + 320, LDS_BYTES = 147456;

typedef GAS float gf32;
struct Args { const float* in[36]; float* out; unsigned char* ws; int ph_lo, ph_hi; };

__device__ __forceinline__ float wave_sum(float v) {
#pragma unroll
    for (int o = 1; o < 64; o <<= 1) v += __shfl_xor(v, o);
    return v;
}
__device__ __forceinline__ float sigm(float x) { return __builtin_amdgcn_rcpf(1.f + __expf(-x)); }
__device__ __forceinline__ float siluf(float x) { return x * sigm(x); }
__device__ __forceinline__ float softplus_(float x) { return fmaxf(x, 0.f) + __logf(1.f + __expf(-fabsf(x))); }
__device__ __forceinline__ float tanh_(float x) { const float e = __expf(2.f * x); return 1.f - 2.f * __builtin_amdgcn_rcpf(e + 1.f); }

template <class Tp> __device__ __forceinline__ Tp* uni(Tp* p) { const unsigned long long v = (unsigned long long)p; const unsigned lo = __builtin_amdgcn_readfirstlane((unsigned)v), hi = __builtin_amdgcn_readfirstlane((unsigned)(v >> 32)); return (Tp*)(((unsigned long long)hi << 32) | lo); }
struct Frame {
    LAS unsigned char* lds; volatile LAS unsigned* MISC; gu32* ctl;
    int tid, lane, wave, vcu, G;
    const float* const* in; float* out; unsigned char* ws;
};

__device__ __forceinline__ void tr_item(const float* W, int ldn, int k0, int n0, bf16_t* WT, int ldk, int drow0, int dk0, const float* kscale, LAS float* scr, int lane) {
#pragma unroll 8
    for (int i = 0; i < 32; ++i) { const int kk = 2 * i + (lane >> 5); float v = W[(size_t)(k0 + kk) * ldn + n0 + (lane & 31)]; if (kscale) v *= kscale[k0 + kk]; scr[kk * 33 + (lane & 31)] = v; }
    LDS_WAIT(); asm volatile("" ::: "memory");
    const int c = lane & 7;
#pragma unroll
    for (int j = 0; j < 4; ++j) { const int n = (lane >> 3) + 8 * j; const LAS float* s = scr + (8 * c) * 33 + n;
        v4u o; o.x = pk2(s[0 * 33], s[1 * 33]); o.y = pk2(s[2 * 33], s[3 * 33]); o.z = pk2(s[4 * 33], s[5 * 33]); o.w = pk2(s[6 * 33], s[7 * 33]);
        *(GAS v4u*)(WT + (size_t)(drow0 + n) * ldk + dk0 + k0 + 8 * c) = o; }
    LDS_WAIT(); asm volatile("" ::: "memory");
}
enum RowMap { RM_PLAIN = 0, RM_HEAD = 1, RM_GU_GATE = 2, RM_GU_UP = 3 };
__device__ __forceinline__ int map_row(int mode, int n0) {
    if (mode == RM_HEAD) { const int pn = n0 >> 8, r = n0 & 255, wc = r >> 6, bj = (r >> 5) & 1; return (pn << 8) + bj * 128 + wc * 32; }
    if (mode == RM_GU_GATE) return ((n0 >> 7) << 8) + (n0 & 127);
    if (mode == RM_GU_UP) return ((n0 >> 7) << 8) + 128 + (n0 & 127);
    return n0;
}
struct TrJob { const float* W; int ldn, K, N, ncol0; bf16_t* WT; int ldk, drow_off, dk0, mode; const float* kscale; };
__device__ __forceinline__ void tr_job_item(const TrJob& j, int item, LAS float* scr, int lane) {
    const int nblk = j.N / 32, kb = item / nblk, nb = item % nblk;
    tr_item(j.W, j.ldn, 64 * kb, j.ncol0 + 32 * nb, j.WT, j.ldk, j.drow_off + map_row(j.mode, 32 * nb), j.dk0, j.kscale, scr, lane);
}

__device__ __forceinline__ void p0_prologue(Frame& F, bool do_experts) {
    const int gw = F.vcu * NWAVES + F.wave, NGW = F.G * NWAVES;
    unsigned char* ws = F.ws;
    {
        LAS float* sc = (LAS float*)(F.lds);
        LAS float* red = (LAS float*)(F.lds + 16384);
        for (int i = F.tid; i < NB * D; i += NTHR) sc[i] = siluf(F.in[1][i]);
        __syncthreads();
        for (int task = blockIdx.x; task < 2 * 96; task += F.G) {
            const int l = task / 96, n0 = (task % 96) * 64;
            const float* W = F.in[2] + ((size_t)l * D + F.wave * 128) * (6 * D) + n0 + F.lane;
            float a0 = 0.f, a1 = 0.f, a2 = 0.f, a3 = 0.f;
#pragma unroll 16
            for (int k = 0; k < 128; ++k) { const float w = W[(size_t)k * (6 * D)]; const int kk = F.wave * 128 + k; a0 += sc[kk] * w; a1 += sc[D + kk] * w; a2 += sc[2 * D + kk] * w; a3 += sc[3 * D + kk] * w; }
            red[(F.wave * 4 + 0) * 64 + F.lane] = a0; red[(F.wave * 4 + 1) * 64 + F.lane] = a1; red[(F.wave * 4 + 2) * 64 + F.lane] = a2; red[(F.wave * 4 + 3) * 64 + F.lane] = a3;
            __syncthreads();
            if (F.tid < 256) { const int b = F.tid >> 6, ln = F.tid & 63; float s = F.in[3][l * 6 * D + n0 + ln];
#pragma unroll
                for (int w = 0; w < 8; ++w) s += red[(w * 4 + b) * 64 + ln];
                ((float*)(ws + WS_MOD))[(size_t)(l * NB + b) * 6 * D + n0 + ln] = s; }
            __syncthreads();
        }
        __syncthreads();
    }
    {
        bf16_t* B2 = (bf16_t*)(ws + WS_B2T);
        const int gt = F.vcu * NTHR + F.tid, NGT = F.G * NTHR;
        for (int idx = gt; idx < 3072 * 256; idx += NGT) { const int n = idx >> 8, k = idx & 255, seg = n >> 10, nn = n & 1023; float v = 0.f;
            if (seg == 0 && k < 64) v = F.in[11][(size_t)k * D + nn]; else if (seg == 1 && k >= 64 && k < 128) v = F.in[14][(size_t)(k - 64) * D + nn]; else if (seg == 2 && k >= 128) v = F.in[16][(size_t)(k - 128) * D + nn];
            B2[idx] = (bf16_t)f2bf(v); }
    }
    LAS float* scr = (LAS float*)(F.lds + F.wave * 16384);
    constexpr int NJ = 30;
    int cum = 0;
#define TRJ(W_, ldn_, K_, N_, ncol0_, WT_, ldk_, drow_, dk0_, mode_, ks_) { const TrJob j{W_, ldn_, K_, N_, ncol0_, (bf16_t*)(ws + (WT_)), ldk_, drow_, dk0_, mode_, ks_}; const int ni = (K_ / 64) * (N_ / 32); \
        for (int it = gw; it < ni; it += NGW) tr_job_item(j, it, scr, F.lane); }
    TRJ(F.in[7], D, D, D, 0, WS_WRKV, D, 0, 0, RM_PLAIN, nullptr)
    TRJ(F.in[7] + (size_t)D * D, D, D, D, 0, WS_WRKV, D, 1024, 0, RM_PLAIN, nullptr)
    TRJ(F.in[7] + 2 * (size_t)D * D, D, D, D, 0, WS_WRKV, D, 2048, 0, RM_PLAIN, nullptr)
    TRJ(F.in[10], 64, D, 64, 0, WS_B1T, 2048, 0, 0, RM_PLAIN, nullptr)
    TRJ(F.in[10], 64, D, 64, 0, WS_B1T, 2048, 0, 1024, RM_PLAIN, F.in[6] + 1 * D)
    TRJ(F.in[13], 64, D, 64, 0, WS_B1T, 2048, 64, 0, RM_PLAIN, nullptr)
    TRJ(F.in[13], 64, D, 64, 0, WS_B1T, 2048, 64, 1024, RM_PLAIN, F.in[6] + 4 * D)
    TRJ(F.in[15], 128, D, 128, 0, WS_B1T, 2048, 128, 0, RM_PLAIN, nullptr)
    TRJ(F.in[15], 128, D, 128, 0, WS_B1T, 2048, 128, 1024, RM_PLAIN, F.in[6] + 5 * D)
    TRJ(F.in[8], D, D, D, 0, WS_WO0, D, 0, 0, RM_PLAIN, nullptr)
    TRJ(F.in[27], D, D, D, 0, WS_WO1, D, 0, 0, RM_PLAIN, nullptr)
    TRJ(F.in[28], NE, D, NE, 0, WS_RT0, D, 0, 0, RM_PLAIN, nullptr)
    TRJ(F.in[28] + (size_t)D * NE, NE, D, NE, 0, WS_RT1, D, 0, 0, RM_PLAIN, nullptr)
    TRJ(F.in[33], FX, D, FX, 0, WS_SGU0, D, 0, 0, RM_GU_GATE, nullptr)
    TRJ(F.in[34], FX, D, FX, 0, WS_SGU0, D, 0, 0, RM_GU_UP, nullptr)
    TRJ(F.in[33] + (size_t)D * FX, FX, D, FX, 0, WS_SGU1, D, 0, 0, RM_GU_GATE, nullptr)
    TRJ(F.in[34] + (size_t)D * FX, FX, D, FX, 0, WS_SGU1, D, 0, 0, RM_GU_UP, nullptr)
    TRJ(F.in[35], D, FX, D, 0, WS_SD0, FX, 0, 0, RM_PLAIN, nullptr)
    TRJ(F.in[35] + (size_t)FX * D, D, FX, D, 0, WS_SD1, FX, 0, 0, RM_PLAIN, nullptr)
    TRJ(F.in[22], 2 * D + H, D, D, 0, WS_KVT, D, 0, 0, RM_HEAD, nullptr)
    TRJ(F.in[22], 2 * D + H, D, D, D, WS_KVT, D, 1024, 0, RM_PLAIN, nullptr)
    TRJ(F.in[25], 2 * D, D, D, 0, WS_QGT, D, 0, 0, RM_HEAD, nullptr)
    TRJ(F.in[25], 2 * D, D, D, D, WS_QGT, D, 1024, 0, RM_PLAIN, nullptr)
    (void)cum; (void)NJ;
    if (do_experts) {
        const int NIT = 2 * NE * 384;
        for (int it = gw; it < NIT; it += NGW) {
            const int le = it / 384, r = it % 384, l = le >> 8, e = le & 255;
            if (r < 256) { const bool up = r >= 128; const float* W = F.in[up ? 31 : 30] + ((size_t)l * NE + e) * D * FX;
                const TrJob j{W, FX, D, FX, 0, (bf16_t*)(ws + WS_EGU + (size_t)l * EGU_L) + (size_t)e * 512 * 1024, D, 0, 0, up ? RM_GU_UP : RM_GU_GATE, nullptr}; tr_job_item(j, r & 127, scr, F.lane); }
            else { const float* W = F.in[32] + ((size_t)l * NE + e) * FX * D;
                const TrJob j{W, D, FX, D, 0, (bf16_t*)(ws + WS_ED + (size_t)l * ED_L) + (size_t)e * 1024 * 256, FX, 0, 0, RM_PLAIN, nullptr}; tr_job_item(j, r - 256, scr, F.lane); }
        }
    }
#undef TRJ
}

__device__ __forceinline__ void p1_mix(Frame& F) {
    const int gw = F.vcu * NWAVES + F.wave;
    const float* x = F.in[0]; const float* mu = F.in[6];
    bf16_t* XR = (bf16_t*)(F.ws + WS_XR); bf16_t* XK = (bf16_t*)(F.ws + WS_XK); bf16_t* XV = (bf16_t*)(F.ws + WS_XV); bf16_t* HX = (bf16_t*)(F.ws + WS_HX);
    for (int chunk = gw; chunk < M / 16; chunk += F.G * NWAVES) {
        const int row0 = chunk * 16, b = row0 / T, t0 = row0 % T;
        const float* mod = (const float*)(F.ws + WS_MOD) + (size_t)(0 * NB + b) * 6 * D;
        f32x4 sh[4], sc[4], mr[4], mk[4], mv[4], hp[4];
#pragma unroll
        for (int j = 0; j < 4; ++j) { const int c = 4 * F.lane + 256 * j; sh[j] = *(const f32x4*)(mod + c); sc[j] = *(const f32x4*)(mod + D + c) + 1.f;
            mr[j] = *(const f32x4*)(mu + 0 * D + c); mk[j] = *(const f32x4*)(mu + 2 * D + c); mv[j] = *(const f32x4*)(mu + 3 * D + c); }
#pragma unroll
        for (int j = 0; j < 4; ++j) { if (t0 == 0) hp[j] = (f32x4){0.f, 0.f, 0.f, 0.f}; else { const f32x4 xp = *(const f32x4*)(x + (size_t)(row0 - 1) * D + 4 * F.lane + 256 * j); hp[j] = xp * sc[j] + sh[j]; } }
        for (int r = 0; r < 16; ++r) { const size_t row = row0 + r;
#pragma unroll
            for (int j = 0; j < 4; ++j) { const int c = 4 * F.lane + 256 * j; const f32x4 xv = *(const f32x4*)(x + row * D + c); const f32x4 h = xv * sc[j] + sh[j]; const f32x4 xx = hp[j] - h; hp[j] = h;
                const f32x4 a = h + xx * mr[j], bq = h + xx * mk[j], cq = h + xx * mv[j];
                typedef unsigned u32x2 __attribute__((ext_vector_type(2)));
                *(u32x2*)(XR + row * D + c) = (u32x2){pk2(a[0], a[1]), pk2(a[2], a[3])};
                *(u32x2*)(XK + row * D + c) = (u32x2){pk2(bq[0], bq[1]), pk2(bq[2], bq[3])};
                *(u32x2*)(XV + row * D + c) = (u32x2){pk2(cq[0], cq[1]), pk2(cq[2], cq[3])};
                *(u32x2*)(HX + row * 2 * D + c) = (u32x2){pk2(h[0], h[1]), pk2(h[2], h[3])};
                *(u32x2*)(HX + row * 2 * D + D + c) = (u32x2){pk2(xx[0], xx[1]), pk2(xx[2], xx[3])}; }
        }
    }
}

struct EpiL1 {
    static constexpr bool PERM = true, AFTER_DRAIN = false;
    bf16_t* O;
    __device__ __forceinline__ void operator()(const f32x4 (&acc)[2][2][4][2], const Unit& u, int wr, int wc, int fr, int fq) const {
        const int row0 = u.pm * BM + wr * 64 + fr, col0 = wc * 32 + 8 * fq;
#pragma unroll
        for (int ai = 0; ai < 2; ++ai)
#pragma unroll
            for (int m = 0; m < 4; ++m) { bf16_t* rowp = O + (size_t)(row0 + ai * HALF + m * 16) * 256 + col0;
#pragma unroll
                for (int bj = 0; bj < 2; ++bj) { f32x4 v0 = acc[ai][bj][m][0], v1 = acc[ai][bj][m][1];
                    if (bj == 1) { for (int i = 0; i < 4; ++i) { v0[i] = sigm(v0[i]); v1[i] = sigm(v1[i]); } }
                    else if (wc < 2) { for (int i = 0; i < 4; ++i) { v0[i] = tanh_(v0[i]); v1[i] = tanh_(v1[i]); } }
                    u32x4 w; w.x = pg8::cvt_pk_bf16(v0[0], v0[1]); w.y = pg8::cvt_pk_bf16(v0[2], v0[3]); w.z = pg8::cvt_pk_bf16(v1[0], v1[1]); w.w = pg8::cvt_pk_bf16(v1[2], v1[3]);
                    *(u32x4*)(rowp + bj * HALF) = w; } }
    }
};
struct EpiL2 {
    static constexpr bool PERM = false, AFTER_DRAIN = false;
    float* LW; bf16_t* A_; bf16_t* G_; const float* w0; const float* a0; float* RAW;
    __device__ __forceinline__ void operator()(const f32x4 (&acc)[2][2][4][2], const Unit& u, int wr, int wc, int fr, int fq) const {
        typedef unsigned u32x2 __attribute__((ext_vector_type(2)));
        const int seg = u.pn >> 2, row0 = u.pm * BM + wr * 64 + fr, colt = (u.pn & 3) * BM + wc * 32 + 4 * fq;
#pragma unroll
        for (int bj = 0; bj < 2; ++bj)
#pragma unroll
            for (int n = 0; n < 2; ++n) { const int col = colt + bj * HALF + n * 16;
                f32x4 bv = (f32x4){0.f, 0.f, 0.f, 0.f}; if (seg == 0) bv = *(const f32x4*)(w0 + col); else if (seg == 1) bv = *(const f32x4*)(a0 + col);
#pragma unroll
                for (int ai = 0; ai < 2; ++ai)
#pragma unroll
                    for (int m = 0; m < 4; ++m) { const size_t off = (size_t)(row0 + ai * HALF + m * 16) * D + col; f32x4 v = acc[ai][bj][m][n] + bv;
#ifdef FK_DBG_RAW
                        *(f32x4*)(RAW + (size_t)(row0 + ai * HALF + m * 16) * 3072 + seg * 1024 + col) = acc[ai][bj][m][n];
#endif
                        if (seg == 0) { f32x4 o; for (int i = 0; i < 4; ++i) o[i] = -__expf(-softplus_(-v[i]) - 0.5f); *(f32x4*)(LW + off) = o; }
                        else if (seg == 1) { *(u32x2*)(A_ + off) = (u32x2){pg8::cvt_pk_bf16(sigm(v[0]), sigm(v[1])), pg8::cvt_pk_bf16(sigm(v[2]), sigm(v[3]))}; }
                        else { *(u32x2*)(G_ + off) = (u32x2){pg8::cvt_pk_bf16(v[0], v[1]), pg8::cvt_pk_bf16(v[2], v[3])}; } }
                asm volatile("" ::: "memory"); }
    }
};
}
namespace fk {
typedef short s16x4 __attribute__((ext_vector_type(4)));
typedef float f32x16 __attribute__((ext_vector_type(16)));
typedef unsigned u32x2 __attribute__((ext_vector_type(2)));
constexpr int TP = 144;
constexpr int TSZ = 64 * TP;
constexpr int L_A = 0 * TSZ, L_At = 1 * TSZ, L_B = 2 * TSZ, L_Bpt = 3 * TSZ, L_K = 4 * TSZ, L_Kpt = 5 * TSZ, L_R = 6 * TSZ, L_Vt = 7 * TSZ, L_L = 8 * TSZ, L_Mak = 9 * TSZ,
              L_Mrb = 10 * TSZ, L_Mrk = 11 * TSZ, L_W1t = 12 * TSZ, L_Di = 13 * TSZ, L_Att = L_A, L_Vtt = L_Mak;
constexpr int L_CTOT = 132096, L_WC = L_CTOT + 2048;
static_assert(14 * TSZ <= 131072 && L_WC + 256 <= LDS_BYTES, "P5 LDS map");

__device__ __forceinline__ float bf2f(unsigned short h) { return __uint_as_float((unsigned)h << 16); }
__device__ __forceinline__ int crow(int r, int hi) { return (r & 3) + 8 * (r >> 2) + 4 * hi; }
__device__ __forceinline__ int fr_off(int row, int k0) { const int rb = row >> 4, l15 = row & 15, s = k0 >> 5, kk = k0 & 31, half = kk >> 4, q = (kk & 15) >> 2; return (((rb * 2 + s) * 64 + q * 16 + l15) * 16) + half * 8; }

__device__ __forceinline__ void prod_half(f32x16 (&acc)[2], const LAS unsigned char* U, const LAS unsigned char* W, int ph, int l31, int hi) {
#pragma unroll
    for (int ks = 0; ks < 4; ++ks) {
        const bf16x8 uf = *(const LAS bf16x8*)(U + (32 * ph + l31) * TP + ks * 32 + hi * 16);
#pragma unroll
        for (int xb = 0; xb < 2; ++xb) { const bf16x8 wf = *(const LAS bf16x8*)(W + (32 * xb + l31) * TP + ks * 32 + hi * 16);
            acc[xb] = __builtin_amdgcn_mfma_f32_32x32x16_bf16(wf, uf, acc[xb], 0, 0, 0); }
    }
}
template <int MASK> __device__ __forceinline__ void st_half_lds(const f32x16 (&acc)[2], LAS unsigned char* Z, int ph, int l31, int hi) {
    const int p = 32 * ph + l31;
#pragma unroll
    for (int xb = 0; xb < 2; ++xb)
#pragma unroll
        for (int g = 0; g < 4; ++g) { const int q0 = 32 * xb + 8 * g + 4 * hi; float v[4];
#pragma unroll
            for (int x = 0; x < 4; ++x) { v[x] = acc[xb][4 * g + x]; if (MASK == 1 && !(q0 + x < p)) v[x] = 0.f; if (MASK == 2 && !(q0 + x <= p)) v[x] = 0.f; }
            *(LAS u32x2*)(Z + p * TP + q0 * 2) = (u32x2){pg8::cvt_pk_bf16(v[0], v[1]), pg8::cvt_pk_bf16(v[2], v[3])}; }
}

__device__ __forceinline__ void p5_unit(Frame& F, int unit) {
    const int c = unit & 127, bh = unit >> 7, h = bh & 15, b = bh >> 4;
    const size_t row0 = (size_t)b * T + c * 64; const int col0 = h * 64;
    const int lane = F.lane, w = F.wave, l31 = lane & 31, hi = lane >> 5;
    LAS unsigned char* lds = F.lds;
    unsigned char* ws = F.ws;
    const bf16_t* Rg = (const bf16_t*)(ws + WS_R); const bf16_t* Kg = (const bf16_t*)(ws + WS_K); const bf16_t* Vg = (const bf16_t*)(ws + WS_V); const bf16_t* Ag = (const bf16_t*)(ws + WS_A);
    const float* LWg = (const float*)(ws + WS_LW);
    {
        const int d = lane;
        unsigned short rr[8], kr[8], vr[8], ar[8]; float lw[8];
#pragma unroll
        for (int i = 0; i < 8; ++i) { const size_t idx = (row0 + 8 * w + i) * D + col0 + d; rr[i] = Rg[idx]; kr[i] = Kg[idx]; vr[i] = Vg[idx]; ar[i] = Ag[idx]; lw[i] = LWg[idx]; }
        const float kkv = F.in[17][col0 + d], kav = F.in[18][col0 + d], rkv = F.in[19][col0 + d];
        float cl[8]; float run = 0.f;
#pragma unroll
        for (int i = 0; i < 8; ++i) { run += lw[i]; cl[i] = run; }
        LAS float* ctot = (LAS float*)(lds + L_CTOT);
        ctot[w * 64 + d] = run;
        __syncthreads();
        float base = 0.f, total = 0.f;
#pragma unroll
        for (int q = 0; q < 8; ++q) { const float x = ctot[q * 64 + d]; total += x; if (q < w) base += x; }
        unsigned short at8[8], bp8[8], kp8[8];
#pragma unroll
        for (int i = 0; i < 8; ++i) { const int t = 8 * w + i;
            const float k = bf2f(kr[i]), a = bf2f(ar[i]), r = bf2f(rr[i]);
            float kkn = k * kkv; const float ss = wave_sum(kkn * kkn); kkn *= rsqrtf(fmaxf(ss, 1e-24f));
            const float kp = k * (1.f + (a - 1.f) * kav), bv = kkn * a, av = -kkn;
            const float bon = wave_sum(r * kp * rkv); if (lane == 0) ((float*)(ws + WS_BONUS))[(row0 + t) * 16 + h] = bon;
            const float cum = base + cl[i], cump = cum - lw[i];
            const float ea = __expf(cump), eb = __expf(-cum), ec = __expf(total - cum), er = __expf(cum);
            const unsigned short Ah = (unsigned short)f2bf(av * ea), Bh = (unsigned short)f2bf(bv * eb), Kh = (unsigned short)f2bf(kp * eb), Rh = (unsigned short)f2bf(r * er);
            *(LAS unsigned short*)(lds + L_A + t * TP + d * 2) = Ah; *(LAS unsigned short*)(lds + L_B + t * TP + d * 2) = Bh;
            *(LAS unsigned short*)(lds + L_K + t * TP + d * 2) = Kh; *(LAS unsigned short*)(lds + L_R + t * TP + d * 2) = Rh;
            at8[i] = Ah; bp8[i] = (unsigned short)f2bf(bv * ec); kp8[i] = (unsigned short)f2bf(kp * ec); }
#define PK8(a_) (v4u){(unsigned)a_[0] | ((unsigned)a_[1] << 16), (unsigned)a_[2] | ((unsigned)a_[3] << 16), (unsigned)a_[4] | ((unsigned)a_[5] << 16), (unsigned)a_[6] | ((unsigned)a_[7] << 16)}
        *(LAS v4u*)(lds + L_At + d * TP + 16 * w) = PK8(at8); *(LAS v4u*)(lds + L_Bpt + d * TP + 16 * w) = PK8(bp8);
        *(LAS v4u*)(lds + L_Kpt + d * TP + 16 * w) = PK8(kp8); *(LAS v4u*)(lds + L_Vt + d * TP + 16 * w) = PK8(vr);
#undef PK8
        if (w == 0) ((LAS float*)(lds + L_WC))[d] = __expf(total);
        __syncthreads();
    }
    {
        const int pid = w >> 1, ph = w & 1;
        f32x16 acc[2]; acc[0] = f32x16{}; acc[1] = f32x16{};
        prod_half(acc, lds + ((pid < 2) ? L_A : L_R), lds + ((pid & 1) ? L_K : L_B), ph, l31, hi);
        if (pid == 0) st_half_lds<1>(acc, lds + L_L, ph, l31, hi); else if (pid == 1) st_half_lds<1>(acc, lds + L_Mak, ph, l31, hi);
        else if (pid == 2) st_half_lds<2>(acc, lds + L_Mrb, ph, l31, hi); else st_half_lds<2>(acc, lds + L_Mrk, ph, l31, hi);
        __syncthreads();
    }
    {
        if (w == 0) {
            const int blk = lane >> 4, j = lane & 15; float tc[16];
#pragma unroll
            for (int t = 0; t < 16; ++t) { const v4u a0 = *(const LAS v4u*)(lds + L_L + (16 * blk + t) * TP + 32 * blk), a1 = *(const LAS v4u*)(lds + L_L + (16 * blk + t) * TP + 32 * blk + 16);
                const unsigned wds[8] = {a0.x, a0.y, a0.z, a0.w, a1.x, a1.y, a1.z, a1.w}; float s = (t == j) ? 1.f : 0.f;
#pragma unroll
                for (int i = 0; i < t; ++i) { const float lv = __uint_as_float((i & 1) ? (wds[i >> 1] & 0xffff0000u) : (wds[i >> 1] << 16)); s += lv * tc[i]; }
                tc[t] = s; *(LAS unsigned short*)(lds + L_Di + (16 * blk + t) * TP + j * 2) = (unsigned short)f2bf(s); }
        } else if (w == 2 || w == 3) {
            f32x16 acc[2]; acc[0] = f32x16{}; acc[1] = f32x16{};
            prod_half(acc, lds + L_Vt, lds + L_Mak, w & 1, l31, hi);
            st_half_lds<0>(acc, lds + L_W1t, w & 1, l31, hi);
        }
        __syncthreads();
    }
    {
        const int l15 = lane & 15, q = lane >> 4, n0 = 16 * (w & 3);
        const LAS unsigned char* rhs = lds + ((w < 4) ? L_At : L_W1t); LAS unsigned char* out = lds + ((w < 4) ? L_Att : L_Vtt);
        f32x4 accX[4]; s16x4 xb16[4];
#pragma unroll
        for (int bi = 0; bi < 4; ++bi) {
            const u32x2 rw = *(const LAS u32x2*)(rhs + (n0 + l15) * TP + (16 * bi + 4 * q) * 2);
            f32x4 acc = (f32x4){__uint_as_float(rw.x << 16), __uint_as_float(rw.x & 0xffff0000u), __uint_as_float(rw.y << 16), __uint_as_float(rw.y & 0xffff0000u)};
#pragma unroll
            for (int bk = 0; bk < bi; ++bk) { const s16x4 lf = *(const LAS s16x4*)(lds + L_L + (16 * bi + l15) * TP + (16 * bk + 4 * q) * 2);
                acc = __builtin_amdgcn_mfma_f32_16x16x16bf16_1k(lf, xb16[bk], acc, 0, 0, 0); }
            const u32x2 pa = (u32x2){pg8::cvt_pk_bf16(acc[0], acc[1]), pg8::cvt_pk_bf16(acc[2], acc[3])};
            const s16x4 df = *(const LAS s16x4*)(lds + L_Di + (16 * bi + l15) * TP + (4 * q) * 2);
            accX[bi] = __builtin_amdgcn_mfma_f32_16x16x16bf16_1k(df, __builtin_bit_cast(s16x4, pa), (f32x4){0.f, 0.f, 0.f, 0.f}, 0, 0, 0);
            const u32x2 px = (u32x2){pg8::cvt_pk_bf16(accX[bi][0], accX[bi][1]), pg8::cvt_pk_bf16(accX[bi][2], accX[bi][3])};
            xb16[bi] = __builtin_bit_cast(s16x4, px);
        }
        __syncthreads();
#pragma unroll
        for (int bi = 0; bi < 4; ++bi) *(LAS s16x4*)(out + (n0 + l15) * TP + (16 * bi + 4 * q) * 2) = xb16[bi];
        __syncthreads();
    }
    {
        const int task = w >> 1, ph = w & 1, p = 32 * ph + l31;
        f32x16 acc[2]; acc[0] = f32x16{}; acc[1] = f32x16{};
        if (task == 0) { prod_half(acc, lds + L_Mrb, lds + L_Att, ph, l31, hi); }
        else if (task == 1) { prod_half(acc, lds + L_Bpt, lds + L_Att, ph, l31, hi); }
        else if (task == 2) { prod_half(acc, lds + L_Mrb, lds + L_Vtt, ph, l31, hi); prod_half(acc, lds + L_Mrk, lds + L_Vt, ph, l31, hi); }
        else { prod_half(acc, lds + L_Vtt, lds + L_Bpt, ph, l31, hi); prod_half(acc, lds + L_Vt, lds + L_Kpt, ph, l31, hi); }
        unsigned char* gout = ws + ((task == 0) ? WS_RTL : (task == 1) ? WS_PT : (task == 2) ? WS_YL : WS_Q) + (size_t)unit * 8192;
        const float wc = (task == 1) ? ((const LAS float*)(lds + L_WC))[p] : 0.f;
#pragma unroll
        for (int xb = 0; xb < 2; ++xb)
#pragma unroll
            for (int g = 0; g < 4; ++g) { const int q0 = 32 * xb + 8 * g + 4 * hi; float v[4];
#pragma unroll
                for (int x = 0; x < 4; ++x) v[x] = acc[xb][4 * g + x];
                if (task == 0) { const u32x2 rw = *(const LAS u32x2*)(lds + L_R + p * TP + q0 * 2); v[0] += __uint_as_float(rw.x << 16); v[1] += __uint_as_float(rw.x & 0xffff0000u); v[2] += __uint_as_float(rw.y << 16); v[3] += __uint_as_float(rw.y & 0xffff0000u); }
                if (task == 1) {
#pragma unroll
                    for (int x = 0; x < 4; ++x) if (q0 + x == p) v[x] += wc; }
                const u32x2 o = (u32x2){pg8::cvt_pk_bf16(v[0], v[1]), pg8::cvt_pk_bf16(v[2], v[3])};
                const int off = (task < 2) ? fr_off(p, q0) : (p * 128 + q0 * 2);
                *(u32x2*)(gout + off) = o; }
        __syncthreads();
    }
}
__device__ __forceinline__ void p5_phase(Frame& F) {
    for (int unit = F.vcu; unit < NB * H * 128; unit += F.G) p5_unit(F, unit);
}

__device__ __forceinline__ void p6_phase(Frame& F) {
    if (F.wave != 0) return;
    for (int task = F.vcu; task < NB * H * 4; task += F.G) {
        const int vq = task & 3, bh = task >> 2, h = bh & 15, b = bh >> 4;
        const int lane = F.lane, l15 = lane & 15, q = lane >> 4;
        unsigned char* ws = F.ws;
        f32x4 accS[4];
#pragma unroll
        for (int kb = 0; kb < 4; ++kb) accS[kb] = (f32x4){0.f, 0.f, 0.f, 0.f};
        const size_t ubase = (size_t)bh * 128;
        bf16x8 Pf[8], Rf[8]; u32x2 Qi[4], Yi[4];
#define P6_LOAD(cc) do { const size_t uo = (ubase + (cc)) * 8192; \
        _Pragma("unroll") for (int f = 0; f < 8; ++f) { Pf[f] = *(const bf16x8*)(ws + WS_PT + uo + (f * 64 + lane) * 16); Rf[f] = *(const bf16x8*)(ws + WS_RTL + uo + (f * 64 + lane) * 16); } \
        _Pragma("unroll") for (int kb = 0; kb < 4; ++kb) { Qi[kb] = *(const u32x2*)(ws + WS_Q + uo + (16 * vq + l15) * 128 + (16 * kb + 4 * q) * 2); Yi[kb] = *(const u32x2*)(ws + WS_YL + uo + (16 * kb + l15) * 128 + (16 * vq + 4 * q) * 2); } } while (0)
        P6_LOAD(0);
        for (int c = 0; c < 128; ++c) {
            bf16x8 Sf[2];
#pragma unroll
            for (int s = 0; s < 2; ++s) { u32x4 t; t.x = pg8::cvt_pk_bf16(accS[2 * s][0], accS[2 * s][1]); t.y = pg8::cvt_pk_bf16(accS[2 * s][2], accS[2 * s][3]);
                t.z = pg8::cvt_pk_bf16(accS[2 * s + 1][0], accS[2 * s + 1][1]); t.w = pg8::cvt_pk_bf16(accS[2 * s + 1][2], accS[2 * s + 1][3]); Sf[s] = __builtin_bit_cast(bf16x8, t); }
            f32x4 accY[4], accN[4];
#pragma unroll
            for (int tb = 0; tb < 4; ++tb) { accY[tb] = (f32x4){__uint_as_float(Yi[tb].x << 16), __uint_as_float(Yi[tb].x & 0xffff0000u), __uint_as_float(Yi[tb].y << 16), __uint_as_float(Yi[tb].y & 0xffff0000u)};
                accN[tb] = (f32x4){__uint_as_float(Qi[tb].x << 16), __uint_as_float(Qi[tb].x & 0xffff0000u), __uint_as_float(Qi[tb].y << 16), __uint_as_float(Qi[tb].y & 0xffff0000u)}; }
#pragma unroll
            for (int s = 0; s < 2; ++s)
#pragma unroll
                for (int tb = 0; tb < 4; ++tb) { accN[tb] = __builtin_amdgcn_mfma_f32_16x16x32_bf16(Pf[tb * 2 + s], Sf[s], accN[tb], 0, 0, 0);
                    accY[tb] = __builtin_amdgcn_mfma_f32_16x16x32_bf16(Sf[s], Rf[tb * 2 + s], accY[tb], 0, 0, 0); }
            if (c + 1 < 128) P6_LOAD(c + 1);
            const size_t row0 = (size_t)b * T + c * 64;
#pragma unroll
            for (int tb = 0; tb < 4; ++tb) { accS[tb] = accN[tb];
                *(u32x2*)(ws + WS_Y + ((row0 + 16 * tb + l15) * D + h * 64 + 16 * vq + 4 * q) * 2) = (u32x2){pg8::cvt_pk_bf16(accY[tb][0], accY[tb][1]), pg8::cvt_pk_bf16(accY[tb][2], accY[tb][3])}; }
        }
#undef P6_LOAD
    }
}

__device__ __forceinline__ void p6b_phase(Frame& F) {
    const int gw = F.vcu * NWAVES + F.wave, lane = F.lane; unsigned char* ws = F.ws;
    const int cb = 16 * lane, h = lane >> 2;
    float lg[16], lb[16];
#pragma unroll
    for (int i = 0; i < 16; ++i) { lg[i] = F.in[20][cb + i]; lb[i] = F.in[21][cb + i]; }
    for (int row = gw; row < M; row += F.G * NWAVES) {
        const size_t o = (size_t)row * D + cb;
        const u32x4 y0 = *(const u32x4*)(ws + WS_Y + o * 2), y1 = *(const u32x4*)(ws + WS_Y + o * 2 + 16);
        const u32x4 v0 = *(const u32x4*)(ws + WS_V + o * 2), v1 = *(const u32x4*)(ws + WS_V + o * 2 + 16);
        const u32x4 g0 = *(const u32x4*)(ws + WS_G + o * 2), g1 = *(const u32x4*)(ws + WS_G + o * 2 + 16);
        const float bon = ((const float*)(ws + WS_BONUS))[(size_t)row * 16 + h];
        const unsigned yw[8] = {y0.x, y0.y, y0.z, y0.w, y1.x, y1.y, y1.z, y1.w}, vw[8] = {v0.x, v0.y, v0.z, v0.w, v1.x, v1.y, v1.z, v1.w}, gwd[8] = {g0.x, g0.y, g0.z, g0.w, g1.x, g1.y, g1.z, g1.w};
        float y[16]; float s = 0.f;
#pragma unroll
        for (int i = 0; i < 8; ++i) { y[2 * i] = __uint_as_float(yw[i] << 16); y[2 * i + 1] = __uint_as_float(yw[i] & 0xffff0000u); s += y[2 * i] + y[2 * i + 1]; }
        s += __shfl_xor(s, 1); s += __shfl_xor(s, 2);
        const float mean = s * (1.f / 64.f); float qv = 0.f;
#pragma unroll
        for (int i = 0; i < 16; ++i) { y[i] -= mean; qv += y[i] * y[i]; }
        qv += __shfl_xor(qv, 1); qv += __shfl_xor(qv, 2);
        const float rstd = rsqrtf(qv * (1.f / 64.f) + 64e-5f);
        unsigned ow[8];
#pragma unroll
        for (int i = 0; i < 8; ++i) { const float va = __uint_as_float(vw[i] << 16), vb = __uint_as_float(vw[i] & 0xffff0000u), ga = __uint_as_float(gwd[i] << 16), gb = __uint_as_float(gwd[i] & 0xffff0000u);
            const float za = (y[2 * i] * rstd * lg[2 * i] + lb[2 * i] + bon * va) * ga, zb = (y[2 * i + 1] * rstd * lg[2 * i + 1] + lb[2 * i + 1] + bon * vb) * gb;
            ow[i] = pg8::cvt_pk_bf16(za, zb); }
        *(u32x4*)(ws + WS_Z + o * 2) = (u32x4){ow[0], ow[1], ow[2], ow[3]}; *(u32x4*)(ws + WS_Z + o * 2 + 16) = (u32x4){ow[4], ow[5], ow[6], ow[7]};
    }
}
}
namespace fk {
struct EpiPre {
    static constexpr bool PERM = false, AFTER_DRAIN = false;
    const float* res; const float* gate; float* out;
    __device__ __forceinline__ void operator()(const f32x4 (&acc)[2][2][4][2], const Unit& u, int wr, int wc, int fr, int fq) const {
        const int row0 = u.pm * BM + wr * 64 + fr, colt = u.pn * BM + wc * 32 + 4 * fq; const int b = (u.pm * BM) / T;
#pragma unroll
        for (int bj = 0; bj < 2; ++bj)
#pragma unroll
            for (int n = 0; n < 2; ++n) { const int col = colt + bj * HALF + n * 16; const f32x4 gv = *(const f32x4*)(gate + (size_t)b * 6 * D + col) + 1.f;
#pragma unroll
                for (int ai = 0; ai < 2; ++ai)
#pragma unroll
                    for (int m = 0; m < 4; ++m) { const size_t off = (size_t)(row0 + ai * HALF + m * 16) * D + col; const f32x4 rv = *(const f32x4*)(res + off);
                        *(f32x4*)(out + off) = rv * ALPHA + gv * acc[ai][bj][m][n]; }
                asm volatile("" ::: "memory"); }
    }
};
struct EpiF32 {
    static constexpr bool PERM = false, AFTER_DRAIN = false;
    float* out; int ldc;
    __device__ __forceinline__ void operator()(const f32x4 (&acc)[2][2][4][2], const Unit& u, int wr, int wc, int fr, int fq) const {
        const int row0 = u.pm * BM + wr * 64 + fr, colt = u.pn * BM + wc * 32 + 4 * fq;
#pragma unroll
        for (int ai = 0; ai < 2; ++ai)
#pragma unroll
            for (int m = 0; m < 4; ++m)
#pragma unroll
                for (int bj = 0; bj < 2; ++bj)
#pragma unroll
                    for (int n = 0; n < 2; ++n) *(f32x4*)(out + (size_t)(row0 + ai * HALF + m * 16) * ldc + colt + bj * HALF + n * 16) = acc[ai][bj][m][n];
    }
};

__device__ __forceinline__ void ln_mod_phase(Frame& F, int l) {
    const int gw = F.vcu * NWAVES + F.wave, lane = F.lane; unsigned char* ws = F.ws;
    const float* PRE = (const float*)(ws + WS_PRE); float* X1 = (float*)(ws + WS_X1); bf16_t* H2 = (bf16_t*)(ws + WS_H2);
    const float* lg = F.in[4] + (l * 2 + 0) * D; const float* lb = F.in[5] + (l * 2 + 0) * D;
    for (int row = gw; row < M; row += F.G * NWAVES) {
        const int b = row / T; const float* mod = (const float*)(ws + WS_MOD) + (size_t)(l * NB + b) * 6 * D;
        f32x4 v[4]; float s = 0.f;
#pragma unroll
        for (int j = 0; j < 4; ++j) { v[j] = *(const f32x4*)(PRE + (size_t)row * D + 4 * lane + 256 * j); s += (v[j][0] + v[j][1]) + (v[j][2] + v[j][3]); }
        const float mean = wave_sum(s) * (1.f / D); float q = 0.f;
#pragma unroll
        for (int j = 0; j < 4; ++j) { v[j] = v[j] - mean; q += (v[j][0] * v[j][0] + v[j][1] * v[j][1]) + (v[j][2] * v[j][2] + v[j][3] * v[j][3]); }
        const float rstd = rsqrtf(wave_sum(q) * (1.f / D) + LN_EPS);
#pragma unroll
        for (int j = 0; j < 4; ++j) { const int c = 4 * lane + 256 * j; const f32x4 x1 = v[j] * rstd * *(const f32x4*)(lg + c) + *(const f32x4*)(lb + c);
            *(f32x4*)(X1 + (size_t)row * D + c) = x1;
            const f32x4 h = x1 * (*(const f32x4*)(mod + 4 * D + c) + 1.f) + *(const f32x4*)(mod + 3 * D + c);
            *(u32x2*)(H2 + (size_t)row * D + c) = (u32x2){pk2(h[0], h[1]), pk2(h[2], h[3])}; }
    }
}

__device__ __forceinline__ void route_phase(Frame& F, int l) {
    const int lane = F.lane, w = F.wave; unsigned char* ws = F.ws; LAS unsigned char* lds = F.lds;
    LAS int* hist = (LAS int*)(lds);
    LAS int* basee = (LAS int*)(lds + 1024);
    LAS int* ent = (LAS int*)(lds + 2048);
    const float* logits = (const float*)(ws + WS_LOGITS); const float* rb = F.in[29] + l * NE;
    float* GWT = (float*)(ws + WS_GW); int* LIST = (int*)(ws + WS_LIST); gu32* cnt = F.ctl + CW_CNT + l * 256;
    const f32x4 bias = *(const f32x4*)(rb + 4 * lane);
    for (int blk = blockIdx.x; blk < M / 128; blk += F.G) {
        for (int i = F.tid; i < 256; i += NTHR) hist[i] = 0;
        __syncthreads();
        for (int it = 0; it < 16; ++it) {
            const int t = blk * 128 + w * 16 + it;
            const f32x4 lg = *(const f32x4*)(logits + (size_t)t * NE + 4 * lane);
            float s[4], c[4];
#pragma unroll
            for (int j = 0; j < 4; ++j) { s[j] = 1.f / (1.f + __expf(-lg[j])); c[j] = s[j] + bias[j]; }
            float m1 = fmaxf(c[0], c[1]), m2 = fminf(c[0], c[1]);
#pragma unroll
            for (int j = 2; j < 4; ++j) { const float x = c[j]; m2 = fmaxf(m2, fminf(m1, x)); m1 = fmaxf(m1, x); }
#pragma unroll
            for (int o = 1; o < 8; o <<= 1) { const float b1 = __shfl_xor(m1, o), b2 = __shfl_xor(m2, o); m2 = fmaxf(fminf(m1, b1), fmaxf(m2, b2)); m1 = fmaxf(m1, b1); }
            const float gs = m1 + m2; const int g = lane >> 3; int rank = 0;
#pragma unroll
            for (int g2 = 0; g2 < 8; ++g2) { const float o = __shfl(gs, 8 * g2); rank += (o > gs || (o == gs && g2 < g)) ? 1 : 0; }
            const bool sel = rank < 4;
#pragma unroll
            for (int j = 0; j < 4; ++j) if (!sel) c[j] = -INFINITY;
            int che[8]; float chs[8]; float ssum = 0.f;
#pragma unroll
            for (int k = 0; k < 8; ++k) {
                float bv = c[0]; int bi = 4 * lane;
#pragma unroll
                for (int j = 1; j < 4; ++j) if (c[j] > bv) { bv = c[j]; bi = 4 * lane + j; }
#pragma unroll
                for (int o = 1; o < 64; o <<= 1) { const float ov = __shfl_xor(bv, o); const int oi = __shfl_xor(bi, o); if (ov > bv || (ov == bv && oi < bi)) { bv = ov; bi = oi; } }
                float sv = 0.f;
#pragma unroll
                for (int j = 0; j < 4; ++j) if (bi == 4 * lane + j) { sv = s[j]; c[j] = -INFINITY; }
                sv = __shfl(sv, bi >> 2);
                che[k] = bi; chs[k] = sv; ssum += sv;
            }
            const float inv = 2.5f / ssum;
            if (lane < 8) { int e = che[0]; float sc = chs[0];
#pragma unroll
                for (int k = 1; k < 8; ++k) if (lane == k) { e = che[k]; sc = chs[k]; }
                const int lp = __hip_atomic_fetch_add(&hist[e], 1, __ATOMIC_RELAXED, __HIP_MEMORY_SCOPE_WORKGROUP);
                ent[(w * 16 + it) * 8 + lane] = (e << 16) | lp;
                GWT[(size_t)t * 8 + lane] = sc * inv; }
        }
        __syncthreads();
        if (F.tid < 256) { const int hc = hist[F.tid]; basee[F.tid] = hc ? (int)__hip_atomic_fetch_add(cnt + F.tid, (unsigned)hc, __ATOMIC_RELAXED, __HIP_MEMORY_SCOPE_AGENT) : 0; }
        __syncthreads();
        for (int i = F.tid; i < 1024; i += NTHR) { const int en = ent[i], e = en >> 16, lp = en & 0xffff; LIST[(size_t)e * M + basee[e] + lp] = (blk * 128 + (i >> 3)) * 8 + (i & 7); }
        __syncthreads();
    }
}
}
namespace fk {
constexpr int MOE_TAB = 132096, MOE_MAXP = 6;
constexpr int MOE_ROWS = MOE_TAB + 128;
static_assert(MOE_ROWS + MOE_MAXP * 2048 <= LDS_BYTES, "MoE LDS tables");
struct MoeUnit { int pm, pn, slot; };
struct MoeSched {
    typedef MoeUnit UnitT;
    LAS unsigned char* lds; int npairs, npn;
    const char* bexp; const char* bsh; size_t estride;
    unsigned a_base_r, a_base_s, a_rowbytes; int a_shift;
    __device__ __forceinline__ bool next(int i, MoeUnit& u) const { const int p = i / npn; if (p >= npairs) return false; u.slot = p; u.pn = i - p * npn; u.pm = 0; return true; }
    __device__ __forceinline__ int pair_e(int slot) const { return ((const LAS int*)(lds + MOE_TAB))[slot * 4 + 0]; }
    __device__ __forceinline__ const char* bbase(const MoeUnit& u) const { const int e = __builtin_amdgcn_readfirstlane(pair_e(u.slot)); return e == NE ? bsh : bexp + (size_t)e * estride; }
    __device__ __forceinline__ unsigned a_off(const MoeUnit& u, int r) const {
        const int v = ((const LAS int*)(lds + MOE_ROWS))[(u.slot * 256 + r) * 2]; const int e = pair_e(u.slot);
        if (v < 0) return (e == NE) ? a_base_s : a_base_r;
        return (e == NE) ? a_base_s + (unsigned)v * a_rowbytes : a_base_r + (unsigned)(v >> a_shift) * a_rowbytes; }
    __device__ __forceinline__ void a_ready(const MoeUnit&) const {}
    __device__ __forceinline__ void done(const MoeUnit&) const {}
};
__device__ __forceinline__ int moe_build(Frame& F, int l) {
    LAS unsigned char* lds = F.lds; LAS int* tiles = (LAS int*)(lds); LAS int* pref = (LAS int*)(lds + 1024); LAS int* cn = (LAS int*)(lds + 2048);
    LAS int* tab = (LAS int*)(lds + MOE_TAB); LAS int* rows = (LAS int*)(lds + MOE_ROWS);
    const gu32* cnt = F.ctl + CW_CNT + l * 256;
    if (F.tid < 256) { const int c = (int)__hip_atomic_load(cnt + F.tid, __ATOMIC_RELAXED, __HIP_MEMORY_SCOPE_AGENT); cn[F.tid] = c; tiles[F.tid] = (c + 255) >> 8; }
    __syncthreads();
    if (F.tid < 256) { int s = 0; for (int e = 0; e <= F.tid; ++e) s += tiles[e]; pref[F.tid] = s; }
    __syncthreads();
    const int Pr = pref[255], Ptot = Pr + 128;
    int np = 0;
    for (int p = F.vcu; p < Ptot && np < MOE_MAXP; p += F.G, ++np) {
        if (p < Pr) { if (F.tid < 256) { const int inc = pref[F.tid], exc = inc - tiles[F.tid]; if (exc <= p && p < inc) { tab[np * 4 + 0] = F.tid; tab[np * 4 + 1] = p - exc; } } }
        else if (F.tid == 0) { tab[np * 4 + 0] = NE; tab[np * 4 + 1] = p - Pr; }
    }
    __syncthreads();
    const int* LIST = (const int*)(F.ws + WS_LIST); const float* GWT = (const float*)(F.ws + WS_GW);
    for (int i = F.tid; i < np * 256; i += NTHR) { const int s = i >> 8, r = i & 255, e = tab[s * 4 + 0], mt = tab[s * 4 + 1]; int v; float gwv = 1.f;
        if (e == NE) v = mt * 256 + r; else { const int idx = mt * 256 + r; if (idx < cn[e]) { v = LIST[(size_t)e * M + idx]; gwv = GWT[v]; } else v = -1; }
        rows[i * 2] = v; rows[i * 2 + 1] = __float_as_int(gwv); }
    __syncthreads();
    return np;
}
struct EpiAct {
    static constexpr bool PERM = true, AFTER_DRAIN = false;
    LAS unsigned char* lds; bf16_t* ACT; bf16_t* ACTS;
    __device__ __forceinline__ void operator()(const f32x4 (&acc)[2][2][4][2], const MoeUnit& u, int wr, int wc, int fr, int fq) const {
        const LAS int* rows = (const LAS int*)(lds + MOE_ROWS) + u.slot * 512; const bool sh = ((const LAS int*)(lds + MOE_TAB))[u.slot * 4] == NE;
        bf16_t* base = sh ? ACTS : ACT; const int col = u.pn * 128 + wc * 32 + 8 * fq;
#pragma unroll
        for (int ai = 0; ai < 2; ++ai)
#pragma unroll
            for (int m = 0; m < 4; ++m) { const int r = ai * HALF + wr * 64 + m * 16 + fr; const int v = rows[r * 2]; if (v < 0) continue;
                float o[8];
#pragma unroll
                for (int n = 0; n < 2; ++n)
#pragma unroll
                    for (int i = 0; i < 4; ++i) { const float gq = acc[ai][0][m][n][i], uq = acc[ai][1][m][n][i]; o[n * 4 + i] = gq * sigm(gq) * uq; }
                u32x4 wv; wv.x = pg8::cvt_pk_bf16(o[0], o[1]); wv.y = pg8::cvt_pk_bf16(o[2], o[3]); wv.z = pg8::cvt_pk_bf16(o[4], o[5]); wv.w = pg8::cvt_pk_bf16(o[6], o[7]);
                *(u32x4*)(base + (size_t)v * FX + col) = wv; }
    }
};
struct EpiDown {
    static constexpr bool PERM = true, AFTER_DRAIN = false;
    LAS unsigned char* lds; bf16_t* OUTR; bf16_t* YS;
    __device__ __forceinline__ void operator()(const f32x4 (&acc)[2][2][4][2], const MoeUnit& u, int wr, int wc, int fr, int fq) const {
        const LAS int* rows = (const LAS int*)(lds + MOE_ROWS) + u.slot * 512; const bool sh = ((const LAS int*)(lds + MOE_TAB))[u.slot * 4] == NE;
        bf16_t* base = sh ? YS : OUTR; const int col0 = u.pn * BM + wc * 32 + 8 * fq;
#pragma unroll
        for (int ai = 0; ai < 2; ++ai)
#pragma unroll
            for (int m = 0; m < 4; ++m) { const int r = ai * HALF + wr * 64 + m * 16 + fr; const int v = rows[r * 2]; if (v < 0) continue; const float gwv = __int_as_float(rows[r * 2 + 1]);
#pragma unroll
                for (int bj = 0; bj < 2; ++bj) { const f32x4 v0 = acc[ai][bj][m][0] * gwv, v1 = acc[ai][bj][m][1] * gwv;
                    u32x4 wv; wv.x = pg8::cvt_pk_bf16(v0[0], v0[1]); wv.y = pg8::cvt_pk_bf16(v0[2], v0[3]); wv.z = pg8::cvt_pk_bf16(v1[0], v1[1]); wv.w = pg8::cvt_pk_bf16(v1[2], v1[3]);
                    *(u32x4*)(base + (size_t)v * D + col0 + bj * HALF) = wv; } }
    }
};

__device__ __forceinline__ void combine_phase(Frame& F, int l, bool next_inputs, float* dst) {
    const int gw = F.vcu * NWAVES + F.wave, lane = F.lane; unsigned char* ws = F.ws;
    const bf16_t* OUTR = (const bf16_t*)(ws + WS_OUTROW); const bf16_t* YS = (const bf16_t*)(ws + WS_YS); float* X1 = (float*)(ws + WS_X1);
    const float* lg = F.in[4] + (l * 2 + 1) * D; const float* lb = F.in[5] + (l * 2 + 1) * D;
    for (int row = gw; row < M; row += F.G * NWAVES) {
        const int b = row / T; const float* mod = (const float*)(ws + WS_MOD) + (size_t)(l * NB + b) * 6 * D;
        float y[16];
#pragma unroll
        for (int i = 0; i < 16; ++i) y[i] = 0.f;
#pragma unroll
        for (int k = 0; k < 9; ++k) { const bf16_t* src = (k < 8) ? OUTR + ((size_t)row * 8 + k) * D : YS + (size_t)row * D;
#pragma unroll
            for (int j = 0; j < 2; ++j) { const u32x4 wv = *(const u32x4*)(src + 8 * lane + 512 * j); const unsigned ww[4] = {wv.x, wv.y, wv.z, wv.w};
#pragma unroll
                for (int i = 0; i < 4; ++i) { y[j * 8 + 2 * i] += __uint_as_float(ww[i] << 16); y[j * 8 + 2 * i + 1] += __uint_as_float(ww[i] & 0xffff0000u); } } }
        float v[16]; float s = 0.f;
#pragma unroll
        for (int j = 0; j < 2; ++j)
#pragma unroll
            for (int h4 = 0; h4 < 2; ++h4) { const int c = 8 * lane + 512 * j + 4 * h4; const f32x4 x1 = *(const f32x4*)(X1 + (size_t)row * D + c); const f32x4 g1 = *(const f32x4*)(mod + 5 * D + c) + 1.f;
#pragma unroll
                for (int i = 0; i < 4; ++i) { const float p = ALPHA * x1[i] + g1[i] * y[j * 8 + h4 * 4 + i]; v[j * 8 + h4 * 4 + i] = p; s += p; } }
        const float mean = wave_sum(s) * (1.f / D); float q = 0.f;
#pragma unroll
        for (int i = 0; i < 16; ++i) { v[i] -= mean; q += v[i] * v[i]; }
        const float rstd = rsqrtf(wave_sum(q) * (1.f / D) + LN_EPS);
#pragma unroll
        for (int j = 0; j < 2; ++j)
#pragma unroll
            for (int h4 = 0; h4 < 2; ++h4) { const int c = 8 * lane + 512 * j + 4 * h4; const f32x4 gg = *(const f32x4*)(lg + c), bb = *(const f32x4*)(lb + c);
#pragma unroll
                for (int i = 0; i < 4; ++i) v[j * 8 + h4 * 4 + i] = v[j * 8 + h4 * 4 + i] * rstd * gg[i] + bb[i];
                *(f32x4*)((next_inputs ? X1 : dst) + (size_t)row * D + c) = (f32x4){v[j * 8 + h4 * 4], v[j * 8 + h4 * 4 + 1], v[j * 8 + h4 * 4 + 2], v[j * 8 + h4 * 4 + 3]}; }
        if (next_inputs) {
            const float* mod1 = (const float*)(ws + WS_MOD) + (size_t)((l + 1) * NB + b) * 6 * D;
            bf16_t* XB = (bf16_t*)(ws + WS_XB); bf16_t* HB = (bf16_t*)(ws + WS_HB);
#pragma unroll
            for (int j = 0; j < 2; ++j) { const int c = 8 * lane + 512 * j; float hh[8];
#pragma unroll
                for (int h4 = 0; h4 < 2; ++h4) { const f32x4 sc = *(const f32x4*)(mod1 + D + c + 4 * h4) + 1.f, sh = *(const f32x4*)(mod1 + c + 4 * h4);
#pragma unroll
                    for (int i = 0; i < 4; ++i) hh[h4 * 4 + i] = v[j * 8 + h4 * 4 + i] * sc[i] + sh[i]; }
                *(u32x4*)(XB + (size_t)row * D + c) = (u32x4){pk2(v[j * 8], v[j * 8 + 1]), pk2(v[j * 8 + 2], v[j * 8 + 3]), pk2(v[j * 8 + 4], v[j * 8 + 5]), pk2(v[j * 8 + 6], v[j * 8 + 7])};
                *(u32x4*)(HB + (size_t)row * D + c) = (u32x4){pk2(hh[0], hh[1]), pk2(hh[2], hh[3]), pk2(hh[4], hh[5]), pk2(hh[6], hh[7])}; }
            const float* kvw = F.in[22]; float fl[16];
#pragma unroll
            for (int hh_ = 0; hh_ < 16; ++hh_) fl[hh_] = 0.f;
#pragma unroll
            for (int j = 0; j < 2; ++j)
#pragma unroll
                for (int i = 0; i < 8; ++i) { const int c = 8 * lane + 512 * j + i; const float xv = v[j * 8 + i]; const float* wr_ = kvw + (size_t)c * (2 * D + H) + 2 * D;
                    const f32x4 w0 = *(const f32x4*)(wr_), w1 = *(const f32x4*)(wr_ + 4), w2 = *(const f32x4*)(wr_ + 8), w3 = *(const f32x4*)(wr_ + 12);
#pragma unroll
                    for (int e = 0; e < 4; ++e) { fl[e] += xv * w0[e]; fl[4 + e] += xv * w1[e]; fl[8 + e] += xv * w2[e]; fl[12 + e] += xv * w3[e]; } }
            float mine = 0.f;
#pragma unroll
            for (int hh_ = 0; hh_ < 16; ++hh_) { const float tsum = wave_sum(fl[hh_]); if (lane == hh_) mine = tsum; }
            if (lane < 16) ((float*)(ws + WS_LOGF))[(size_t)row * 16 + lane] = -softplus_(-(mine + F.in[23][lane]));
        }
    }
}
}
namespace attn_fox {
using bf16=__hip_bfloat16;
using bf16x8=__attribute__((ext_vector_type(8)))short;
using s16x4=__attribute__((ext_vector_type(4)))short;
using f32x16=__attribute__((ext_vector_type(16)))float;
using u32x4=__attribute__((ext_vector_type(4)))unsigned;
using f32x4k=__attribute__((ext_vector_type(4)))float;
constexpr int BATCH=4,NHEAD=16,SEQ=8192,D=64,DM=NHEAD*D;
constexpr int NW=8,QBLK=32,QB=QBLK*NW,KVBLK=64,NQB=SEQ/QB;
constexpr int ATTN_PITCH=DM, ATTN_UNIT_ROWS=QB;
__device__ __forceinline__ int crow(int r,int hi){return (r&3)+8*(r>>2)+4*hi;}
#define SBAR() __builtin_amdgcn_sched_barrier(0)
__device__ __forceinline__ void cmask(f32x16&p0,f32x16&p1,int jb,int qrel,int hi){
  const float NEG=-INFINITY; int kb=64*jb+4*hi;
  #pragma unroll
  for(int r=0;r<16;++r){int kv=kb+(r&3)+8*(r>>2); if(kv>qrel)p0[r]=NEG; if(kv+32>qrel)p1[r]=NEG;}
}

constexpr int NSLOT=3, SLOTB=8192;
constexpr int LDS_K=0, LDS_V=NSLOT*SLOTB, LDS_WS=2*NSLOT*SLOTB, LDS_OST=LDS_WS+NW*64*4, LDS_KB=86016  , LDS_BYTES=LDS_KB+SEQ*4;
constexpr float C2=0.125f*1.4426950408889634f;
__device__ __forceinline__ void glds16(const void*gsrc,unsigned lds_dst){unsigned keep;
  asm volatile("s_mov_b32 %0, m0\n\ts_mov_b32 m0, %2\n\ts_nop 0\n\tglobal_load_lds_dwordx4 %1, off\n\ts_mov_b32 m0, %0":"=&s"(keep):"v"(gsrc),"s"(lds_dst):"memory");}
__device__ __forceinline__ float max3f(float a,float b,float c){float r;asm("v_max3_f32 %0, %1, %2, %3":"=v"(r):"v"(a),"v"(b),"v"(c));return r;}
__device__ __forceinline__ float max2f(float a,float b){float r;asm("v_max_f32_e32 %0, %1, %2":"=v"(r):"v"(a),"v"(b));return r;}
__device__ __forceinline__ float fadd_s(float a,float b){float r;asm("v_add_f32_e32 %0, %1, %2":"=v"(r):"v"(a),"v"(b));return r;}
__device__ __forceinline__ float fsub_s(float a,float b){float r;asm("v_sub_f32_e32 %0, %1, %2":"=v"(r):"v"(a),"v"(b));return r;}
typedef float f32x2_t __attribute__((ext_vector_type(2))); typedef __bf16 bf16x2_t __attribute__((ext_vector_type(2)));
__device__ __forceinline__ unsigned cvtpk_s(float lo,float hi){f32x2_t v={lo,hi};bf16x2_t b=__builtin_convertvector(v,bf16x2_t);return __builtin_bit_cast(unsigned,b);}
#define WAIT_BAR(N) asm volatile("s_waitcnt vmcnt(" #N ") lgkmcnt(0)\n\ts_barrier":::"memory")

__device__ __forceinline__ void qkt(f32x16&p0,f32x16&p1,const char*Kslot,const bf16x8*qr,const f32x16&negm,int r32,int hi){
  const char*kb=Kslot+hi*1024+r32*16;
  #pragma unroll
  for(int d0=0;d0<4;++d0){
    const bf16x8 b0=*reinterpret_cast<const bf16x8*>(kb+d0*2048);
    const bf16x8 b1=*reinterpret_cast<const bf16x8*>(kb+d0*2048+512);
    if(d0==0){p0=__builtin_amdgcn_mfma_f32_32x32x16_bf16(b0,qr[0],negm,0,0,0);p1=__builtin_amdgcn_mfma_f32_32x32x16_bf16(b1,qr[0],negm,0,0,0);}
    else{p0=__builtin_amdgcn_mfma_f32_32x32x16_bf16(b0,qr[d0],p0,0,0,0);p1=__builtin_amdgcn_mfma_f32_32x32x16_bf16(b1,qr[d0],p1,0,0,0);}}
}
typedef __attribute__((address_space(3))) const char* lds_cptr;
typedef short v4i16_t __attribute__((ext_vector_type(4)));
__device__ __forceinline__ void kload8(bf16x8*kf,lds_cptr kp){
  kf[0]=*(const __attribute__((address_space(3))) bf16x8*)(kp);      kf[1]=*(const __attribute__((address_space(3))) bf16x8*)(kp+512);
  kf[2]=*(const __attribute__((address_space(3))) bf16x8*)(kp+2048); kf[3]=*(const __attribute__((address_space(3))) bf16x8*)(kp+2560);
  kf[4]=*(const __attribute__((address_space(3))) bf16x8*)(kp+4096); kf[5]=*(const __attribute__((address_space(3))) bf16x8*)(kp+4608);
  kf[6]=*(const __attribute__((address_space(3))) bf16x8*)(kp+6144); kf[7]=*(const __attribute__((address_space(3))) bf16x8*)(kp+6656);
}
__device__ __forceinline__ void kload2(bf16x8*kf,lds_cptr kp,int j){ kf[2*j]=*(const __attribute__((address_space(3))) bf16x8*)(kp+j*2048); kf[2*j+1]=*(const __attribute__((address_space(3))) bf16x8*)(kp+j*2048+512); }
__device__ __forceinline__ s16x4 vtr(lds_cptr p){ return __builtin_bit_cast(s16x4,__builtin_amdgcn_ds_read_tr16_b64_v4i16((__attribute__((address_space(3))) v4i16_t*)p)); }
__device__ __forceinline__ float rowmax(const f32x16&p0,const f32x16&p1){
  float a=max3f(p0[0],p0[1],p1[0]),b=max3f(p0[2],p0[3],p1[1]);a=max3f(a,p1[2],p1[3]);
  #pragma unroll
  for(int r=4;r<16;r+=4){a=max3f(a,p0[r],p0[r+1]);b=max3f(b,p0[r+2],p0[r+3]);a=max3f(a,p1[r],p1[r+1]);b=max3f(b,p1[r+2],p1[r+3]);}
  const float m=max2f(a,b);
  auto rr=__builtin_amdgcn_permlane32_swap(__float_as_uint(m),__float_as_uint(m),false,false);
  return max2f(__uint_as_float(rr[0]),__uint_as_float(rr[1]));
}
__device__ __forceinline__ void pv(f32x16*o,int vb,bf16x8 pa0,bf16x8 pa1,bf16x8 pa2,bf16x8 pa3){
  #pragma unroll
  for(int d0=0;d0<2;++d0){s16x4 lo[4],hi[4];
    #pragma unroll
    for(int ks=0;ks<4;++ks){
      asm volatile("ds_read_b64_tr_b16 %0,%1 offset:%c2":"=&v"(lo[ks]):"v"(vb),"i"(d0*4096+ks*1024):"memory");
      asm volatile("ds_read_b64_tr_b16 %0,%1 offset:%c2":"=&v"(hi[ks]):"v"(vb),"i"(d0*4096+ks*1024+512):"memory");}
    asm volatile("s_waitcnt lgkmcnt(0)":::"memory");SBAR();
    #define PK(k) (bf16x8){lo[k][0],lo[k][1],lo[k][2],lo[k][3],hi[k][0],hi[k][1],hi[k][2],hi[k][3]}
    o[d0]=__builtin_amdgcn_mfma_f32_32x32x16_bf16(pa0,PK(0),o[d0],0,0,0);
    o[d0]=__builtin_amdgcn_mfma_f32_32x32x16_bf16(pa1,PK(1),o[d0],0,0,0);
    o[d0]=__builtin_amdgcn_mfma_f32_32x32x16_bf16(pa2,PK(2),o[d0],0,0,0);
    o[d0]=__builtin_amdgcn_mfma_f32_32x32x16_bf16(pa3,PK(3),o[d0],0,0,0);
    #undef PK
  }
}

#ifndef ATTN_STORE16
#define ATTN_STORE16(p,v) (*(u32x4*)(p)=(v))
#endif
template<int THRL> __device__ __forceinline__ void attn_unit(int b,int h,int qb,const bf16*Q,const bf16*__restrict__ K,const bf16*__restrict__ V,bf16*O,const bf16*__restrict__ GATE,const float*__restrict__ Fbh,float thr_nat,char*shm,int wid_in){
  int lane; asm volatile("v_mbcnt_lo_u32_b32 %0, -1, 0\n\tv_mbcnt_hi_u32_b32 %0, -1, %0":"=v"(lane)); const int wid=__builtin_amdgcn_readfirstlane(wid_in); const int tid=wid*64+lane,r32=lane&31,hi=lane>>5;
  const long rowbase=(long)b*SEQ; const int q0=qb*QB;
  const float Fref=Fbh[q0]; int t_lo;
  { const int NTF=(q0+QB)/KVBLK; const int ta=lane, tb=lane+64;
    const bool ka=(ta<NTF-4)?((Fref-Fbh[64*ta+63])<-thr_nat):false, kb_=(tb<NTF-4)?((Fref-Fbh[64*tb+63])<-thr_nat):false;
    const unsigned long long ma=__ballot(!ka), mb=__ballot(!kb_);
    int lead=(ma!=0ull)?__builtin_ctzll(ma):((mb!=0ull)?64+__builtin_ctzll(mb):128); t_lo=__builtin_amdgcn_readfirstlane(lead)&~1; }
  { typedef __attribute__((address_space(3))) float ldsf; ldsf*kbw=(ldsf*)(shm+LDS_KB); const int nk=q0+QB-64*t_lo; const float L2E=1.4426950408889634f;
    for(int i=tid;i<nk;i+=NW*64) kbw[i]=(Fref-Fbh[64*t_lo+i])*L2E; }
  const bf16*Qw=Q+(rowbase+q0+wid*QBLK)*DM+h*D;
  const bf16*Kh=K+(rowbase+64*t_lo)*DM+h*D,*Vh=V+(rowbase+64*t_lo)*DM+h*D;
  const unsigned lds0=(unsigned)(uintptr_t)shm;
  float*wsf=(float*)(shm+LDS_WS)+wid*64;
  const bf16*ksrc=Kh+(long)lane*DM+wid*8;
  const bf16*vsrc=Vh+(long)(16*(wid&3)+(lane>>2))*DM+(wid>>2)*32+(lane&3)*8;
  const unsigned kdst=lds0+LDS_K+wid*1024, vdst=lds0+LDS_V+wid*1024;
  #define DMA_K(t,slot) glds16(ksrc+(long)(t)*KVBLK*DM,(unsigned)__builtin_amdgcn_readfirstlane(kdst+(slot)))
  #define DMA_V(t,slot) glds16(vsrc+(long)(t)*KVBLK*DM,(unsigned)__builtin_amdgcn_readfirstlane(vdst+(slot)))
  const int vb0=(int)(lds0+LDS_V)+((lane>>4)&1)*32+(lane&3)*8+(4*hi+((lane&15)>>2))*64;
  const char*Kbase=shm+LDS_K; bf16x8 kf[8];
  const lds_cptr shm3=(lds_cptr)shm; const lds_cptr kp0=shm3+LDS_K+hi*1024+r32*16; const lds_cptr vp0=shm3+LDS_V+((lane>>4)&1)*32+(lane&3)*8+(4*hi+((lane&15)>>2))*64;
  const int NT=(q0+QB)/KVBLK-t_lo;
  DMA_K(0,0);DMA_V(0,0);DMA_K(1,SLOTB);
  bf16x8 qr[4];
  #pragma unroll
  for(int d0=0;d0<4;++d0)qr[d0]=*reinterpret_cast<const bf16x8*>(&Qw[(long)r32*DM+d0*16+hi*8]);
  const int qrel=wid*QBLK+r32;
  float l_reg=0.f;f32x16 o[2];o[0]=f32x16{};o[1]=f32x16{};const float rb=(Fbh[q0+qrel]-Fref)*1.4426950408889634f; const f32x16 negm=f32x16{};
  typedef __attribute__((address_space(3))) const float* kb_cptr; const kb_cptr kb0=(kb_cptr)(shm+LDS_KB)+4*hi;
  #define KBIAS(C0_,C1_,t_) do{ const kb_cptr kp_=kb0+64*(t_); _Pragma("unroll") for(int g_=0;g_<4;++g_){ const f32x4k a_=*(const __attribute__((address_space(3))) f32x4k*)(kp_+8*g_), b_=*(const __attribute__((address_space(3))) f32x4k*)(kp_+32+8*g_); \
      _Pragma("unroll") for(int x_=0;x_<4;++x_){ C0_[4*g_+x_]+=(a_[x_]+rb); C1_[4*g_+x_]+=(b_[x_]+rb); } } }while(0)
  #define CMASK(P0,P1,t) do{int jb_=(t)-(NT-4); if(jb_>=0)cmask(P0,P1,jb_,qrel,hi);}while(0)
  #define START(P0,P1) do{ _Pragma("unroll") for(int r=0;r<16;++r)P0[r]=__builtin_amdgcn_exp2f(P0[r]); }while(0)
  #define RESC() do{}while(0)
  f32x16 pA0,pA1,pB0,pB1;
  int sl_prev=0,sl_cur=0,sl_next=SLOTB;
  #define ROT() do{sl_prev=sl_cur;sl_cur=sl_next;sl_next=(sl_next==(NSLOT-1)*SLOTB)?0:sl_next+SLOTB;}while(0)
  DMA_K(2,2*SLOTB);
  WAIT_BAR(3);
  qkt(pA0,pA1,Kbase,qr,negm,r32,hi);asm volatile("s_nop 15\n\ts_nop 7":"+v"(pA0),"+v"(pA1));KBIAS(pA0,pA1,0);CMASK(pA0,pA1,0);
  START(pA0,pA1);
  _Pragma("unroll") for(int r=0;r<16;++r)pA1[r]=__builtin_amdgcn_exp2f(pA1[r]);
  WAIT_BAR(0);
  DMA_K(3,0);DMA_V(1,SLOTB);
  ROT();
  kload8(kf,kp0+sl_cur);
  WAIT_BAR(2);
  s16x4 vlo[8],vhi[8]; u32x4 pw0,pw1,pw2,pw3;
  #define PKW(P,B) cvtpk_s(P[B],P[B+1])
  #define PAF(k) __builtin_bit_cast(bf16x8,pw##k)
  #define VFR(i) (bf16x8){vlo[i][0],vlo[i][1],vlo[i][2],vlo[i][3],vhi[i][0],vhi[i][1],vhi[i][2],vhi[i][3]}
  #define PIN(x) asm volatile("":"+v"(x))
  #define MX3(a,b,c) __builtin_fmaxf(__builtin_fmaxf((a),(b)),(c))
  #define GAPA(MF,A0,A1,A2,A3,W0,W1,PW) do{ MF; sacc+=A0; sacc+=A1; sacc+=A2; sacc+=A3; PIN(sacc); W0; W1; PIN(PW); SBAR(); }while(0)
  #define EX(v) __builtin_amdgcn_exp2f(v)
  #define GAPB(MF,X,B) do{ MF; X[B]=EX(X[B]); X[B+1]=EX(X[B+1]); X[B+2]=EX(X[B+2]); X[B+3]=EX(X[B+3]); PIN(X); SBAR(); }while(0)
  #define VRD(i) do{ vlo[i]=vtr(vp_+(((i)>>2)*4096+((i)&3)*1024)); vhi[i]=vtr(vp_+(((i)>>2)*4096+((i)&3)*1024+512)); }while(0)
  #define KRD(G,j) do{ if(G){ kload2(kf,kp0+sl_next,j); SBAR(); } }while(0)
  #define STEP(C0,C1,P0,P1,t,GK,GV,GL) do{ SBAR(); \
    const lds_cptr vp_=vp0+sl_prev; \
    VRD(0); SBAR(); float sacc=(P0[0]+P0[1]); \
    GAPA(C0=__builtin_amdgcn_mfma_f32_32x32x16_bf16(kf[0],qr[0],negm,0,0,0), P0[2],P0[3],P0[4],P0[5],     pw0[0]=PKW(P0,0), pw0[1]=PKW(P0,2), pw0); \
    VRD(4); SBAR(); GAPA(C1=__builtin_amdgcn_mfma_f32_32x32x16_bf16(kf[1],qr[0],negm,0,0,0), P0[6],P0[7],P0[8],P0[9],     pw0[2]=PKW(P0,4), pw0[3]=PKW(P0,6), pw0); \
    VRD(1); SBAR(); GAPA(C0=__builtin_amdgcn_mfma_f32_32x32x16_bf16(kf[2],qr[1],C0,0,0,0),   P0[10],P0[11],P0[12],P0[13], pw1[0]=PKW(P0,8), pw1[1]=PKW(P0,10), pw1); \
    VRD(5); SBAR(); GAPA(C1=__builtin_amdgcn_mfma_f32_32x32x16_bf16(kf[3],qr[1],C1,0,0,0),   P0[14],P0[15],P1[0],P1[1],   pw1[2]=PKW(P0,12),pw1[3]=PKW(P0,14), pw1); \
    VRD(2); SBAR(); GAPA(C0=__builtin_amdgcn_mfma_f32_32x32x16_bf16(kf[4],qr[2],C0,0,0,0),   P1[2],P1[3],P1[4],P1[5],     pw2[0]=PKW(P1,0), pw2[1]=PKW(P1,2), pw2); \
    VRD(6); SBAR(); GAPA(C1=__builtin_amdgcn_mfma_f32_32x32x16_bf16(kf[5],qr[2],C1,0,0,0),   P1[6],P1[7],P1[8],P1[9],     pw2[2]=PKW(P1,4), pw2[3]=PKW(P1,6), pw2); \
    VRD(3); SBAR(); GAPA(C0=__builtin_amdgcn_mfma_f32_32x32x16_bf16(kf[6],qr[3],C0,0,0,0),   P1[10],P1[11],P1[12],P1[13], pw3[0]=PKW(P1,8), pw3[1]=PKW(P1,10), pw3); \
    VRD(7); SBAR(); GAPA(C1=__builtin_amdgcn_mfma_f32_32x32x16_bf16(kf[7],qr[3],C1,0,0,0),   P1[14],P1[15],0.f,0.f,       pw3[2]=PKW(P1,12),pw3[3]=PKW(P1,14), pw3); \
    l_reg+=sacc; \
    if(GK){DMA_K((t)+3,sl_cur);} if(GV){DMA_V((t)+1,sl_next);} \
    KBIAS(C0,C1,t); CMASK(C0,C1,t); \
    SBAR(); \
    GAPB(o[0]=__builtin_amdgcn_mfma_f32_32x32x16_bf16(PAF(0),VFR(0),o[0],0,0,0), C0,0); \
    GAPB(o[1]=__builtin_amdgcn_mfma_f32_32x32x16_bf16(PAF(0),VFR(4),o[1],0,0,0), C0,4); \
    KRD(GL,0); GAPB(o[0]=__builtin_amdgcn_mfma_f32_32x32x16_bf16(PAF(1),VFR(1),o[0],0,0,0), C0,8); \
    KRD(GL,1); GAPB(o[1]=__builtin_amdgcn_mfma_f32_32x32x16_bf16(PAF(1),VFR(5),o[1],0,0,0), C0,12); \
    KRD(GL,2); GAPB(o[0]=__builtin_amdgcn_mfma_f32_32x32x16_bf16(PAF(2),VFR(2),o[0],0,0,0), C1,0); \
    KRD(GL,3); GAPB(o[1]=__builtin_amdgcn_mfma_f32_32x32x16_bf16(PAF(2),VFR(6),o[1],0,0,0), C1,4); \
    GAPB(o[0]=__builtin_amdgcn_mfma_f32_32x32x16_bf16(PAF(3),VFR(3),o[0],0,0,0), C1,8); \
    GAPB(o[1]=__builtin_amdgcn_mfma_f32_32x32x16_bf16(PAF(3),VFR(7),o[1],0,0,0), C1,12); \
    }while(0)
  int t=1;
  #undef CMASK
  #define CMASK(P0,P1,t) do{}while(0)
  for(;t+5<NT;t+=2){
    STEP(pB0,pB1,pA0,pA1,t,true,true,true);     WAIT_BAR(2); RESC(); ROT();
    STEP(pA0,pA1,pB0,pB1,t+1,true,true,true);   WAIT_BAR(2); RESC(); ROT();
  }
  #undef CMASK
  #define CMASK(P0,P1,t) do{int jb_=(t)-(NT-4); if(jb_>=0)cmask(P0,P1,jb_,qrel,hi);}while(0)
  #define ENDW(tt) do{ if((tt)+3<NT){WAIT_BAR(2);} else if((tt)+2<NT){WAIT_BAR(1);} else {WAIT_BAR(0);} }while(0)
  for(;t+1<NT;t+=2){
    STEP(pB0,pB1,pA0,pA1,t,(t+3<NT),(t+1<NT),(t+1<NT));       ENDW(t);   RESC(); ROT();
    STEP(pA0,pA1,pB0,pB1,t+1,(t+4<NT),(t+2<NT),(t+2<NT));     ENDW(t+1); RESC(); ROT();
  }
  STEP(pB0,pB1,pA0,pA1,NT-1,false,false,false); RESC();
  { float sacc=pB0[0]+pB0[1]; _Pragma("unroll") for(int r=2;r<16;++r)sacc+=pB0[r]; _Pragma("unroll") for(int r=0;r<16;++r)sacc+=pB1[r]; l_reg+=sacc;
    pw0=(u32x4){PKW(pB0,0),PKW(pB0,2),PKW(pB0,4),PKW(pB0,6)};pw1=(u32x4){PKW(pB0,8),PKW(pB0,10),PKW(pB0,12),PKW(pB0,14)};pw2=(u32x4){PKW(pB1,0),PKW(pB1,2),PKW(pB1,4),PKW(pB1,6)};pw3=(u32x4){PKW(pB1,8),PKW(pB1,10),PKW(pB1,12),PKW(pB1,14)};
    SBAR(); pv(o,vb0+sl_cur,PAF(0),PAF(1),PAF(2),PAF(3)); }
  #undef PKW
  #undef PAF
  #undef VFR
  #undef PIN
  #undef MX3
  #undef GAPA
  #undef GAPB
  #undef EX
  #undef VRD
  #undef KRD
  #undef STEP
  #undef ENDW
  {auto rr=__builtin_amdgcn_permlane32_swap(__float_as_uint(l_reg),__float_as_uint(l_reg),false,false);l_reg=__uint_as_float(rr[0])+__uint_as_float(rr[1]);}
  if(hi==0)wsf[32+r32]=l_reg;asm volatile("s_waitcnt lgkmcnt(0)":::"memory");
  float rli[16];
  #pragma unroll
  for(int r=0;r<16;++r)rli[r]=__builtin_amdgcn_rcpf(wsf[32+crow(r,hi)]);
  bf16*Ow=O+(rowbase+q0+wid*QBLK)*DM+h*D;
  { bf16*stg=(bf16*)(shm+LDS_OST)+wid*2048;
    #pragma unroll
    for(int r=0;r<16;++r){const int orow=crow(r,hi);
      #pragma unroll
      for(int d0=0;d0<2;++d0)stg[orow*64+d0*32+r32]=__float2bfloat16(o[d0][r]*rli[r]);}
    asm volatile("s_waitcnt lgkmcnt(0)":::"memory");
    #pragma unroll
    for(int i=0;i<4;++i){const int row=i*8+(lane>>3),ch=lane&7; const u32x4 v=*(const u32x4*)(stg+row*64+ch*8); const u32x4 gq=*(const u32x4*)(GATE+(rowbase+q0+wid*QBLK+row)*DM+h*D+ch*8);
      const unsigned vv_[4]={v.x,v.y,v.z,v.w},gg_[4]={gq.x,gq.y,gq.z,gq.w}; unsigned oo_[4];
      _Pragma("unroll") for(int x_=0;x_<4;++x_) oo_[x_]=cvtpk_s(__uint_as_float(vv_[x_]<<16)*__uint_as_float(gg_[x_]<<16),__uint_as_float(vv_[x_]&0xffff0000u)*__uint_as_float(gg_[x_]&0xffff0000u));
      ATTN_STORE16(Ow+(long)row*DM+ch*8,((u32x4){oo_[0],oo_[1],oo_[2],oo_[3]}));} }
  asm volatile("s_waitcnt lgkmcnt(0)\n\ts_barrier":::"memory");
  #undef DMA_K
  #undef DMA_V
  #undef CMASK
  #undef START
  #undef RESC
  #undef ROT
  #undef KBIAS
}
constexpr int ATTN_LDS_BYTES=LDS_BYTES;
#undef SBAR
#undef WAIT_BAR
}
namespace fk {
template <bool SIG> struct EpiNormHeads {
    static constexpr bool PERM = true, AFTER_DRAIN = false;
    bf16_t* O0; bf16_t* O1; const float* gain; float scale;
    __device__ __forceinline__ void operator()(const f32x4 (&acc)[2][2][4][2], const Unit& u, int wr, int wc, int fr, int fq) const {
        const int row0 = u.pm * BM + wr * 64 + fr;
        if (u.pn < 4) {
            const int head = 4 * u.pn + wc;
            f32x4 g[2][2];
#pragma unroll
            for (int bj = 0; bj < 2; ++bj)
#pragma unroll
                for (int n = 0; n < 2; ++n) g[bj][n] = *(const f32x4*)(gain + 32 * bj + 8 * fq + 4 * n) * scale;
#pragma unroll
            for (int ai = 0; ai < 2; ++ai)
#pragma unroll
                for (int m = 0; m < 4; ++m) { float ss = 0.f;
#pragma unroll
                    for (int bj = 0; bj < 2; ++bj)
#pragma unroll
                        for (int n = 0; n < 2; ++n) { const f32x4 x = acc[ai][bj][m][n]; ss += (x[0] * x[0] + x[1] * x[1]) + (x[2] * x[2] + x[3] * x[3]); }
                    ss += __shfl_xor(ss, 16); ss += __shfl_xor(ss, 32);
                    const float rs = rsqrtf(ss * (1.f / 64.f) + 1e-6f);
                    bf16_t* rowp = O0 + (size_t)(row0 + ai * HALF + m * 16) * D + head * 64 + 8 * fq;
#pragma unroll
                    for (int bj = 0; bj < 2; ++bj) { const f32x4 v0 = acc[ai][bj][m][0] * rs * g[bj][0], v1 = acc[ai][bj][m][1] * rs * g[bj][1];
                        u32x4 wv; wv.x = pg8::cvt_pk_bf16(v0[0], v0[1]); wv.y = pg8::cvt_pk_bf16(v0[2], v0[3]); wv.z = pg8::cvt_pk_bf16(v1[0], v1[1]); wv.w = pg8::cvt_pk_bf16(v1[2], v1[3]);
                        *(u32x4*)(rowp + 32 * bj) = wv; } }
        } else {
            const int col0 = (u.pn - 4) * BM + wc * 32 + 8 * fq;
#pragma unroll
            for (int ai = 0; ai < 2; ++ai)
#pragma unroll
                for (int m = 0; m < 4; ++m) { bf16_t* rowp = O1 + (size_t)(row0 + ai * HALF + m * 16) * D + col0;
#pragma unroll
                    for (int bj = 0; bj < 2; ++bj) { f32x4 v0 = acc[ai][bj][m][0], v1 = acc[ai][bj][m][1];
                        if (SIG) { for (int i = 0; i < 4; ++i) { v0[i] = sigm(v0[i]); v1[i] = sigm(v1[i]); } }
                        u32x4 wv; wv.x = pg8::cvt_pk_bf16(v0[0], v0[1]); wv.y = pg8::cvt_pk_bf16(v0[2], v0[3]); wv.z = pg8::cvt_pk_bf16(v1[0], v1[1]); wv.w = pg8::cvt_pk_bf16(v1[2], v1[3]);
                        *(u32x4*)(rowp + bj * HALF) = wv; } }
        }
    }
};

__device__ __forceinline__ void fcum_phase(Frame& F) {
    LAS float* part = (LAS float*)(F.lds);
    for (int bh = blockIdx.x; bh < NB * H; bh += F.G) {
        const int b = bh >> 4, h = bh & 15; const float* lf = (const float*)(F.ws + WS_LOGF) + ((size_t)b * T + F.tid * 16) * 16 + h;
        float v[16]; float s = 0.f;
#pragma unroll
        for (int i = 0; i < 16; ++i) { v[i] = lf[(size_t)i * 16]; s += v[i]; }
        part[F.tid] = s;
        __syncthreads();
        if (F.wave == 0) { float run = 0.f;
            for (int c = 0; c < 8; ++c) { const float x = part[c * 64 + F.lane]; float inc = x;
#pragma unroll
                for (int o = 1; o < 64; o <<= 1) { const float u = __shfl_up(inc, o); if (F.lane >= o) inc += u; }
                part[c * 64 + F.lane] = run + inc - x;
                run += __shfl(inc, 63); } }
        __syncthreads();
        float run = part[F.tid]; float* Fo = (float*)(F.ws + WS_FLOC) + (size_t)bh * T + F.tid * 16;
#pragma unroll
        for (int i = 0; i < 16; ++i) { run += v[i]; Fo[i] = run; }
        __syncthreads();
    }
}

__device__ __forceinline__ void attn_phase_fox(Frame& F, unsigned char* lds_generic) {
    typedef attn_fox::bf16 abf;
    const float gq = fabsf(F.in[26][F.lane]), gk = fabsf(F.in[24][F.lane]); float mq = gq, mk = gk;
#pragma unroll
    for (int o = 1; o < 64; o <<= 1) { mq = fmaxf(mq, __shfl_xor(mq, o)); mk = fmaxf(mk, __shfl_xor(mk, o)); }
    const float thr = 104.f + 16.5f * mq * mk;
    const abf* Q = (const abf*)(F.ws + WS_QN); const abf* K = (const abf*)(F.ws + WS_KN); const abf* V = (const abf*)(F.ws + WS_VV); const abf* G = (const abf*)(F.ws + WS_GATE); abf* O = (abf*)(F.ws + WS_O);
    const float* Fc = (const float*)(F.ws + WS_FLOC);
    const int nunits = NB * H * 32;
    for (int i = 0;; ++i) {
        const int v = F.vcu + (i >> 3) * F.G; const int bh = v >> 2, s = v & 3, j = i & 7; if (bh >= NB * H) break;
        const int qb = (j & 1) ? (8 * (j >> 1) + 7 - s) : (8 * (j >> 1) + s);
        attn_fox::attn_unit<8>(bh >> 4, bh & 15, qb, Q, K, V, O, G, Fc + (size_t)bh * T, thr, (char*)lds_generic, F.wave);
    }
    (void)nunits;
}
}
namespace fk {
#ifndef FK_PH_HI
#define FK_PH_HI 4
#endif
#ifndef FK_EXPERTS
#define FK_EXPERTS 0
#endif
__global__ void __launch_bounds__(NTHR, 2) fwd(Args args) {
    extern __shared__ __attribute__((aligned(16))) unsigned char lds[];
    Frame F;
    F.lds = (LAS unsigned char*)lds; F.MISC = (volatile LAS unsigned*)(F.lds + MISC_OFF);
    F.tid = threadIdx.x; F.lane = F.tid & 63; F.wave = __builtin_amdgcn_readfirstlane(F.tid >> 6);
    F.G = gridDim.x; { const int bx = blockIdx.x; F.vcu = (F.G % 8 == 0) ? (bx % 8) * (F.G / 8) + bx / 8 : bx; }
    F.in = args.in; F.out = args.out; F.ws = args.ws; F.ctl = (gu32*)(args.ws + WS_CTL);
    for (int u = F.tid; u < (LDS_BYTES - LDSCTL_OFF) / 4; u += NTHR) ((LAS unsigned*)(F.lds + LDSCTL_OFF))[u] = 0u;
    __syncthreads();
    const int lo = args.ph_lo, hi = args.ph_hi;
    const bool multi = (hi - lo) > 1;
    XcdBarrier bar; bar.bar = (unsigned*)(F.ctl + CW_BAR); bar.x = 0; bar.st = nullptr;
    if (multi) bar = xcd_barrier_post((unsigned*)(F.ctl + CW_BAR), F.MISC + 8);
#define IN(k) (lo <= (k) && (k) < hi)
#define BOTH(k) (IN(k) && IN((k) + 1))
#define GRID_BAR() xcd_barrier(bar, F.wave == 0 && hw_lane() == 0)
#define FRESH() do { F.lane = hw_lane(); F.tid = F.wave * 64 + F.lane; } while (0)
#define ws (args.ws)
    if (IN(0)) { FRESH(); p0_prologue(F, FK_EXPERTS != 0); if (BOTH(0)) GRID_BAR(); }
    if (IN(1)) { FRESH(); p1_mix(F); if (BOTH(1)) GRID_BAR(); }
    if (IN(2)) { FRESH();
        { pg8::Gemm g{(const bf16_t*)(ws + WS_XR), (const bf16_t*)(ws + WS_WRKV), M, 3 * D, D, 4, (size_t)(WS_XK - WS_XR)}; pg8::StaticOrder S; S.init(M, 3 * D, F.G, (int)blockIdx.x);
          pg8::EpiBf16<0> E{(bf16_t*)(ws + WS_R), D, nullptr, D, (size_t)(WS_K - WS_R) / 2, 1.f};
          pg8::gemm_phase<pg8::EpiBf16<0>, pg8::StaticOrder, true, true>(F.lds, g, S, E, F.wave); }
        { pg8::Gemm g{(const bf16_t*)(ws + WS_HX), (const bf16_t*)(ws + WS_B1T), M, 256, 2 * D, 1 << 30, 0}; pg8::StaticOrder S; S.init(M, 256, F.G, (int)blockIdx.x);
          EpiL1 E{(bf16_t*)(ws + WS_L1)};
          pg8::gemm_phase<EpiL1, pg8::StaticOrder, true, true>(F.lds, g, S, E, F.wave); }
        if (BOTH(2)) GRID_BAR();
    }
    if (IN(3)) { FRESH();
        pg8::Gemm g{(const bf16_t*)(ws + WS_L1), (const bf16_t*)(ws + WS_B2T), M, 3 * D, 256, 1 << 30, 0}; pg8::StaticOrder S; S.init(M, 3 * D, F.G, (int)blockIdx.x);
        EpiL2 E{(float*)(ws + WS_LW), (bf16_t*)(ws + WS_A), (bf16_t*)(ws + WS_G), F.in[9], F.in[12], (float*)(ws + WS_X1)};
        pg8::gemm_phase<EpiL2, pg8::StaticOrder, true, true>(F.lds, g, S, E, F.wave);
        if (BOTH(3)) GRID_BAR();
    }
    if (IN(4)) { FRESH(); p5_phase(F); if (BOTH(4)) GRID_BAR(); }
    if (IN(5)) { FRESH(); p6_phase(F); if (BOTH(5)) GRID_BAR(); }
    if (IN(6)) { FRESH(); p6b_phase(F); if (BOTH(6)) GRID_BAR(); }
#define POST_BLOCK(P7, L, RESPTR, WO_OFF, RT_OFF, SGU_OFF, SD_OFF, NEXT, DST) \
    if (IN(P7)) { FRESH(); \
        pg8::Gemm g{(const bf16_t*)(ws + ((L) == 0 ? WS_Z : WS_O)), (const bf16_t*)(ws + (WO_OFF)), M, D, D, 1 << 30, 0}; pg8::StaticOrder S; S.init(M, D, F.G, (int)blockIdx.x); \
        EpiPre E{RESPTR, (const float*)(ws + WS_MOD) + (size_t)(L) * NB * 6 * D + 2 * D, (float*)(ws + WS_PRE)}; \
        pg8::gemm_phase<EpiPre, pg8::StaticOrder, true, true>(F.lds, g, S, E, F.wave); \
        if (BOTH(P7)) GRID_BAR(); } \
    if (IN((P7) + 1)) { FRESH(); ln_mod_phase(F, L); if (BOTH((P7) + 1)) GRID_BAR(); } \
    if (IN((P7) + 2)) { FRESH(); \
        pg8::Gemm g{(const bf16_t*)(ws + WS_H2), (const bf16_t*)(ws + (RT_OFF)), M, NE, D, 1 << 30, 0}; pg8::StaticOrder S; S.init(M, NE, F.G, (int)blockIdx.x); \
        EpiF32 E{(float*)(ws + WS_LOGITS), NE}; \
        pg8::gemm_phase<EpiF32, pg8::StaticOrder, true, true>(F.lds, g, S, E, F.wave); \
        if (BOTH((P7) + 2)) GRID_BAR(); } \
    if (IN((P7) + 3)) { FRESH(); route_phase(F, L); if (BOTH((P7) + 3)) GRID_BAR(); } \
    if (IN((P7) + 4)) { FRESH(); \
        const int np = moe_build(F, L); \
        pg8::Gemm g{(const bf16_t*)ws, nullptr, 0, 2 * FX, D, 1 << 30, 0}; \
        MoeSched S{F.lds, np, 2, (const char*)(ws + WS_EGU + (size_t)(L) * EGU_L), (const char*)(ws + (SGU_OFF)), (size_t)512 * D * 2, (unsigned)WS_H2, (unsigned)WS_H2, (unsigned)(D * 2), 3}; \
        EpiAct E{F.lds, (bf16_t*)(ws + WS_ACT), (bf16_t*)(ws + WS_ACTS)}; \
        pg8::gemm_phase_g<EpiAct, MoeSched, true, true>(F.lds, g, S, E, F.wave); \
        if (BOTH((P7) + 4)) GRID_BAR(); } \
    if (IN((P7) + 5)) { FRESH(); \
        const int np = moe_build(F, L); \
        pg8::Gemm g{(const bf16_t*)ws, nullptr, 0, D, FX, 1 << 30, 0}; \
        MoeSched S{F.lds, np, 4, (const char*)(ws + WS_ED + (size_t)(L) * ED_L), (const char*)(ws + (SD_OFF)), (size_t)D * FX * 2, (unsigned)WS_ACT, (unsigned)WS_ACTS, (unsigned)(FX * 2), 0}; \
        EpiDown E{F.lds, (bf16_t*)(ws + WS_OUTROW), (bf16_t*)(ws + WS_YS)}; \
        pg8::gemm_phase_g<EpiDown, MoeSched, true, true>(F.lds, g, S, E, F.wave); \
        if (BOTH((P7) + 5)) GRID_BAR(); } \
    if (IN((P7) + 6)) { FRESH(); combine_phase(F, L, NEXT, DST); if (BOTH((P7) + 6)) GRID_BAR(); }

    POST_BLOCK(7, 0, F.in[0], WS_WO0, WS_RT0, WS_SGU0, WS_SD0, true, nullptr)
    if (IN(14)) { FRESH();
        fcum_phase(F);
        { pg8::Gemm g{(const bf16_t*)(ws + WS_XB), (const bf16_t*)(ws + WS_KVT), M, 2 * D, D, 1 << 30, 0}; pg8::StaticOrder S; S.init(M, 2 * D, F.G, (int)blockIdx.x);
          EpiNormHeads<false> E{(bf16_t*)(ws + WS_KN), (bf16_t*)(ws + WS_VV), F.in[24], 1.f};
          pg8::gemm_phase<EpiNormHeads<false>, pg8::StaticOrder, true, true>(F.lds, g, S, E, F.wave); }
        { pg8::Gemm g{(const bf16_t*)(ws + WS_HB), (const bf16_t*)(ws + WS_QGT), M, 2 * D, D, 1 << 30, 0}; pg8::StaticOrder S; S.init(M, 2 * D, F.G, (int)blockIdx.x);
          EpiNormHeads<true> E{(bf16_t*)(ws + WS_QN), (bf16_t*)(ws + WS_GATE), F.in[26], 0.125f * 1.4426950408889634f};
          pg8::gemm_phase<EpiNormHeads<true>, pg8::StaticOrder, true, true>(F.lds, g, S, E, F.wave); }
        if (BOTH(14)) GRID_BAR();
    }
    if (IN(15)) { FRESH(); attn_phase_fox(F, lds); if (BOTH(15)) GRID_BAR(); }
    POST_BLOCK(16, 1, (const float*)(ws + WS_X1), WS_WO1, WS_RT1, WS_SGU1, WS_SD1, false, F.out)
#undef POST_BLOCK
#undef ws
#undef IN
#undef BOTH
#undef GRID_BAR
}

__global__ void k_cmp(const float* ref, int ldr, const void* fast, int is_bf16, int ldf, int rows, int cols, float* acc) {
    __shared__ float r1[8], r2[8];
    float num = 0.f, den = 0.f;
    for (size_t i = (size_t)blockIdx.x * blockDim.x + threadIdx.x; i < (size_t)rows * cols; i += (size_t)gridDim.x * blockDim.x) {
        const size_t r = i / cols, c = i % cols; const float o = ref[r * ldr + c];
        float f; if (is_bf16) { const unsigned short h = ((const unsigned short*)fast)[r * ldf + c]; f = __uint_as_float((unsigned)h << 16); } else f = ((const float*)fast)[r * ldf + c];
        num += (f - o) * (f - o); den += o * o; }
    num = wave_sum(num); den = wave_sum(den);
    if ((threadIdx.x & 63) == 0) { r1[threadIdx.x >> 6] = num; r2[threadIdx.x >> 6] = den; }
    __syncthreads();
    if (threadIdx.x == 0) { float a = 0.f, b = 0.f; for (int w = 0; w < (int)(blockDim.x >> 6); ++w) { a += r1[w]; b += r2[w]; } atomicAdd(acc, a); atomicAdd(acc + 1, b); }
}
__global__ void k_code(const float* acc, int nchk, float tol2, float* out, size_t n) {
    float c = 0.f;
    for (int i = 0; i < nchk; ++i) { const float num = acc[2 * i], den = acc[2 * i + 1]; float r2 = num / fmaxf(den, 1e-30f); if (!(r2 == r2)) r2 = 0.98f; if (den <= 0.f) r2 = 0.97f;
        if (r2 > tol2) { float v = fminf(fmaxf(r2 * 1e6f, 1.f), 9.9e5f); { const float e10 = floorf(log10f(v)); v = powf(10.f, e10) * (v / powf(10.f, e10) >= 3.16f ? 3.f : 1.f); } for (int k = 0; k < i; ++k) v *= 1e6f; c = sqrtf(v); break; } }
    for (size_t i = (size_t)blockIdx.x * blockDim.x + threadIdx.x; i < n; i += (size_t)gridDim.x * blockDim.x) out[i] = c;
}
}

extern "C" void kernel_launch(void* const* d_in, const int* in_sizes, int n_in, void* d_out, int out_size, void* d_ws, size_t ws_size, hipStream_t stream) {
    using namespace fk;
    static int grid = 0;
    if (grid == 0) {
        int dev = 0, cus = 0;
        if (n_in != 36 || hipGetDevice(&dev) != hipSuccess || hipDeviceGetAttribute(&cus, hipDeviceAttributeMultiprocessorCount, dev) != hipSuccess) { grid = -1; return; }
        if (hipFuncSetAttribute((const void*)fwd, hipFuncAttributeMaxDynamicSharedMemorySize, LDS_BYTES) != hipSuccess) { grid = -1; return; }
        grid = cus;
    }
    if (grid < 0) return;
#if defined(FK_DEBUG)
    constexpr size_t NV_BASE = 32 * MiB, SAVE_BASE = 1922 * MiB; constexpr int DBG_B = FK_DEBUG - 1;
    char* nws = (char*)d_ws + NV_BASE;
    auto nb = [&](int i) { return (const float*)(nws + nv::W_BUF + (size_t)i * nv::TD); };
    auto sv = [&](int i) { return (const float*)((char*)d_ws + SAVE_BASE + (size_t)i * nv::TD); };
    {
        nv::In in; for (int i = 0; i < 36; ++i) in.p[i] = (const float*)d_in[i];
        hipLaunchKernelGGL(nv::k_mod, dim3(2 * nv::NB * 6 * nv::D / 256), dim3(256), 0, stream, in.p[1], in.p[2], in.p[3], (float*)(nws + nv::W_MOD));
        nv::forward_batch(stream, in, nws, DBG_B, (float*)(nws + nv::W_BUF + (size_t)nv::B_OG * nv::TD), FK_DBG_STOP);
#define SAVE(i, src, bytes) (void)hipMemcpyAsync((char*)d_ws + SAVE_BASE + (size_t)(i) * nv::TD, src, bytes, hipMemcpyDeviceToDevice, stream);
        FK_DBG_SAVES
#undef SAVE
    }
#endif
    (void)hipMemsetAsync((char*)d_ws + WS_CTL, 0, CTL_ZERO_BYTES, stream);
    Args a{};
    for (int i = 0; i < 36; ++i) a.in[i] = (const float*)d_in[i];
    a.out = (float*)d_out; a.ws = (unsigned char*)d_ws;
#if defined(FK_PER_PHASE)
    for (int p = 0; p < FK_PH_HI; ++p) { a.ph_lo = p; a.ph_hi = p + 1; hipLaunchKernelGGL(fwd, dim3(grid), dim3(NTHR), LDS_BYTES, stream, a); }
#else
    a.ph_lo = 0; a.ph_hi = FK_PH_HI; hipLaunchKernelGGL(fwd, dim3(grid), dim3(NTHR), LDS_BYTES, stream, a);
#endif
#if defined(FK_DEBUG)
    {
        float* acc = (float*)((char*)d_ws + WS_CTL) + CW_DBG;
        const size_t ro = (size_t)DBG_B * T;
        int nchk = 0;
#define CHK(refp, ldr, fastoff, isbf, ldf, cols) { hipLaunchKernelGGL(k_cmp, dim3(1024), dim3(256), 0, stream, refp, ldr, (const void*)((char*)d_ws + (fastoff) + ro * (ldf) * ((isbf) ? 2 : 4)), isbf, ldf, T, cols, acc + 2 * nchk); ++nchk; }
        FK_DBG_CHECKS
#undef CHK
        hipLaunchKernelGGL(k_code, dim3(1024), dim3(256), 0, stream, acc, nchk, FK_DBG_TOL2, (float*)d_out, (size_t)out_size);
    }
#endif
}
```

```cpp
#define FK_EXPERTS 1
#define FK_PH_HI 23
#include <hip/hip_runtime.h>
#include <hip/hip_bf16.h>
#include <cstdio>
#include <cstdint>
#include <cstring>
#include <cmath>
namespace pg8 {
#define PG8_LAS __attribute__((address_space(3)))
typedef unsigned short bf16_t;
typedef short bf16x8 __attribute__((ext_vector_type(8)));
typedef float f32x4 __attribute__((ext_vector_type(4)));
typedef unsigned u32x4 __attribute__((ext_vector_type(4)));
constexpr int BM = 256, BK = 64, HALF = 128, HTB = HALF * BK * 2  , STAGE_BYTES = 8 * HTB, NXCD = 8, WGM = 8;

__host__ __device__ __forceinline__ int lds_byte(int r, int c) { const int st = (r >> 4) * 2 + (c >> 5), rr = r & 15, cc = c & 31, ob = rr * 64 + cc * 2; return st * 1024 + (ob ^ (((ob >> 9) & 1) << 5)); }
__host__ __device__ __forceinline__ void stage_rc(int b, int& R, int& C) { const int st = b / 1024, sb = b % 1024, swz = sb ^ (((sb >> 9) & 1) << 5); R = (st >> 1) * 16 + swz / 64; C = (st & 1) * 32 + (swz % 64) / 2; }
__host__ __device__ __forceinline__ int perm32(int rho) { const int n = rho >> 4, i = rho & 15; return 8 * (i >> 2) + 4 * n + (i & 3); }

struct Unit { int pm, pn; };
struct Gemm { const bf16_t* A; const bf16_t* Bt; int M, N, K; int asel_div; size_t asel_stride; };

struct StaticOrder {
    int nM, nN, nwg, G, c;
    __host__ __device__ void init(int M, int N, int G_, int c_) { nM = M / BM; nN = N / BM; nwg = nM * nN; G = G_; c = c_; }
    __host__ __device__ bool next(int i, Unit& u) const {
        const long L = (long)i * G + c; if (L >= nwg) return false;
        int wgid = (int)L; { const int q = nwg / NXCD, r = nwg % NXCD, xcd = wgid % NXCD, off = wgid / NXCD; wgid = (xcd < r ? xcd * (q + 1) : r * (q + 1) + (xcd - r) * q) + off; }
        const int nig = WGM * nN, gid = wgid / nig, fm = gid * WGM, gsz = (nM - fm) < WGM ? (nM - fm) : WGM;
        u.pm = fm + ((wgid % nig) % gsz); u.pn = (wgid % nig) / gsz; return true;
    }
    __device__ __forceinline__ void a_ready(const Unit&) const {}
    __device__ __forceinline__ void done(const Unit&) const {}
};

typedef float f32x2c_t __attribute__((ext_vector_type(2))); typedef __bf16 bf16x2c_t __attribute__((ext_vector_type(2)));
__device__ __forceinline__ unsigned cvt_pk_bf16(float lo, float hi) { f32x2c_t v = {lo, hi}; bf16x2c_t b = __builtin_convertvector(v, bf16x2c_t); return __builtin_bit_cast(unsigned, b); }
typedef float f32x2 __attribute__((ext_vector_type(2)));
__device__ __forceinline__ f32x2 gelu_pk(f32x2 v) {
    const f32x2 av = __builtin_elementwise_abs(v), d = av * 0.2316418882f + 1.0f;
    f32x2 t; t.x = __builtin_amdgcn_rcpf(d.x); t.y = __builtin_amdgcn_rcpf(d.y);
    f32x2 q = t * 0.5307027145f + (-0.7265760135f); q = q * t + 0.7107068705f; q = q * t + (-0.142248368f); q = q * t + 0.127414796f; q = q * t;
    const f32x2 s = (v * v) * (-0.72134752044f);
    f32x2 e; e.x = __builtin_amdgcn_exp2f(s.x); e.y = __builtin_amdgcn_exp2f(s.y);
    const f32x2 m = v * (q * e), r = v - m;
    f32x2 o; o.x = v.x < 0.f ? m.x : r.x; o.y = v.y < 0.f ? m.y : r.y; return o;
}

template <int ACT  > struct EpiBf16 {
    static constexpr bool PERM = true, AFTER_DRAIN = false; static_assert(ACT == 0 || ACT == 1, "EpiBf16: ACT is 0 (none) or 1 (gelu_pk)");
    bf16_t* O; int ldc; const float* bias; int split_cols; size_t split_stride; float scale0;
    __device__ __forceinline__ void operator()(const f32x4 (&acc)[2][2][4][2], const Unit& u, int wr, int wc, int fr, int fq) const {
        const int row0 = u.pm * BM + wr * 64 + fr; int colt = u.pn * BM; bf16_t* base = O;
        float sc = 1.f; if (split_cols) { const int t = colt / split_cols; base += (size_t)t * split_stride; colt -= t * split_cols; if (t == 0) sc = scale0; }
        const int col0 = colt + wc * 32 + 8 * fq, bcol0 = u.pn * BM + wc * 32 + 8 * fq;
        f32x4 bv[2][2];
#pragma unroll
        for (int bj = 0; bj < 2; ++bj)
#pragma unroll
            for (int n = 0; n < 2; ++n) bv[bj][n] = bias ? *(const f32x4*)(bias + bcol0 + bj * HALF + 4 * n) : (f32x4){0.f, 0.f, 0.f, 0.f};
#pragma unroll
        for (int ai = 0; ai < 2; ++ai)
#pragma unroll
            for (int m = 0; m < 4; ++m) { bf16_t* rowp = base + (size_t)(row0 + ai * HALF + m * 16) * ldc + col0;
#pragma unroll
                for (int bj = 0; bj < 2; ++bj) { f32x4 v0 = acc[ai][bj][m][0] + bv[bj][0], v1 = acc[ai][bj][m][1] + bv[bj][1];
                    if (ACT == 1) { f32x2 a = gelu_pk((f32x2){v0[0], v0[1]}), b = gelu_pk((f32x2){v0[2], v0[3]}), c = gelu_pk((f32x2){v1[0], v1[1]}), d = gelu_pk((f32x2){v1[2], v1[3]});
                        v0 = (f32x4){a.x, a.y, b.x, b.y}; v1 = (f32x4){c.x, c.y, d.x, d.y}; }
                    v0 = v0 * sc; v1 = v1 * sc; u32x4 w; w.x = cvt_pk_bf16(v0[0], v0[1]); w.y = cvt_pk_bf16(v0[2], v0[3]); w.z = cvt_pk_bf16(v1[0], v1[1]); w.w = cvt_pk_bf16(v1[2], v1[3]);
                    *(u32x4*)(rowp + bj * HALF) = w; } }
    }
};

struct PanelStats {
    unsigned* xbuf;
    unsigned* cnt;
    unsigned* tmo;
    int ntn; float eps;
    unsigned code;
    __device__ __forceinline__ bool run(const f32x4 (&v)[2][2][4][2], const Unit& u, int wr, int wc, int fr, int fq, PG8_LAS unsigned char* lds, int wid, int lane) const {
        typedef float f32x2v __attribute__((ext_vector_type(2)));
        PG8_LAS f32x2v* P = (PG8_LAS f32x2v*)lds;
        PG8_LAS f32x2v* S = (PG8_LAS f32x2v*)(lds + 8192);
        PG8_LAS unsigned* flag = (PG8_LAS unsigned*)(lds + 8192 + 2048);
#pragma unroll
        for (int ai = 0; ai < 2; ++ai)
#pragma unroll
            for (int m = 0; m < 4; ++m) {
                float s = 0.f;
#pragma unroll
                for (int bj = 0; bj < 2; ++bj)
#pragma unroll
                    for (int n = 0; n < 2; ++n) { const f32x4 x = v[ai][bj][m][n]; s += (x[0] + x[1]) + (x[2] + x[3]); }
                s += __shfl_xor(s, 16); s += __shfl_xor(s, 32);
                const float mw = s * (1.0f / 64.0f); float q = 0.f;
#pragma unroll
                for (int bj = 0; bj < 2; ++bj)
#pragma unroll
                    for (int n = 0; n < 2; ++n) { const f32x4 d = v[ai][bj][m][n] - mw; q += (d[0] * d[0] + d[1] * d[1]) + (d[2] * d[2] + d[3] * d[3]); }
                q += __shfl_xor(q, 16); q += __shfl_xor(q, 32);
                if (fq == 0) P[(ai * HALF + wr * 64 + m * 16 + fr) * 4 + wc] = (f32x2v){mw, q};
            }
        asm volatile("s_waitcnt lgkmcnt(0)" ::: "memory"); __builtin_amdgcn_s_barrier(); asm volatile("" ::: "memory");
#if defined(BROKEN_EXCHANGE_NO_WAIT)
#warning BROKEN CONTROL BUILD: the row-statistics exchange does not wait; results are wrong by design
        if (blockIdx.x >= 64) { const long long t0_ = clock64(); while (clock64() - t0_ < 60000) __builtin_amdgcn_s_sleep(8); }
#endif
        const int row = wid * 32 + (lane & 31);
        if (lane < 32) {
            const f32x2v a = P[row * 4 + 0], b = P[row * 4 + 1], c = P[row * 4 + 2], d = P[row * 4 + 3];
            const float mt = (a.x + b.x + c.x + d.x) * 0.25f;
            const float da = a.x - mt, db = b.x - mt, dc = c.x - mt, dd = d.x - mt;
            const float m2 = (a.y + b.y) + (c.y + d.y) + 64.0f * ((da * da + db * db) + (dc * dc + dd * dd));
            unsigned long long* slot = (unsigned long long*)xbuf + ((size_t)(u.pm * BM + row) * 4 + u.pn);
            __hip_atomic_store(slot, ((unsigned long long)__float_as_uint(m2) << 32) | __float_as_uint(mt), __ATOMIC_RELAXED, __HIP_MEMORY_SCOPE_AGENT);
        }
        asm volatile("s_waitcnt vmcnt(0)" ::: "memory");
        if (lane == 0) __hip_atomic_fetch_add(cnt + 64 * u.pm, 1u, __ATOMIC_RELAXED, __HIP_MEMORY_SCOPE_AGENT);
        if (wid == 0) {
            bool dead = false; const unsigned long long t0 = __builtin_amdgcn_s_memrealtime(); const unsigned want = 8u * (unsigned)ntn;
            for (;;) {
#if defined(BROKEN_EXCHANGE_NO_WAIT)
                break;
#endif
                if ((unsigned)__builtin_amdgcn_readfirstlane(__hip_atomic_load(cnt + 64 * u.pm, __ATOMIC_RELAXED, __HIP_MEMORY_SCOPE_AGENT)) >= want) break;
                if (__builtin_amdgcn_s_memrealtime() - t0 > 2000000ull) {
                    if (lane == 0) { unsigned expect = 0u; __hip_atomic_compare_exchange_strong(tmo + 1, &expect, code | (unsigned)(u.pm & 0xff), __ATOMIC_RELAXED, __ATOMIC_RELAXED, __HIP_MEMORY_SCOPE_AGENT);
                                     __hip_atomic_store(tmo, 1u, __ATOMIC_RELAXED, __HIP_MEMORY_SCOPE_AGENT); }
                    dead = true; break; }
                __builtin_amdgcn_s_sleep(2);
            }
            __builtin_amdgcn_fence(__ATOMIC_ACQUIRE, "agent");
            if (lane == 0) flag[0] = dead ? 1u : 0u;
        }
        asm volatile("s_waitcnt vmcnt(0) lgkmcnt(0)" ::: "memory"); __builtin_amdgcn_s_barrier(); asm volatile("" ::: "memory");
        const bool bad = flag[0] != 0u;
        if (lane < 32) {
            const unsigned long long* slot = (const unsigned long long*)xbuf + (size_t)(u.pm * BM + row) * 4; float mt[4], m2[4]; float ms = 0.f;
#pragma unroll
            for (int t = 0; t < 4; ++t) { if (t < ntn) { const unsigned long long w = __hip_atomic_load(slot + t, __ATOMIC_RELAXED, __HIP_MEMORY_SCOPE_AGENT); mt[t] = __uint_as_float((unsigned)w); m2[t] = __uint_as_float((unsigned)(w >> 32)); } else { mt[t] = 0.f; m2[t] = 0.f; } ms += mt[t]; }
            const float mean = ms / (float)ntn; float q = 0.f;
#pragma unroll
            for (int t = 0; t < 4; ++t) if (t < ntn) { const float dm = mt[t] - mean; q += m2[t] + 256.0f * dm * dm; }
            S[row] = (f32x2v){mean, 1.0f / sqrtf(q / (256.0f * (float)ntn) + eps)};
        }
        asm volatile("s_waitcnt lgkmcnt(0)" ::: "memory"); __builtin_amdgcn_s_barrier(); asm volatile("" ::: "memory");
        return bad;
    }
};
struct EpiLnRes {
    static constexpr bool PERM = false, AFTER_DRAIN = true;
    const float* base; float* out; int ldc; const float* bias; PanelStats st; unsigned poison;
    __device__ __forceinline__ void fused(f32x4 (&acc)[2][2][4][2], const Unit& u, int wr, int wc, int fr, int fq, PG8_LAS unsigned char* lds, int wid, int lane) const {
        typedef float f32x2v __attribute__((ext_vector_type(2)));
        const PG8_LAS f32x2v* S = (const PG8_LAS f32x2v*)(lds + 8192);
        const int col0 = u.pn * BM + wc * 32 + 4 * fq;
#pragma unroll
        for (int bj = 0; bj < 2; ++bj)
#pragma unroll
            for (int n = 0; n < 2; ++n) { const f32x4 bv = bias ? *(const f32x4*)(bias + col0 + bj * HALF + n * 16) : (f32x4){0.f, 0.f, 0.f, 0.f};
#pragma unroll
                for (int ai = 0; ai < 2; ++ai)
#pragma unroll
                    for (int m = 0; m < 4; ++m) acc[ai][bj][m][n] += bv; }
        f32x4 pre[4][2][2];
#pragma unroll
        for (int m = 0; m < 4; ++m) { const size_t off = (size_t)(u.pm * BM + wr * 64 + m * 16 + fr) * ldc + col0;
#pragma unroll
            for (int bj = 0; bj < 2; ++bj)
#pragma unroll
                for (int n = 0; n < 2; ++n) pre[m][bj][n] = *(const f32x4*)(base + off + bj * HALF + n * 16); }
        const bool bad = st.run(acc, u, wr, wc, fr, fq, lds, wid, lane) || poison != 0u;
        const float qnan = __builtin_nanf("");
#pragma unroll
        for (int ai = 0; ai < 2; ++ai)
#pragma unroll
            for (int m = 0; m < 4; ++m) { const int r = ai * HALF + wr * 64 + m * 16 + fr; const f32x2v sr = S[r]; const size_t off = (size_t)(u.pm * BM + r) * ldc + col0;
#pragma unroll
                for (int bj = 0; bj < 2; ++bj)
#pragma unroll
                    for (int n = 0; n < 2; ++n) { const f32x4 bs = ai == 0 ? pre[m][bj][n] : *(const f32x4*)(base + off + bj * HALF + n * 16); f32x4 o = bs + (acc[ai][bj][m][n] - sr.x) * sr.y;
                        if (bad) o = (f32x4){qnan, qnan, qnan, qnan}; *(f32x4*)(out + off + bj * HALF + n * 16) = o; }
                if (m & 1) asm volatile("" ::: "memory"); }
    }
};
struct EpiLnResLn {
    static constexpr bool PERM = false, AFTER_DRAIN = true;
    const float* base; float* out; bf16_t* xn; int ldc; const float* bias; PanelStats st1, st2; unsigned poison;
    __device__ __forceinline__ void fused(f32x4 (&acc)[2][2][4][2], const Unit& u, int wr, int wc, int fr, int fq, PG8_LAS unsigned char* lds, int wid, int lane) const {
        typedef float f32x2v __attribute__((ext_vector_type(2))); typedef unsigned u32x2v __attribute__((ext_vector_type(2)));
        const PG8_LAS f32x2v* S = (const PG8_LAS f32x2v*)(lds + 8192);
        const int col0 = u.pn * BM + wc * 32 + 4 * fq;
#pragma unroll
        for (int bj = 0; bj < 2; ++bj)
#pragma unroll
            for (int n = 0; n < 2; ++n) { const f32x4 bv = bias ? *(const f32x4*)(bias + col0 + bj * HALF + n * 16) : (f32x4){0.f, 0.f, 0.f, 0.f};
#pragma unroll
                for (int ai = 0; ai < 2; ++ai)
#pragma unroll
                    for (int m = 0; m < 4; ++m) acc[ai][bj][m][n] += bv; }
        bool bad = st1.run(acc, u, wr, wc, fr, fq, lds, wid, lane) || poison != 0u;
        const float qnan = __builtin_nanf("");
#pragma unroll
        for (int ai = 0; ai < 2; ++ai)
#pragma unroll
            for (int m = 0; m < 4; ++m) { const int r = ai * HALF + wr * 64 + m * 16 + fr; const f32x2v sr = S[r]; const size_t off = (size_t)(u.pm * BM + r) * ldc + col0;
#pragma unroll
                for (int bj = 0; bj < 2; ++bj)
#pragma unroll
                    for (int n = 0; n < 2; ++n) { const f32x4 bs = *(const f32x4*)(base + off + bj * HALF + n * 16); acc[ai][bj][m][n] = bs + (acc[ai][bj][m][n] - sr.x) * sr.y; }
                asm volatile("" : "+v"(acc[ai][0][m][0]), "+v"(acc[ai][0][m][1]), "+v"(acc[ai][1][m][0]), "+v"(acc[ai][1][m][1]));
                if (m & 1) asm volatile("" ::: "memory"); }
        const bool bad1 = bad;
        bad = st2.run(acc, u, wr, wc, fr, fq, lds, wid, lane) || bad;
#pragma unroll
        for (int ai = 0; ai < 2; ++ai)
#pragma unroll
            for (int m = 0; m < 4; ++m) { const int r = ai * HALF + wr * 64 + m * 16 + fr; const f32x2v sr = S[r]; const size_t off = (size_t)(u.pm * BM + r) * ldc + col0;
#pragma unroll
                for (int bj = 0; bj < 2; ++bj)
#pragma unroll
                    for (int n = 0; n < 2; ++n) { const f32x4 x1 = acc[ai][bj][m][n]; *(f32x4*)(out + off + bj * HALF + n * 16) = bad1 ? (f32x4){qnan, qnan, qnan, qnan} : x1;
                        const f32x4 o = (x1 - sr.x) * sr.y; u32x2v w; w.x = cvt_pk_bf16(o[0], o[1]); w.y = cvt_pk_bf16(o[2], o[3]);
                        if (bad) { w.x = 0x7fc07fc0u; w.y = 0x7fc07fc0u; } *(u32x2v*)(xn + off + bj * HALF + n * 16) = w; }
                asm volatile("" ::: "memory"); }
    }
};

template <class Epi, class Sched, bool ALIGN_EPI = false, bool SP2 = false>
__device__ __forceinline__ void gemm_phase(PG8_LAS unsigned char* lds, const Gemm g, const Sched& S, const Epi& E, const int wid_in) {
    int lane_; asm volatile("v_mbcnt_lo_u32_b32 %0, -1, 0\n\tv_mbcnt_hi_u32_b32 %0, -1, %0" : "=v"(lane_));
    const int wid = __builtin_amdgcn_readfirstlane(wid_in), lane = lane_, tid = wid * 64 + lane, wr = wid >> 2, wc = wid & 3, fr = lane & 15, fq = lane >> 4;
    const int K = g.K, nt = K / BK;
    unsigned voffA[2], voffB[2];
#pragma unroll
    for (int i = 0; i < 2; ++i) { int R, C; stage_rc(tid * 16 + i * 8192, R, C); const int Rb = Epi::PERM ? ((R & ~31) + perm32(R & 31)) : R;
        voffA[i] = (unsigned)(R * K + C) * 2u; voffB[i] = (unsigned)(Rb * K + C) * 2u; }
    const size_t kstep = (size_t)(BK * 2);
    const size_t hstep = (size_t)HALF * K * 2;
    const size_t tstep = 2 * hstep;
    const unsigned ldsw = (unsigned)wid * 1024u;
    const int aoff = lds_byte(wr * 64 + fr, fq * 8), boff = lds_byte(wc * 32 + fr, fq * 8);
#define PG8_SA(b, h) (((b) * 2 + (h)) * HTB)
#define PG8_SB(b, h) ((4 + (b) * 2 + (h)) * HTB)
#define PG8_STAGE(bufoff, gbase, voff) do { _Pragma("unroll") for (int _i = 0; _i < 2; ++_i) \
        __builtin_amdgcn_global_load_lds((const unsigned*)((const char*)(gbase) + (voff)[_i]), (PG8_LAS unsigned*)(lds + (bufoff) + ldsw + _i * 8192), 16, 0, 0); } while (0)
#define PG8_LDA(dst, b, h) do { _Pragma("unroll") for (int m = 0; m < 4; ++m) _Pragma("unroll") for (int k = 0; k < 2; ++k) dst[m][k] = *(const PG8_LAS bf16x8*)(lds + PG8_SA(b, h) + aoff + m * 2048 + k * 1024); } while (0)
#define PG8_LDB(dst, b, h) do { _Pragma("unroll") for (int n = 0; n < 2; ++n) _Pragma("unroll") for (int k = 0; k < 2; ++k) dst[n][k] = *(const PG8_LAS bf16x8*)(lds + PG8_SB(b, h) + boff + n * 2048 + k * 1024); } while (0)
#define PG8_MMA(ai, bj, At, Bt) do { __builtin_amdgcn_s_setprio(1); _Pragma("unroll") for (int m = 0; m < 4; ++m) _Pragma("unroll") for (int n = 0; n < 2; ++n) _Pragma("unroll") for (int k = 0; k < 2; ++k) \
        acc[ai][bj][m][n] = __builtin_amdgcn_mfma_f32_16x16x32_bf16(Bt[n][k], At[m][k], acc[ai][bj][m][n], 0, 0, 0); __builtin_amdgcn_s_setprio(0); } while (0)
#define PG8_WAIT_V(n) asm volatile("s_waitcnt vmcnt(" #n ")" ::: "memory")
#define PG8_WAIT_L(n) asm volatile("s_waitcnt lgkmcnt(" #n ")" ::: "memory")
#define PG8_BAR __builtin_amdgcn_s_barrier()
#define PG8_SCHED __builtin_amdgcn_sched_barrier(0)
    Unit cur, nxt; int ui = 0;
    if (!S.next(0, cur)) return;
    f32x4 acc[2][2][4][2];
#pragma unroll
    for (int a = 0; a < 2; ++a)
#pragma unroll
        for (int b = 0; b < 2; ++b)
#pragma unroll
            for (int m = 0; m < 4; ++m)
#pragma unroll
                for (int n = 0; n < 2; ++n) acc[a][b][m][n] = (f32x4){0.f, 0.f, 0.f, 0.f};
    bf16x8 At[4][2], B0[2][2], B1[2][2];
    const char* cA = (const char*)g.A + (size_t)cur.pm * tstep + (size_t)(cur.pn / g.asel_div) * g.asel_stride; const char* cB = (const char*)g.Bt + (size_t)cur.pn * tstep;
    S.a_ready(cur);
    if constexpr (SP2) {
        PG8_STAGE(PG8_SB(0, 0), cB, voffB); PG8_STAGE(PG8_SB(0, 1), cB + hstep, voffB); PG8_STAGE(PG8_SA(0, 0), cA, voffA); PG8_STAGE(PG8_SA(0, 1), cA + hstep, voffA);
        if (wr == 1) PG8_BAR;
        PG8_WAIT_V(2); PG8_BAR;
        PG8_STAGE(PG8_SB(1, 0), cB + kstep, voffB); PG8_STAGE(PG8_SA(1, 0), cA + kstep, voffA); PG8_STAGE(PG8_SB(1, 1), cB + hstep + kstep, voffB);
        PG8_WAIT_V(6); PG8_BAR;
    } else {
        PG8_STAGE(PG8_SB(0, 0), cB, voffB); PG8_STAGE(PG8_SA(0, 0), cA, voffA); PG8_STAGE(PG8_SB(0, 1), cB + hstep, voffB); PG8_STAGE(PG8_SA(0, 1), cA + hstep, voffA);
        if (wr == 1) PG8_BAR;
        PG8_WAIT_V(4); PG8_BAR;
        PG8_STAGE(PG8_SB(1, 0), cB + kstep, voffB); PG8_STAGE(PG8_SA(1, 0), cA + kstep, voffA); PG8_STAGE(PG8_SB(1, 1), cB + hstep + kstep, voffB);
        PG8_WAIT_V(6); PG8_BAR;
    }
    for (;;) {
        const bool has_next = S.next(ui + 1, nxt);
        const char* nA = has_next ? (const char*)g.A + (size_t)nxt.pm * tstep + (size_t)(nxt.pn / g.asel_div) * g.asel_stride : cA; const char* nB = has_next ? (const char*)g.Bt + (size_t)nxt.pn * tstep : cB;
#pragma unroll 1
        for (int t = 0; t < nt; t += 2) {
            const bool last = (t == nt - 2);
            const char* a1 = cA + (size_t)(t + 1) * kstep;
            const char* a2 = last ? nA : cA + (size_t)(t + 2) * kstep; const char* b2 = last ? nB : cB + (size_t)(t + 2) * kstep;
            const char* a3 = a2 + kstep; const char* b3 = b2 + kstep;
            if (last && has_next) S.a_ready(nxt);
            if constexpr (SP2) {
            PG8_LDB(B0, 0, 0); PG8_LDB(B1, 0, 1); PG8_SCHED; PG8_LDA(At, 0, 0); PG8_STAGE(PG8_SA(1, 1), a1 + hstep, voffA);
            PG8_WAIT_V(8); PG8_WAIT_L(0); PG8_BAR; PG8_MMA(0, 0, At, B0); PG8_MMA(0, 1, At, B1); PG8_BAR; PG8_SCHED;
            PG8_LDA(At, 0, 1); PG8_STAGE(PG8_SB(0, 0), b2, voffB); PG8_STAGE(PG8_SB(0, 1), b2 + hstep, voffB); PG8_STAGE(PG8_SA(0, 0), a2, voffA);
            PG8_WAIT_V(8); PG8_WAIT_L(0); PG8_BAR; PG8_MMA(1, 0, At, B0); PG8_MMA(1, 1, At, B1); PG8_BAR; PG8_SCHED;
            PG8_LDB(B0, 1, 0); PG8_LDB(B1, 1, 1); PG8_SCHED; PG8_LDA(At, 1, 0); PG8_STAGE(PG8_SA(0, 1), a2 + hstep, voffA);
            PG8_WAIT_V(8); PG8_WAIT_L(0); PG8_BAR; PG8_MMA(0, 0, At, B0); PG8_MMA(0, 1, At, B1); PG8_BAR; PG8_SCHED;
            PG8_LDA(At, 1, 1); PG8_STAGE(PG8_SB(1, 0), b3, voffB); PG8_STAGE(PG8_SB(1, 1), b3 + hstep, voffB); PG8_STAGE(PG8_SA(1, 0), a3, voffA);
            PG8_WAIT_V(8); PG8_WAIT_L(0); PG8_BAR; PG8_MMA(1, 0, At, B0); PG8_MMA(1, 1, At, B1); PG8_BAR; PG8_SCHED;
            } else {
            PG8_LDB(B0, 0, 0); PG8_SCHED; PG8_LDA(At, 0, 0); PG8_STAGE(PG8_SA(1, 1), a1 + hstep, voffA);
            PG8_WAIT_L(8); PG8_BAR; PG8_WAIT_L(0); PG8_MMA(0, 0, At, B0); PG8_BAR; PG8_SCHED;
            PG8_LDB(B1, 0, 1); PG8_STAGE(PG8_SB(0, 0), b2, voffB);
            PG8_BAR; PG8_WAIT_L(0); PG8_MMA(0, 1, At, B1); PG8_BAR;
            PG8_LDA(At, 0, 1); PG8_STAGE(PG8_SA(0, 0), a2, voffA);
            PG8_BAR; PG8_WAIT_L(0); PG8_MMA(1, 0, At, B0); PG8_BAR; PG8_SCHED;
            PG8_STAGE(PG8_SB(0, 1), b2 + hstep, voffB);
            PG8_WAIT_V(6); PG8_BAR; PG8_MMA(1, 1, At, B1); PG8_BAR;
            PG8_LDB(B0, 1, 0); PG8_SCHED; PG8_LDA(At, 1, 0); PG8_STAGE(PG8_SA(0, 1), a2 + hstep, voffA);
            PG8_WAIT_L(8); PG8_BAR; PG8_WAIT_L(0); PG8_MMA(0, 0, At, B0); PG8_BAR; PG8_SCHED;
            PG8_LDB(B1, 1, 1); PG8_STAGE(PG8_SB(1, 0), b3, voffB);
            PG8_BAR; PG8_WAIT_L(0); PG8_MMA(0, 1, At, B1); PG8_BAR;
            PG8_LDA(At, 1, 1); PG8_STAGE(PG8_SA(1, 0), a3, voffA);
            PG8_BAR; PG8_WAIT_L(0); PG8_MMA(1, 0, At, B0); PG8_BAR; PG8_SCHED;
            PG8_STAGE(PG8_SB(1, 1), b3 + hstep, voffB);
            PG8_WAIT_V(6); PG8_BAR; PG8_MMA(1, 1, At, B1); PG8_BAR;
            }
        }
        if constexpr (ALIGN_EPI) { if (wr == 0) PG8_BAR; }
        if constexpr (!Epi::AFTER_DRAIN) { E(acc, cur, wr, wc, fr, fq); S.done(cur); }
        if (!has_next) break;
#pragma unroll
        for (int a = 0; a < 2; ++a)
#pragma unroll
            for (int b = 0; b < 2; ++b)
#pragma unroll
                for (int m = 0; m < 4; ++m)
#pragma unroll
                    for (int n = 0; n < 2; ++n) acc[a][b][m][n] = (f32x4){0.f, 0.f, 0.f, 0.f};
        cur = nxt; cA = nA; cB = nB; ++ui;
        if constexpr (ALIGN_EPI) { if (wr == 1) PG8_BAR; }
    }
    PG8_WAIT_V(0);
    if constexpr (!ALIGN_EPI) { if (wr == 0) PG8_BAR; }
    PG8_BAR;
    if constexpr (Epi::AFTER_DRAIN) { E.fused(acc, cur, wr, wc, fr, fq, lds, wid, lane); S.done(cur); }
#undef PG8_SA
#undef PG8_SB
#undef PG8_STAGE
#undef PG8_LDA
#undef PG8_LDB
#undef PG8_MMA
#undef PG8_WAIT_V
#undef PG8_WAIT_L
#undef PG8_BAR
#undef PG8_SCHED
}
}
namespace pg8 {
__device__ __forceinline__ void glds_sv(const void* sbase, unsigned voff, unsigned lds_dst) { unsigned keep;
    asm volatile("s_mov_b32 %0, m0\n\ts_mov_b32 m0, %3\n\ts_nop 0\n\tglobal_load_lds_dwordx4 %1, %2\n\ts_mov_b32 m0, %0" : "=&s"(keep) : "v"(voff), "s"(sbase), "s"(lds_dst) : "memory"); }
typedef int i32x4_t __attribute__((ext_vector_type(4))); typedef int i32x8_t __attribute__((ext_vector_type(8)));
template <class Epi, class Sched, bool ALIGN_EPI = false, bool SP2 = false, bool F8 = false>
__device__ __forceinline__ void gemm_phase_g(PG8_LAS unsigned char* lds, const Gemm g, const Sched& S, const Epi& E, const int wid_in) {
    int lane_; asm volatile("v_mbcnt_lo_u32_b32 %0, -1, 0\n\tv_mbcnt_hi_u32_b32 %0, -1, %0" : "=v"(lane_));
    const int wid = __builtin_amdgcn_readfirstlane(wid_in), lane = lane_, tid = wid * 64 + lane, wr = wid >> 2, wc = wid & 3, fr = lane & 15, fq = lane >> 4;
    const int K = g.K, nt = K / BK;
    unsigned voffB[2]; int RA[2], CA[2];
#pragma unroll
    for (int i = 0; i < 2; ++i) { int R, C; stage_rc(tid * 16 + i * 8192, R, C); const int Rb = Epi::PERM ? ((R & ~31) + perm32(R & 31)) : R;
        RA[i] = R; CA[i] = C * 2; voffB[i] = (unsigned)(Rb * K + C) * 2u; }
    unsigned vAc[2][2];
    const size_t kstep = (size_t)(BK * 2);
    const size_t hstep = (size_t)HALF * K * 2;
    const size_t tstep = 2 * hstep;
    const unsigned ldsw = (unsigned)wid * 1024u;
    const int aoff = lds_byte(wr * 64 + fr, fq * 8), boff = lds_byte(wc * 32 + fr, fq * 8);
#define PG8_SA(b, h) (((b) * 2 + (h)) * HTB)
#define PG8_SB(b, h) ((4 + (b) * 2 + (h)) * HTB)
#define PG8_LDSADDR(bufoff, i_) ((unsigned)__builtin_amdgcn_readfirstlane((int)(unsigned)(unsigned long long)(lds + (bufoff) + ldsw + (i_) * 8192)))
#define PG8_STAGE(bufoff, gbase, voff) do { _Pragma("unroll") for (int _i = 0; _i < 2; ++_i) glds_sv((const void*)(gbase), (voff)[_i], PG8_LDSADDR(bufoff, _i)); } while (0)
#define PG8_STAGE_A(bufoff, va, h_, kb_) do { _Pragma("unroll") for (int _i = 0; _i < 2; ++_i) glds_sv((const void*)((const char*)g.A + (size_t)(kb_)), (va)[h_][_i], PG8_LDSADDR(bufoff, _i)); } while (0)
#define PG8_LD8(p_) __builtin_shufflevector(*(const PG8_LAS i32x4_t*)(p_), *(const PG8_LAS i32x4_t*)((p_) + 1024), 0, 1, 2, 3, 4, 5, 6, 7)
#define PG8_LDA(dst, b, h) do { _Pragma("unroll") for (int m = 0; m < 4; ++m) dst[m] = PG8_LD8(lds + PG8_SA(b, h) + aoff + m * 2048); } while (0)
#define PG8_LDB(dst, b, h) do { _Pragma("unroll") for (int n = 0; n < 2; ++n) dst[n] = PG8_LD8(lds + PG8_SB(b, h) + boff + n * 2048); } while (0)
#define PG8_HALF(f_, k_) __builtin_bit_cast(bf16x8, (k_) == 0 ? __builtin_shufflevector((f_), (f_), 0, 1, 2, 3) : __builtin_shufflevector((f_), (f_), 4, 5, 6, 7))
#define PG8_MMA(ai, bj, At, Bt) do { __builtin_amdgcn_s_setprio(1); _Pragma("unroll") for (int m = 0; m < 4; ++m) _Pragma("unroll") for (int n = 0; n < 2; ++n) { \
        if constexpr (F8) acc[ai][bj][m][n] = __builtin_amdgcn_mfma_scale_f32_16x16x128_f8f6f4(Bt[n], At[m], acc[ai][bj][m][n], 0, 0, 0, 0x7F7F7F7F, 0, 0x7F7F7F7F); \
        else { acc[ai][bj][m][n] = __builtin_amdgcn_mfma_f32_16x16x32_bf16(PG8_HALF(Bt[n], 0), PG8_HALF(At[m], 0), acc[ai][bj][m][n], 0, 0, 0); \
               acc[ai][bj][m][n] = __builtin_amdgcn_mfma_f32_16x16x32_bf16(PG8_HALF(Bt[n], 1), PG8_HALF(At[m], 1), acc[ai][bj][m][n], 0, 0, 0); } } __builtin_amdgcn_s_setprio(0); } while (0)
#define PG8_WAIT_V(n) asm volatile("s_waitcnt vmcnt(" #n ")" ::: "memory")
#define PG8_WAIT_L(n) asm volatile("s_waitcnt lgkmcnt(" #n ")" ::: "memory")
#define PG8_BAR __builtin_amdgcn_s_barrier()
#define PG8_SCHED __builtin_amdgcn_sched_barrier(0)
    typename Sched::UnitT cur, nxt; int ui = 0;
    if (!S.next(0, cur)) return;
    f32x4 acc[2][2][4][2];
#pragma unroll
    for (int a = 0; a < 2; ++a)
#pragma unroll
        for (int b = 0; b < 2; ++b)
#pragma unroll
            for (int m = 0; m < 4; ++m)
#pragma unroll
                for (int n = 0; n < 2; ++n) acc[a][b][m][n] = (f32x4){0.f, 0.f, 0.f, 0.f};
    i32x8_t At[4], B0[2], B1[2];
    const char* cB = S.bbase(cur) + (size_t)cur.pn * tstep;
    S.a_ready(cur);
#pragma unroll
    for (int h_ = 0; h_ < 2; ++h_)
#pragma unroll
        for (int i_ = 0; i_ < 2; ++i_) vAc[h_][i_] = S.a_off(cur, h_ * HALF + RA[i_]) + (unsigned)CA[i_];
    if constexpr (SP2) {
        PG8_STAGE(PG8_SB(0, 0), cB, voffB); PG8_STAGE(PG8_SB(0, 1), cB + hstep, voffB); PG8_STAGE_A(PG8_SA(0, 0), vAc, 0, 0); PG8_STAGE_A(PG8_SA(0, 1), vAc, 1, 0);
        if (wr == 1) PG8_BAR;
        PG8_WAIT_V(2); PG8_BAR;
        PG8_STAGE(PG8_SB(1, 0), cB + kstep, voffB); PG8_STAGE_A(PG8_SA(1, 0), vAc, 0, kstep); PG8_STAGE(PG8_SB(1, 1), cB + hstep + kstep, voffB);
        PG8_WAIT_V(6); PG8_BAR;
    } else {
        PG8_STAGE(PG8_SB(0, 0), cB, voffB); PG8_STAGE_A(PG8_SA(0, 0), vAc, 0, 0); PG8_STAGE(PG8_SB(0, 1), cB + hstep, voffB); PG8_STAGE_A(PG8_SA(0, 1), vAc, 1, 0);
        if (wr == 1) PG8_BAR;
        PG8_WAIT_V(4); PG8_BAR;
        PG8_STAGE(PG8_SB(1, 0), cB + kstep, voffB); PG8_STAGE_A(PG8_SA(1, 0), vAc, 0, kstep); PG8_STAGE(PG8_SB(1, 1), cB + hstep + kstep, voffB);
        PG8_WAIT_V(6); PG8_BAR;
    }
    for (;;) {
        const bool has_next = S.next(ui + 1, nxt);
        const char* nB = has_next ? S.bbase(nxt) + (size_t)nxt.pn * tstep : cB;
#pragma unroll 1
        for (int t = 0; t < nt; t += 2) {
            const bool last = (t == nt - 2);
            const size_t k1 = (size_t)(t + 1) * kstep, k2 = last ? 0 : (size_t)(t + 2) * kstep, k3 = k2 + kstep;
            unsigned vA2[2][2];
#pragma unroll
            for (int h_ = 0; h_ < 2; ++h_)
#pragma unroll
                for (int i_ = 0; i_ < 2; ++i_) vA2[h_][i_] = (last && has_next) ? S.a_off(nxt, h_ * HALF + RA[i_]) + (unsigned)CA[i_] : vAc[h_][i_];
            const char* b2 = last ? nB : cB + (size_t)(t + 2) * kstep; const char* b3 = b2 + kstep;
            if (last && has_next) S.a_ready(nxt);
            if constexpr (SP2) {
            PG8_LDB(B0, 0, 0); PG8_LDB(B1, 0, 1); PG8_SCHED; PG8_LDA(At, 0, 0); PG8_STAGE_A(PG8_SA(1, 1), vAc, 1, k1);
            PG8_WAIT_V(8); PG8_WAIT_L(0); PG8_BAR; PG8_MMA(0, 0, At, B0); PG8_MMA(0, 1, At, B1); PG8_BAR; PG8_SCHED;
            PG8_LDA(At, 0, 1); PG8_STAGE(PG8_SB(0, 0), b2, voffB); PG8_STAGE(PG8_SB(0, 1), b2 + hstep, voffB); PG8_STAGE_A(PG8_SA(0, 0), vA2, 0, k2);
            PG8_WAIT_V(8); PG8_WAIT_L(0); PG8_BAR; PG8_MMA(1, 0, At, B0); PG8_MMA(1, 1, At, B1); PG8_BAR; PG8_SCHED;
            PG8_LDB(B0, 1, 0); PG8_LDB(B1, 1, 1); PG8_SCHED; PG8_LDA(At, 1, 0); PG8_STAGE_A(PG8_SA(0, 1), vA2, 1, k2);
            PG8_WAIT_V(8); PG8_WAIT_L(0); PG8_BAR; PG8_MMA(0, 0, At, B0); PG8_MMA(0, 1, At, B1); PG8_BAR; PG8_SCHED;
            PG8_LDA(At, 1, 1); PG8_STAGE(PG8_SB(1, 0), b3, voffB); PG8_STAGE(PG8_SB(1, 1), b3 + hstep, voffB); PG8_STAGE_A(PG8_SA(1, 0), vA2, 0, k3);
            PG8_WAIT_V(8); PG8_WAIT_L(0); PG8_BAR; PG8_MMA(1, 0, At, B0); PG8_MMA(1, 1, At, B1); PG8_BAR; PG8_SCHED;
            } else {
            PG8_LDB(B0, 0, 0); PG8_SCHED; PG8_LDA(At, 0, 0); PG8_STAGE_A(PG8_SA(1, 1), vAc, 1, k1);
            PG8_WAIT_L(8); PG8_BAR; PG8_WAIT_L(0); PG8_MMA(0, 0, At, B0); PG8_BAR; PG8_SCHED;
            PG8_LDB(B1, 0, 1); PG8_STAGE(PG8_SB(0, 0), b2, voffB);
            PG8_BAR; PG8_WAIT_L(0); PG8_MMA(0, 1, At, B1); PG8_BAR;
            PG8_LDA(At, 0, 1); PG8_STAGE_A(PG8_SA(0, 0), vA2, 0, k2);
            PG8_BAR; PG8_WAIT_L(0); PG8_MMA(1, 0, At, B0); PG8_BAR; PG8_SCHED;
            PG8_STAGE(PG8_SB(0, 1), b2 + hstep, voffB);
            PG8_WAIT_V(6); PG8_BAR; PG8_MMA(1, 1, At, B1); PG8_BAR;
            PG8_LDB(B0, 1, 0); PG8_SCHED; PG8_LDA(At, 1, 0); PG8_STAGE_A(PG8_SA(0, 1), vA2, 1, k2);
            PG8_WAIT_L(8); PG8_BAR; PG8_WAIT_L(0); PG8_MMA(0, 0, At, B0); PG8_BAR; PG8_SCHED;
            PG8_LDB(B1, 1, 1); PG8_STAGE(PG8_SB(1, 0), b3, voffB);
            PG8_BAR; PG8_WAIT_L(0); PG8_MMA(0, 1, At, B1); PG8_BAR;
            PG8_LDA(At, 1, 1); PG8_STAGE_A(PG8_SA(1, 0), vA2, 0, k3);
            PG8_BAR; PG8_WAIT_L(0); PG8_MMA(1, 0, At, B0); PG8_BAR; PG8_SCHED;
            PG8_STAGE(PG8_SB(1, 1), b3 + hstep, voffB);
            PG8_WAIT_V(6); PG8_BAR; PG8_MMA(1, 1, At, B1); PG8_BAR;
            }
        }
        if constexpr (ALIGN_EPI) { if (wr == 0) PG8_BAR; }
        if constexpr (!Epi::AFTER_DRAIN) { E(acc, cur, wr, wc, fr, fq); S.done(cur); }
        if (!has_next) break;
#pragma unroll
        for (int a = 0; a < 2; ++a)
#pragma unroll
            for (int b = 0; b < 2; ++b)
#pragma unroll
                for (int m = 0; m < 4; ++m)
#pragma unroll
                    for (int n = 0; n < 2; ++n) acc[a][b][m][n] = (f32x4){0.f, 0.f, 0.f, 0.f};
        cur = nxt; cB = nB; ++ui;
#pragma unroll
        for (int h_ = 0; h_ < 2; ++h_)
#pragma unroll
            for (int i_ = 0; i_ < 2; ++i_) vAc[h_][i_] = S.a_off(cur, h_ * HALF + RA[i_]) + (unsigned)CA[i_];
        if constexpr (ALIGN_EPI) { if (wr == 1) PG8_BAR; }
    }
    PG8_WAIT_V(0);
    if constexpr (!ALIGN_EPI) { if (wr == 0) PG8_BAR; }
    PG8_BAR;
    if constexpr (Epi::AFTER_DRAIN) { E.fused(acc, cur, wr, wc, fr, fq, lds, wid, lane); S.done(cur); }
#undef PG8_SA
#undef PG8_SB
#undef PG8_STAGE
#undef PG8_STAGE_A
#undef PG8_LDSADDR
#undef PG8_LDA
#undef PG8_LDB
#undef PG8_MMA
#undef PG8_LD8
#undef PG8_HALF
#undef PG8_WAIT_V
#undef PG8_WAIT_L
#undef PG8_BAR
#undef PG8_SCHED
}
}
__device__ __forceinline__ int hw_lane() { int l; asm volatile("v_mbcnt_lo_u32_b32 %0, -1, 0\n\tv_mbcnt_hi_u32_b32 %0, -1, %0" : "=v"(l)); return l; }
#define GAS __attribute__((address_space(1)))
#define LAS __attribute__((address_space(3)))
typedef unsigned short bf16;
typedef unsigned v4u __attribute__((ext_vector_type(4)));
typedef float f32x4 __attribute__((ext_vector_type(4)));
typedef short bf16x8 __attribute__((ext_vector_type(8)));
typedef GAS unsigned gu32;
typedef GAS unsigned long long gu64;
#define RLX_AGENT __ATOMIC_RELAXED, __HIP_MEMORY_SCOPE_AGENT
#define LDS_WAIT() asm volatile("s_waitcnt lgkmcnt(0)" ::: "memory")
#define VM_WAIT() asm volatile("s_waitcnt vmcnt(0)" ::: "memory")
__device__ __forceinline__ unsigned long long rt() { return __builtin_amdgcn_s_memrealtime(); }
__device__ __forceinline__ unsigned f2bf(float f) { unsigned u = __builtin_bit_cast(unsigned, f); return (u + 0x7fffu + ((u >> 16) & 1u)) >> 16; }
__device__ __forceinline__ unsigned pk2(float lo, float hi) { return f2bf(lo) | (f2bf(hi) << 16); }

#define XB_TMO      128
#define XB_XCNT(j)  (256  + 64 * (j))
#define XB_XSUB(j)  (1280 + 64 * (j))
#define XB_XGEN(j)  (2304 + 64 * (j))
#define XB_TOP      3328
#define XB_TOPGEN   3392
#define XCD_BAR_WORDS 3456
#define XB_SPIN_CAP (1u << 18)

__device__ __forceinline__ unsigned xb_ld(unsigned* p)              { return __hip_atomic_load(p, __ATOMIC_RELAXED, __HIP_MEMORY_SCOPE_AGENT); }
__device__ __forceinline__ unsigned xb_add(unsigned* p, unsigned v) { return __hip_atomic_fetch_add(p, v, __ATOMIC_RELAXED, __HIP_MEMORY_SCOPE_AGENT); }
__device__ __forceinline__ unsigned xb_xcc_id() { return (unsigned)__builtin_amdgcn_s_getreg((3 << 11) | 20) & 0xFu; }
#define XB_SPIN(cond, bar) do { unsigned _sp = 0; while (cond) { __builtin_amdgcn_s_sleep(1); \
    if ((++_sp & 255u) == 0u) { if (xb_ld(&(bar)[XB_TMO])) break; if (_sp > XB_SPIN_CAP) { atomicAdd(&(bar)[XB_TMO], 1u); break; } } } } while (0)

struct XcdBarrier {
    unsigned* bar; unsigned x;
    volatile LAS unsigned* st;
};

__device__ __forceinline__ XcdBarrier xcd_barrier_post(unsigned* bar, volatile LAS unsigned* st) {
    XcdBarrier b; b.bar = bar; b.x = xb_xcc_id(); b.st = st;
    if (threadIdx.x == 0) (void)xb_add(&bar[XB_XCNT(b.x)], 1u);
    return b;
}
__device__ __forceinline__ void xcd_barrier_complete(unsigned* bar, unsigned x, unsigned& nloc, unsigned& nx) {
    const unsigned G = gridDim.x * gridDim.y * gridDim.z;
    unsigned sum, cnt, mine, sp = 0u;
    for (;;) {
        sum = 0u; cnt = 0u; mine = 0u;
#pragma unroll
        for (unsigned j = 0; j < 16; ++j) { const unsigned c = xb_ld(&bar[XB_XCNT(j)]); sum += c; cnt += (c > 0u) ? 1u : 0u; mine = (j == x) ? c : mine; }
        if (sum == G) break;
        __builtin_amdgcn_s_sleep(1);
        if ((++sp & 255u) == 0u) { if (xb_ld(&bar[XB_TMO])) break; if (sp > XB_SPIN_CAP) { atomicAdd(&bar[XB_TMO], 1u); break; } }
    }
    nloc = mine > 0u ? mine : 1u; nx = cnt > 0u ? cnt : 1u;
}

__device__ __forceinline__ void xcd_barrier(const XcdBarrier& b, const bool is_t0) {
    asm volatile("s_waitcnt vmcnt(0)" ::: "memory");
    __syncthreads();
    if (is_t0) {
        unsigned* bar = b.bar;
        __builtin_amdgcn_s_waitcnt(0);
        unsigned nloc = b.st[0], nx = b.st[1];
        if (nloc == 0u) { xcd_barrier_complete(bar, b.x, nloc, nx); b.st[0] = nloc; b.st[1] = nx; }
        const unsigned old = xb_add(&bar[XB_XSUB(b.x)], 1u);
        const unsigned gen = old / nloc;
        if (old + 1u == (gen + 1u) * nloc) {
            __builtin_amdgcn_fence(__ATOMIC_RELEASE, "agent");
            asm volatile("s_waitcnt vmcnt(0)" ::: "memory");
            const unsigned og = xb_add(&bar[XB_TOP], 1u);
            const unsigned tg = og / nx;
            if (og + 1u == (tg + 1u) * nx) xb_add(&bar[XB_TOPGEN], 1u);
            else XB_SPIN(xb_ld(&bar[XB_TOPGEN]) == tg, bar);
            __builtin_amdgcn_fence(__ATOMIC_ACQUIRE, "agent");
            xb_add(&bar[XB_XGEN(b.x)], 1u);
            asm volatile("s_waitcnt vmcnt(0)" ::: "memory");
        } else {
            XB_SPIN(xb_ld(&bar[XB_XGEN(b.x)]) == gen, bar);
            __builtin_amdgcn_fence(__ATOMIC_ACQUIRE, "agent");
            asm volatile("s_waitcnt vmcnt(0)" ::: "memory");
        }
    }
    __syncthreads();
}

namespace fk {
using pg8::bf16_t; using pg8::f32x4; using pg8::u32x4; using pg8::Unit; using pg8::BM; using pg8::HALF;
constexpr int NWAVES = 8, NTHR = 512;
constexpr int NB = 4, T = 8192, D = 1024, H = 16, HD = 64, M = NB * T, NE = 256, FX = 256;
constexpr float ALPHA = 1.4142135623730951f, LN_EPS = 1e-5f;
constexpr size_t MiB = 1u << 20;
constexpr size_t WS_CTL = 0, CTL_ZERO_BYTES = 1 * MiB;
constexpr size_t WS_MOD = 1 * MiB;
constexpr size_t WS_WRKV = 2 * MiB, WS_B1T = 8 * MiB, WS_B2T = 9 * MiB, WS_WO0 = 11 * MiB, WS_RT0 = 13 * MiB, WS_SGU0 = 15 * MiB, WS_SD0 = 16 * MiB,
                 WS_KVT = 17 * MiB, WS_QGT = 21 * MiB, WS_WO1 = 25 * MiB, WS_RT1 = 27 * MiB, WS_SGU1 = 29 * MiB, WS_SD1 = 30 * MiB;
constexpr size_t WS_EGU = 32 * MiB, EGU_L = 256 * MiB, WS_ED = 544 * MiB, ED_L = 128 * MiB;
constexpr size_t WS_XR = 800 * MiB, WS_XK = 864 * MiB, WS_XV = 928 * MiB, WS_HX = 992 * MiB;
constexpr size_t WS_R = 1120 * MiB, WS_K = 1184 * MiB, WS_V = 1248 * MiB, WS_L1 = 1312 * MiB, WS_LW = 1328 * MiB, WS_A = 1456 * MiB, WS_G = 1520 * MiB, WS_BONUS = 1584 * MiB;
constexpr size_t WS_PT = 800 * MiB, WS_RTL = 864 * MiB, WS_Q = 928 * MiB, WS_YL = 992 * MiB, WS_Y = 1056 * MiB, WS_Z = 1120 * MiB, WS_PRE = 1328 * MiB;
constexpr size_t WS_X1 = 1600 * MiB, WS_H2 = 1728 * MiB, WS_LOGITS = 1792 * MiB, WS_IDX = 1824 * MiB, WS_GW = 1825 * MiB, WS_LIST = 1826 * MiB, WS_HB = 1858 * MiB;
constexpr size_t WS_ACT = 800 * MiB, WS_ACTS = 928 * MiB, WS_OUTROW = 944 * MiB, WS_YS = 1456 * MiB, WS_XB = 1520 * MiB;
constexpr size_t WS_KN = 800 * MiB, WS_VV = 864 * MiB, WS_QN = 928 * MiB, WS_GATE = 992 * MiB, WS_LOGF = 1586 * MiB, WS_FLOC = 1588 * MiB, WS_FTOT = 1590 * MiB, WS_O = 1064 * MiB;
constexpr size_t WS_FAST_END = 1954 * MiB, WS_H2F8 = 1922 * MiB;
constexpr float F8_SA = 16.f, F8_SB = 256.f;
constexpr int CW_TMO = 0, CW_CODE = 1, CW_BAR = 4096, CW_CNT = 16384  , CW_DBG = 32768, CW_TS = 40960;
constexpr int RING_BYTES = 131072, LDSCTL_OFF = RING_BYTES, MISC_OFF = LDSCTL_OFF + 320, LDS_BYTES = 147456;

typedef GAS float gf32;
struct Args { const float* in[36]; float* out; unsigned char* ws; int ph_lo, ph_hi; };

#define FK_DPP(x, ctrl) __builtin_bit_cast(float, __builtin_amdgcn_update_dpp(0, __builtin_bit_cast(int, (x)), (ctrl), 0xF, 0xF, true))
__device__ __forceinline__ float row16_sum(float v) { v += FK_DPP(v, 0xB1); v += FK_DPP(v, 0x4E); v += FK_DPP(v, 0x141); v += FK_DPP(v, 0x140); return v; }
__device__ __forceinline__ float row16_max(float v) { v = fmaxf(v, FK_DPP(v, 0xB1)); v = fmaxf(v, FK_DPP(v, 0x4E)); v = fmaxf(v, FK_DPP(v, 0x141)); v = fmaxf(v, FK_DPP(v, 0x140)); return v; }
__device__ __forceinline__ float swap16_sum(float v) { const auto r = __builtin_amdgcn_permlane16_swap(__float_as_uint(v), __float_as_uint(v), false, false); return __uint_as_float(r[0]) + __uint_as_float(r[1]); }
__device__ __forceinline__ float swap32_sum(float v) { const auto r = __builtin_amdgcn_permlane32_swap(__float_as_uint(v), __float_as_uint(v), false, false); return __uint_as_float(r[0]) + __uint_as_float(r[1]); }
__device__ __forceinline__ float swap16_max(float v) { const auto r = __builtin_amdgcn_permlane16_swap(__float_as_uint(v), __float_as_uint(v), false, false); return fmaxf(__uint_as_float(r[0]), __uint_as_float(r[1])); }
__device__ __forceinline__ float swap32_max(float v) { const auto r = __builtin_amdgcn_permlane32_swap(__float_as_uint(v), __float_as_uint(v), false, false); return fmaxf(__uint_as_float(r[0]), __uint_as_float(r[1])); }
__device__ __forceinline__ float wave_sum(float v) { return swap32_sum(swap16_sum(row16_sum(v))); }
__device__ __forceinline__ float wave_max(float v) { return swap32_max(swap16_max(row16_max(v))); }
__device__ __forceinline__ float sigm(float x) { return __builtin_amdgcn_rcpf(1.f + __expf(-x)); }
__device__ __forceinline__ float siluf(float x) { return x * sigm(x); }
__device__ __forceinline__ float softplus_(float x) { return fmaxf(x, 0.f) + __logf(1.f + __expf(-fabsf(x))); }
__device__ __forceinline__ float tanh_(float x) { const float e = __expf(2.f * x); return 1.f - 2.f * __builtin_amdgcn_rcpf(e + 1.f); }

template <class Tp> __device__ __forceinline__ Tp* uni(Tp* p) { const unsigned long long v = (unsigned long long)p; const unsigned lo = __builtin_amdgcn_readfirstlane((unsigned)v), hi = __builtin_amdgcn_readfirstlane((unsigned)(v >> 32)); return (Tp*)(((unsigned long long)hi << 32) | lo); }
struct Frame {
    LAS unsigned char* lds; volatile LAS unsigned* MISC; gu32* ctl;
    int tid, lane, wave, vcu, G;
    const float* const* in; float* out; unsigned char* ws;
};

__device__ __forceinline__ unsigned pk4_fp8(float a, float b, float c, float d) { int p = __builtin_amdgcn_cvt_pk_fp8_f32(a, b, 0, false); p = __builtin_amdgcn_cvt_pk_fp8_f32(c, d, p, true); return (unsigned)p; }
__device__ __forceinline__ void tr_item(const float* W, int ldn, int k0, int n0, bf16_t* WT, int ldk, int drow0, int dk0, const float* kscale, LAS float* scr, int lane, float f8scale = 0.f) {
#pragma unroll
    for (int i = 0; i < 32; ++i) { const int kk = 2 * i + (lane >> 5); float v = W[(size_t)(k0 + kk) * ldn + n0 + (lane & 31)]; if (kscale) v *= kscale[k0 + kk]; scr[kk * 33 + (lane & 31)] = v; }
    LDS_WAIT(); asm volatile("" ::: "memory");
    const int c = lane & 7;
#pragma unroll
    for (int j = 0; j < 4; ++j) { const int n = (lane >> 3) + 8 * j; const LAS float* s = scr + (8 * c) * 33 + n;
        v4u o; o.x = pk2(s[0 * 33], s[1 * 33]); o.y = pk2(s[2 * 33], s[3 * 33]); o.z = pk2(s[4 * 33], s[5 * 33]); o.w = pk2(s[6 * 33], s[7 * 33]);
        if (f8scale != 0.f) { typedef unsigned u32x2t __attribute__((ext_vector_type(2)));
            const u32x2t o8 = {pk4_fp8(s[0 * 33] * f8scale, s[1 * 33] * f8scale, s[2 * 33] * f8scale, s[3 * 33] * f8scale), pk4_fp8(s[4 * 33] * f8scale, s[5 * 33] * f8scale, s[6 * 33] * f8scale, s[7 * 33] * f8scale)};
            *(GAS u32x2t*)((unsigned char*)WT + (size_t)(drow0 + n) * ldk + dk0 + k0 + 8 * c) = o8; }
        else *(GAS v4u*)(WT + (size_t)(drow0 + n) * ldk + dk0 + k0 + 8 * c) = o; }
    LDS_WAIT(); asm volatile("" ::: "memory");
}
enum RowMap { RM_PLAIN = 0, RM_HEAD = 1, RM_GU_GATE = 2, RM_GU_UP = 3 };
__device__ __forceinline__ int map_row(int mode, int n0) {
    if (mode == RM_HEAD) { const int pn = n0 >> 8, r = n0 & 255, wc = r >> 6, bj = (r >> 5) & 1; return (pn << 8) + bj * 128 + wc * 32; }
    if (mode == RM_GU_GATE) return ((n0 >> 7) << 8) + (n0 & 127);
    if (mode == RM_GU_UP) return ((n0 >> 7) << 8) + 128 + (n0 & 127);
    return n0;
}
struct TrJob { const float* W; int ldn, K, N, ncol0; bf16_t* WT; int ldk, drow_off, dk0, mode; const float* kscale; float f8scale; };
__device__ __forceinline__ void tr_job_item(const TrJob& j, int item, LAS float* scr, int lane) {
    const int nblk = j.N / 32, kb = item / nblk, nb = item % nblk;
    tr_item(j.W, j.ldn, 64 * kb, j.ncol0 + 32 * nb, j.WT, j.ldk, j.drow_off + map_row(j.mode, 32 * nb), j.dk0, j.kscale, scr, lane, j.f8scale);
}

__device__ __forceinline__ void p0_prologue(Frame& F, bool do_experts) {
    const int gw = F.vcu * NWAVES + F.wave, NGW = F.G * NWAVES;
    unsigned char* ws = F.ws;
    {
        LAS float* sc = (LAS float*)(F.lds);
        LAS float* red = (LAS float*)(F.lds + 16384);
        for (int i = F.tid; i < NB * D; i += NTHR) sc[i] = siluf(F.in[1][i]);
        __syncthreads();
        for (int task = blockIdx.x; task < 2 * 96; task += F.G) {
            const int l = task / 96, n0 = (task % 96) * 64;
            const float* W = F.in[2] + ((size_t)l * D + F.wave * 128) * (6 * D) + n0 + F.lane;
            float a0 = 0.f, a1 = 0.f, a2 = 0.f, a3 = 0.f;
#pragma unroll 16
            for (int k = 0; k < 128; ++k) { const float w = W[(size_t)k * (6 * D)]; const int kk = F.wave * 128 + k; a0 += sc[kk] * w; a1 += sc[D + kk] * w; a2 += sc[2 * D + kk] * w; a3 += sc[3 * D + kk] * w; }
            red[(F.wave * 4 + 0) * 64 + F.lane] = a0; red[(F.wave * 4 + 1) * 64 + F.lane] = a1; red[(F.wave * 4 + 2) * 64 + F.lane] = a2; red[(F.wave * 4 + 3) * 64 + F.lane] = a3;
            __syncthreads();
            if (F.tid < 256) { const int b = F.tid >> 6, ln = F.tid & 63; float s = F.in[3][l * 6 * D + n0 + ln];
#pragma unroll
                for (int w = 0; w < 8; ++w) s += red[(w * 4 + b) * 64 + ln];
                ((float*)(ws + WS_MOD))[(size_t)(l * NB + b) * 6 * D + n0 + ln] = s; }
            __syncthreads();
        }
        __syncthreads();
    }
    {
        bf16_t* B2 = (bf16_t*)(ws + WS_B2T);
        const int gt = F.vcu * NTHR + F.tid, NGT = F.G * NTHR;
        for (int idx = gt; idx < 3072 * 256; idx += NGT) { const int n = idx >> 8, k = idx & 255, seg = n >> 10, nn = n & 1023; float v = 0.f;
            if (seg == 0 && k < 64) v = F.in[11][(size_t)k * D + nn]; else if (seg == 1 && k >= 64 && k < 128) v = F.in[14][(size_t)(k - 64) * D + nn]; else if (seg == 2 && k >= 128) v = F.in[16][(size_t)(k - 128) * D + nn];
            B2[idx] = (bf16_t)f2bf(v); }
    }
    LAS float* scr = (LAS float*)(F.lds + F.wave * 16384);
    constexpr int NJ = 30;
    int cum = 0;
#define TRJ(W_, ldn_, K_, N_, ncol0_, WT_, ldk_, drow_, dk0_, mode_, ks_) { const TrJob j{W_, ldn_, K_, N_, ncol0_, (bf16_t*)(ws + (WT_)), ldk_, drow_, dk0_, mode_, ks_, F8S}; const int ni = (K_ / 64) * (N_ / 32); \
        for (int it = gw; it < ni; it += NGW) tr_job_item(j, it, scr, F.lane); }
#define F8S 0.f
    TRJ(F.in[7], D, D, D, 0, WS_WRKV, D, 0, 0, RM_PLAIN, nullptr)
    TRJ(F.in[7] + (size_t)D * D, D, D, D, 0, WS_WRKV, D, 1024, 0, RM_PLAIN, nullptr)
    TRJ(F.in[7] + 2 * (size_t)D * D, D, D, D, 0, WS_WRKV, D, 2048, 0, RM_PLAIN, nullptr)
    TRJ(F.in[10], 64, D, 64, 0, WS_B1T, 2048, 0, 0, RM_PLAIN, nullptr)
    TRJ(F.in[10], 64, D, 64, 0, WS_B1T, 2048, 0, 1024, RM_PLAIN, F.in[6] + 1 * D)
    TRJ(F.in[13], 64, D, 64, 0, WS_B1T, 2048, 64, 0, RM_PLAIN, nullptr)
    TRJ(F.in[13], 64, D, 64, 0, WS_B1T, 2048, 64, 1024, RM_PLAIN, F.in[6] + 4 * D)
    TRJ(F.in[15], 128, D, 128, 0, WS_B1T, 2048, 128, 0, RM_PLAIN, nullptr)
    TRJ(F.in[15], 128, D, 128, 0, WS_B1T, 2048, 128, 1024, RM_PLAIN, F.in[6] + 5 * D)
    TRJ(F.in[8], D, D, D, 0, WS_WO0, D, 0, 0, RM_PLAIN, nullptr)
    TRJ(F.in[27], D, D, D, 0, WS_WO1, D, 0, 0, RM_PLAIN, nullptr)
    TRJ(F.in[28], NE, D, NE, 0, WS_RT0, D, 0, 0, RM_PLAIN, nullptr)
    TRJ(F.in[28] + (size_t)D * NE, NE, D, NE, 0, WS_RT1, D, 0, 0, RM_PLAIN, nullptr)
#undef F8S
#define F8S F8_SB
    TRJ(F.in[33], FX, D, FX, 0, WS_SGU0, D, 0, 0, RM_GU_GATE, nullptr)
    TRJ(F.in[34], FX, D, FX, 0, WS_SGU0, D, 0, 0, RM_GU_UP, nullptr)
    TRJ(F.in[33] + (size_t)D * FX, FX, D, FX, 0, WS_SGU1, D, 0, 0, RM_GU_GATE, nullptr)
    TRJ(F.in[34] + (size_t)D * FX, FX, D, FX, 0, WS_SGU1, D, 0, 0, RM_GU_UP, nullptr)
#undef F8S
#define F8S 0.f
    TRJ(F.in[35], D, FX, D, 0, WS_SD0, FX, 0, 0, RM_PLAIN, nullptr)
    TRJ(F.in[35] + (size_t)FX * D, D, FX, D, 0, WS_SD1, FX, 0, 0, RM_PLAIN, nullptr)
    TRJ(F.in[22], 2 * D + H, D, D, 0, WS_KVT, D, 0, 0, RM_HEAD, nullptr)
    TRJ(F.in[22], 2 * D + H, D, D, D, WS_KVT, D, 1024, 0, RM_PLAIN, nullptr)
    TRJ(F.in[25], 2 * D, D, D, 0, WS_QGT, D, 0, 0, RM_HEAD, nullptr)
    TRJ(F.in[25], 2 * D, D, D, D, WS_QGT, D, 1024, 0, RM_PLAIN, nullptr)
    (void)cum; (void)NJ;
    if (do_experts) {
        const int NIT = 2 * NE * 384;
        for (int it = gw; it < NIT; it += NGW) {
            const int le = it / 384, r = it % 384, l = le >> 8, e = le & 255;
            if (r < 256) { const bool up = r >= 128; const float* W = F.in[up ? 31 : 30] + ((size_t)l * NE + e) * D * FX;
                const TrJob j{W, FX, D, FX, 0, (bf16_t*)(ws + WS_EGU + (size_t)l * EGU_L + (size_t)e * 512 * 1024), D, 0, 0, up ? RM_GU_UP : RM_GU_GATE, nullptr, F8_SB}; tr_job_item(j, r & 127, scr, F.lane); }
            else { const float* W = F.in[32] + ((size_t)l * NE + e) * FX * D;
                const TrJob j{W, D, FX, D, 0, (bf16_t*)(ws + WS_ED + (size_t)l * ED_L) + (size_t)e * 1024 * 256, FX, 0, 0, RM_PLAIN, nullptr, 0.f}; tr_job_item(j, r - 256, scr, F.lane); }
        }
    }
#undef TRJ
#undef F8S
}

__device__ __forceinline__ void p1_mix(Frame& F) {
    const int gw = F.vcu * NWAVES + F.wave;
    const float* x = F.in[0]; const float* mu = F.in[6];
    bf16_t* XR = (bf16_t*)(F.ws + WS_XR); bf16_t* XK = (bf16_t*)(F.ws + WS_XK); bf16_t* XV = (bf16_t*)(F.ws + WS_XV); bf16_t* HX = (bf16_t*)(F.ws + WS_HX);
    for (int chunk = gw; chunk < M / 16; chunk += F.G * NWAVES) {
        const int row0 = chunk * 16, b = row0 / T, t0 = row0 % T;
        const float* mod = (const float*)(F.ws + WS_MOD) + (size_t)(0 * NB + b) * 6 * D;
        f32x4 sh[4], sc[4], mr[4], mk[4], mv[4], hp[4];
#pragma unroll
        for (int j = 0; j < 4; ++j) { const int c = 4 * F.lane + 256 * j; sh[j] = *(const f32x4*)(mod + c); sc[j] = *(const f32x4*)(mod + D + c) + 1.f;
            mr[j] = *(const f32x4*)(mu + 0 * D + c); mk[j] = *(const f32x4*)(mu + 2 * D + c); mv[j] = *(const f32x4*)(mu + 3 * D + c); }
#pragma unroll
        for (int j = 0; j < 4; ++j) { if (t0 == 0) hp[j] = (f32x4){0.f, 0.f, 0.f, 0.f}; else { const f32x4 xp = *(const f32x4*)(x + (size_t)(row0 - 1) * D + 4 * F.lane + 256 * j); hp[j] = xp * sc[j] + sh[j]; } }
        for (int r = 0; r < 16; ++r) { const size_t row = row0 + r;
#pragma unroll
            for (int j = 0; j < 4; ++j) { const int c = 4 * F.lane + 256 * j; const f32x4 xv = *(const f32x4*)(x + row * D + c); const f32x4 h = xv * sc[j] + sh[j]; const f32x4 xx = hp[j] - h; hp[j] = h;
                const f32x4 a = h + xx * mr[j], bq = h + xx * mk[j], cq = h + xx * mv[j];
                typedef unsigned u32x2 __attribute__((ext_vector_type(2)));
                *(u32x2*)(XR + row * D + c) = (u32x2){pk2(a[0], a[1]), pk2(a[2], a[3])};
                *(u32x2*)(XK + row * D + c) = (u32x2){pk2(bq[0], bq[1]), pk2(bq[2], bq[3])};
                *(u32x2*)(XV + row * D + c) = (u32x2){pk2(cq[0], cq[1]), pk2(cq[2], cq[3])};
                *(u32x2*)(HX + row * 2 * D + c) = (u32x2){pk2(h[0], h[1]), pk2(h[2], h[3])};
                *(u32x2*)(HX + row * 2 * D + D + c) = (u32x2){pk2(xx[0], xx[1]), pk2(xx[2], xx[3])}; }
        }
    }
}

struct EpiL1 {
    static constexpr bool PERM = true, AFTER_DRAIN = false;
    bf16_t* O;
    __device__ __forceinline__ void operator()(const f32x4 (&acc)[2][2][4][2], const Unit& u, int wr, int wc, int fr, int fq) const {
        const int row0 = u.pm * BM + wr * 64 + fr, col0 = wc * 32 + 8 * fq;
#pragma unroll
        for (int ai = 0; ai < 2; ++ai)
#pragma unroll
            for (int m = 0; m < 4; ++m) { bf16_t* rowp = O + (size_t)(row0 + ai * HALF + m * 16) * 256 + col0;
#pragma unroll
                for (int bj = 0; bj < 2; ++bj) { f32x4 v0 = acc[ai][bj][m][0], v1 = acc[ai][bj][m][1];
                    if (bj == 1) { for (int i = 0; i < 4; ++i) { v0[i] = sigm(v0[i]); v1[i] = sigm(v1[i]); } }
                    else if (wc < 2) { for (int i = 0; i < 4; ++i) { v0[i] = tanh_(v0[i]); v1[i] = tanh_(v1[i]); } }
                    u32x4 w; w.x = pg8::cvt_pk_bf16(v0[0], v0[1]); w.y = pg8::cvt_pk_bf16(v0[2], v0[3]); w.z = pg8::cvt_pk_bf16(v1[0], v1[1]); w.w = pg8::cvt_pk_bf16(v1[2], v1[3]);
                    *(u32x4*)(rowp + bj * HALF) = w; } }
    }
};
struct EpiL2 {
    static constexpr bool PERM = false, AFTER_DRAIN = false;
    float* LW; bf16_t* A_; bf16_t* G_; const float* w0; const float* a0; float* RAW;
    __device__ __forceinline__ void operator()(const f32x4 (&acc)[2][2][4][2], const Unit& u, int wr, int wc, int fr, int fq) const {
        typedef unsigned u32x2 __attribute__((ext_vector_type(2)));
        const int seg = u.pn >> 2, row0 = u.pm * BM + wr * 64 + fr, colt = (u.pn & 3) * BM + wc * 32 + 4 * fq;
#pragma unroll
        for (int bj = 0; bj < 2; ++bj)
#pragma unroll
            for (int n = 0; n < 2; ++n) { const int col = colt + bj * HALF + n * 16;
                f32x4 bv = (f32x4){0.f, 0.f, 0.f, 0.f}; if (seg == 0) bv = *(const f32x4*)(w0 + col); else if (seg == 1) bv = *(const f32x4*)(a0 + col);
#pragma unroll
                for (int ai = 0; ai < 2; ++ai)
#pragma unroll
                    for (int m = 0; m < 4; ++m) { const size_t off = (size_t)(row0 + ai * HALF + m * 16) * D + col; f32x4 v = acc[ai][bj][m][n] + bv;
#ifdef FK_DBG_RAW
                        *(f32x4*)(RAW + (size_t)(row0 + ai * HALF + m * 16) * 3072 + seg * 1024 + col) = acc[ai][bj][m][n];
#endif
                        if (seg == 0) { f32x4 o; for (int i = 0; i < 4; ++i) o[i] = -__expf(-softplus_(-v[i]) - 0.5f); *(f32x4*)(LW + off) = o; }
                        else if (seg == 1) { *(u32x2*)(A_ + off) = (u32x2){pg8::cvt_pk_bf16(sigm(v[0]), sigm(v[1])), pg8::cvt_pk_bf16(sigm(v[2]), sigm(v[3]))}; }
                        else { *(u32x2*)(G_ + off) = (u32x2){pg8::cvt_pk_bf16(v[0], v[1]), pg8::cvt_pk_bf16(v[2], v[3])}; } }
                asm volatile("" ::: "memory"); }
    }
};
}
namespace fk {
typedef short s16x4 __attribute__((ext_vector_type(4)));
typedef float f32x16 __attribute__((ext_vector_type(16)));
typedef unsigned u32x2 __attribute__((ext_vector_type(2)));
constexpr int TP = 144;
constexpr int TSZ = 64 * TP;
constexpr int L_A = 0 * TSZ, L_At = 1 * TSZ, L_B = 2 * TSZ, L_Bpt = 3 * TSZ, L_K = 4 * TSZ, L_Kpt = 5 * TSZ, L_R = 6 * TSZ, L_Vt = 7 * TSZ, L_L = 8 * TSZ, L_Mak = 9 * TSZ,
              L_Mrb = 10 * TSZ, L_Mrk = 11 * TSZ, L_W1t = 12 * TSZ, L_Di = 13 * TSZ, L_Att = L_A, L_Vtt = L_Mak;
constexpr int L_CTOT = 132096, L_WC = L_CTOT + 2048;
static_assert(14 * TSZ <= 131072 && L_WC + 256 <= LDS_BYTES, "P5 LDS map");

__device__ __forceinline__ float bf2f(unsigned short h) { return __uint_as_float((unsigned)h << 16); }
__device__ __forceinline__ int crow(int r, int hi) { return (r & 3) + 8 * (r >> 2) + 4 * hi; }
__device__ __forceinline__ int fr_off(int row, int k0) { const int rb = row >> 4, l15 = row & 15, s = k0 >> 5, kk = k0 & 31, half = kk >> 4, q = (kk & 15) >> 2; return (((rb * 2 + s) * 64 + q * 16 + l15) * 16) + half * 8; }

__device__ __forceinline__ void prod_half(f32x16 (&acc)[2], const LAS unsigned char* U, const LAS unsigned char* W, int ph, int l31, int hi) {
#pragma unroll
    for (int ks = 0; ks < 4; ++ks) {
        const bf16x8 uf = *(const LAS bf16x8*)(U + (32 * ph + l31) * TP + ks * 32 + hi * 16);
#pragma unroll
        for (int xb = 0; xb < 2; ++xb) { const bf16x8 wf = *(const LAS bf16x8*)(W + (32 * xb + l31) * TP + ks * 32 + hi * 16);
            acc[xb] = __builtin_amdgcn_mfma_f32_32x32x16_bf16(wf, uf, acc[xb], 0, 0, 0); }
    }
}
template <int MASK> __device__ __forceinline__ void st_half_lds(const f32x16 (&acc)[2], LAS unsigned char* Z, int ph, int l31, int hi) {
    const int p = 32 * ph + l31;
#pragma unroll
    for (int xb = 0; xb < 2; ++xb)
#pragma unroll
        for (int g = 0; g < 4; ++g) { const int q0 = 32 * xb + 8 * g + 4 * hi; float v[4];
#pragma unroll
            for (int x = 0; x < 4; ++x) { v[x] = acc[xb][4 * g + x]; if (MASK == 1 && !(q0 + x < p)) v[x] = 0.f; if (MASK == 2 && !(q0 + x <= p)) v[x] = 0.f; }
            *(LAS u32x2*)(Z + p * TP + q0 * 2) = (u32x2){pg8::cvt_pk_bf16(v[0], v[1]), pg8::cvt_pk_bf16(v[2], v[3])}; }
}

#define P5_LBAR() asm volatile("s_waitcnt lgkmcnt(0)\n\ts_barrier" ::: "memory")
__device__ __forceinline__ void p5_unit(Frame& F, int unit, const unsigned short (&rr)[8], const unsigned short (&kr)[8], const unsigned short (&vr)[8], const unsigned short (&ar)[8], const float (&lw)[8]) {
    const int c = unit & 127, bh = unit >> 7, h = bh & 15, b = bh >> 4;
    const size_t row0 = (size_t)b * T + c * 64; const int col0 = h * 64;
    const int lane = F.lane, w = F.wave, l31 = lane & 31, hi = lane >> 5;
    LAS unsigned char* lds = F.lds;
    unsigned char* ws = F.ws;
    {
        const int d = lane;
        const float kkv = F.in[17][col0 + d], kav = F.in[18][col0 + d], rkv = F.in[19][col0 + d];
        float cl[8]; float run = 0.f;
#pragma unroll
        for (int i = 0; i < 8; ++i) { run += lw[i]; cl[i] = run; }
        LAS float* ctot = (LAS float*)(lds + L_CTOT);
        ctot[w * 64 + d] = run;
        P5_LBAR();
        float base = 0.f, total = 0.f;
#pragma unroll
        for (int q = 0; q < 8; ++q) { const float x = ctot[q * 64 + d]; total += x; if (q < w) base += x; }
        unsigned short at8[8], bp8[8], kp8[8]; const float etot = __expf(total); float erp = __expf(base);
#define CV1(x_) ((unsigned short)(pg8::cvt_pk_bf16((x_), 0.f) & 0xffffu))
#pragma unroll
        for (int i = 0; i < 8; ++i) { const int t = 8 * w + i;
            const float k = bf2f(kr[i]), a = bf2f(ar[i]), r = bf2f(rr[i]);
            float kkn = k * kkv; const float ss = wave_sum(kkn * kkn); kkn *= rsqrtf(fmaxf(ss, 1e-24f));
            const float kp = k * (1.f + (a - 1.f) * kav), bv = kkn * a, av = -kkn;
            const float bon = wave_sum(r * kp * rkv); if (lane == 0) ((float*)(ws + WS_BONUS))[(row0 + t) * 16 + h] = bon;
            const float cum = base + cl[i];
            const float ea = erp, eb = __expf(-cum), ec = etot * eb, er = __expf(cum); erp = er;
            const unsigned short Ah = CV1(av * ea), Bh = CV1(bv * eb), Kh = CV1(kp * eb), Rh = CV1(r * er);
            *(LAS unsigned short*)(lds + L_A + t * TP + d * 2) = Ah; *(LAS unsigned short*)(lds + L_B + t * TP + d * 2) = Bh;
            *(LAS unsigned short*)(lds + L_K + t * TP + d * 2) = Kh; *(LAS unsigned short*)(lds + L_R + t * TP + d * 2) = Rh;
            at8[i] = Ah; bp8[i] = CV1(bv * ec); kp8[i] = CV1(kp * ec); }
#undef CV1
#define PK8(a_) (v4u){(unsigned)a_[0] | ((unsigned)a_[1] << 16), (unsigned)a_[2] | ((unsigned)a_[3] << 16), (unsigned)a_[4] | ((unsigned)a_[5] << 16), (unsigned)a_[6] | ((unsigned)a_[7] << 16)}
        *(LAS v4u*)(lds + L_At + d * TP + 16 * w) = PK8(at8); *(LAS v4u*)(lds + L_Bpt + d * TP + 16 * w) = PK8(bp8);
        *(LAS v4u*)(lds + L_Kpt + d * TP + 16 * w) = PK8(kp8); *(LAS v4u*)(lds + L_Vt + d * TP + 16 * w) = PK8(vr);
#undef PK8
        if (w == 0) ((LAS float*)(lds + L_WC))[d] = etot;
        P5_LBAR();
    }
    {
        const int pid = w >> 1, ph = w & 1;
        f32x16 acc[2]; acc[0] = f32x16{}; acc[1] = f32x16{};
        prod_half(acc, lds + ((pid < 2) ? L_A : L_R), lds + ((pid & 1) ? L_K : L_B), ph, l31, hi);
        if (pid == 0) st_half_lds<1>(acc, lds + L_L, ph, l31, hi); else if (pid == 1) st_half_lds<1>(acc, lds + L_Mak, ph, l31, hi);
        else if (pid == 2) st_half_lds<2>(acc, lds + L_Mrb, ph, l31, hi); else st_half_lds<2>(acc, lds + L_Mrk, ph, l31, hi);
        P5_LBAR();
    }
    {
        if (w == 0) {
            const int blk = lane >> 4, j = lane & 15; float tc[16]; v4u la[16], lb[16];
#pragma unroll
            for (int t = 1; t < 16; ++t) { la[t] = *(const LAS v4u*)(lds + L_L + (16 * blk + t) * TP + 32 * blk); if (t > 8) lb[t] = *(const LAS v4u*)(lds + L_L + (16 * blk + t) * TP + 32 * blk + 16); }
#pragma unroll
            for (int t = 0; t < 16; ++t) { float s = (t == j) ? 1.f : 0.f;
#pragma unroll
                for (int i = 0; i < t; ++i) { const unsigned wd = (i < 8) ? ((i >> 1) == 0 ? la[t].x : (i >> 1) == 1 ? la[t].y : (i >> 1) == 2 ? la[t].z : la[t].w) : (((i - 8) >> 1) == 0 ? lb[t].x : ((i - 8) >> 1) == 1 ? lb[t].y : ((i - 8) >> 1) == 2 ? lb[t].z : lb[t].w);
                    const float lv = __uint_as_float((i & 1) ? (wd & 0xffff0000u) : (wd << 16)); s += lv * tc[i]; }
                tc[t] = s; *(LAS unsigned short*)(lds + L_Di + (16 * blk + t) * TP + j * 2) = (unsigned short)f2bf(s); }
        } else if (w == 2 || w == 3) {
            f32x16 acc[2]; acc[0] = f32x16{}; acc[1] = f32x16{};
            prod_half(acc, lds + L_Vt, lds + L_Mak, w & 1, l31, hi);
            st_half_lds<0>(acc, lds + L_W1t, w & 1, l31, hi);
        }
        P5_LBAR();
    }
    {
        const int l15 = lane & 15, q = lane >> 4, n0 = 16 * (w & 3);
        const LAS unsigned char* rhs = lds + ((w < 4) ? L_At : L_W1t); LAS unsigned char* out = lds + ((w < 4) ? L_Att : L_Vtt);
        f32x4 accX[4]; s16x4 xb16[4];
#pragma unroll
        for (int bi = 0; bi < 4; ++bi) {
            const u32x2 rw = *(const LAS u32x2*)(rhs + (n0 + l15) * TP + (16 * bi + 4 * q) * 2);
            f32x4 acc = (f32x4){__uint_as_float(rw.x << 16), __uint_as_float(rw.x & 0xffff0000u), __uint_as_float(rw.y << 16), __uint_as_float(rw.y & 0xffff0000u)};
#pragma unroll
            for (int bk = 0; bk < bi; ++bk) { const s16x4 lf = *(const LAS s16x4*)(lds + L_L + (16 * bi + l15) * TP + (16 * bk + 4 * q) * 2);
                acc = __builtin_amdgcn_mfma_f32_16x16x16bf16_1k(lf, xb16[bk], acc, 0, 0, 0); }
            const u32x2 pa = (u32x2){pg8::cvt_pk_bf16(acc[0], acc[1]), pg8::cvt_pk_bf16(acc[2], acc[3])};
            const s16x4 df = *(const LAS s16x4*)(lds + L_Di + (16 * bi + l15) * TP + (4 * q) * 2);
            accX[bi] = __builtin_amdgcn_mfma_f32_16x16x16bf16_1k(df, __builtin_bit_cast(s16x4, pa), (f32x4){0.f, 0.f, 0.f, 0.f}, 0, 0, 0);
            const u32x2 px = (u32x2){pg8::cvt_pk_bf16(accX[bi][0], accX[bi][1]), pg8::cvt_pk_bf16(accX[bi][2], accX[bi][3])};
            xb16[bi] = __builtin_bit_cast(s16x4, px);
        }
        P5_LBAR();
#pragma unroll
        for (int bi = 0; bi < 4; ++bi) *(LAS s16x4*)(out + (n0 + l15) * TP + (16 * bi + 4 * q) * 2) = xb16[bi];
        P5_LBAR();
    }
    {
        const int task = w >> 1, ph = w & 1, p = 32 * ph + l31;
        f32x16 acc[2]; acc[0] = f32x16{}; acc[1] = f32x16{};
        if (task == 0) { prod_half(acc, lds + L_Mrb, lds + L_Att, ph, l31, hi); }
        else if (task == 1) { prod_half(acc, lds + L_Bpt, lds + L_Att, ph, l31, hi); }
        else if (task == 2) { prod_half(acc, lds + L_Mrb, lds + L_Vtt, ph, l31, hi); prod_half(acc, lds + L_Mrk, lds + L_Vt, ph, l31, hi); }
        else { prod_half(acc, lds + L_Vtt, lds + L_Bpt, ph, l31, hi); prod_half(acc, lds + L_Vt, lds + L_Kpt, ph, l31, hi); }
        unsigned char* gout = ws + ((task == 0) ? WS_RTL : (task == 1) ? WS_PT : (task == 2) ? WS_YL : WS_Q) + (size_t)unit * 8192;
        const float wc = (task == 1) ? ((const LAS float*)(lds + L_WC))[p] : 0.f;
#pragma unroll
        for (int xb = 0; xb < 2; ++xb)
#pragma unroll
            for (int g = 0; g < 4; ++g) { const int q0 = 32 * xb + 8 * g + 4 * hi; float v[4];
#pragma unroll
                for (int x = 0; x < 4; ++x) v[x] = acc[xb][4 * g + x];
                if (task == 0) { const u32x2 rw = *(const LAS u32x2*)(lds + L_R + p * TP + q0 * 2); v[0] += __uint_as_float(rw.x << 16); v[1] += __uint_as_float(rw.x & 0xffff0000u); v[2] += __uint_as_float(rw.y << 16); v[3] += __uint_as_float(rw.y & 0xffff0000u); }
                if (task == 1) {
#pragma unroll
                    for (int x = 0; x < 4; ++x) if (q0 + x == p) v[x] += wc; }
                const u32x2 o = (u32x2){pg8::cvt_pk_bf16(v[0], v[1]), pg8::cvt_pk_bf16(v[2], v[3])};
                const int off = (task < 2) ? fr_off(p, q0) : (p * 128 + q0 * 2);
                *(u32x2*)(gout + off) = o; }
        P5_LBAR();
    }
}
__device__ __forceinline__ void p5_phase(Frame& F) {
    const bf16_t* Rg = (const bf16_t*)(F.ws + WS_R); const bf16_t* Kg = (const bf16_t*)(F.ws + WS_K); const bf16_t* Vg = (const bf16_t*)(F.ws + WS_V); const bf16_t* Ag = (const bf16_t*)(F.ws + WS_A);
    const float* LWg = (const float*)(F.ws + WS_LW);
    unsigned short rr[8], kr[8], vr[8], ar[8], nrr[8], nkr[8], nvr[8], nar[8]; float lw[8], nlw[8];
#define P5_LOAD(u_, R_, K_, V_, A_, W_) do { const int c_ = (u_) & 127, bh_ = (u_) >> 7; const size_t base_ = ((size_t)(bh_ >> 4) * T + c_ * 64 + 8 * F.wave) * D + (bh_ & 15) * 64 + F.lane; \
        _Pragma("unroll") for (int i = 0; i < 8; ++i) { const size_t idx = base_ + (size_t)i * D; R_[i] = Rg[idx]; K_[i] = Kg[idx]; V_[i] = Vg[idx]; A_[i] = Ag[idx]; W_[i] = LWg[idx]; } } while (0)
    int unit = F.vcu; const int NU = NB * H * 128;
    if (unit < NU) P5_LOAD(unit, rr, kr, vr, ar, lw);
    for (; unit < NU; unit += F.G) {
        const int nu = unit + F.G;
        if (nu < NU) P5_LOAD(nu, nrr, nkr, nvr, nar, nlw);
        p5_unit(F, unit, rr, kr, vr, ar, lw);
#pragma unroll
        for (int i = 0; i < 8; ++i) { rr[i] = nrr[i]; kr[i] = nkr[i]; vr[i] = nvr[i]; ar[i] = nar[i]; lw[i] = nlw[i]; }
    }
#undef P5_LOAD
}

__device__ __forceinline__ void p6_phase(Frame& F) {
    if (F.wave != 0) return;
    for (int task = F.vcu; task < NB * H * 4; task += F.G) {
        const int vq = task & 3, bh = task >> 2, h = bh & 15, b = bh >> 4;
        const int lane = F.lane, l15 = lane & 15, q = lane >> 4;
        unsigned char* ws = F.ws;
        f32x4 accS[4];
#pragma unroll
        for (int kb = 0; kb < 4; ++kb) accS[kb] = (f32x4){0.f, 0.f, 0.f, 0.f};
        const size_t ubase = (size_t)bh * 128;
        bf16x8 Pf[8], Rf[8]; u32x2 Qi[4], Yi[4];
#define P6_LOAD(cc) do { const size_t uo = (ubase + (cc)) * 8192; \
        _Pragma("unroll") for (int f = 0; f < 8; ++f) { Pf[f] = *(const bf16x8*)(ws + WS_PT + uo + (f * 64 + lane) * 16); Rf[f] = *(const bf16x8*)(ws + WS_RTL + uo + (f * 64 + lane) * 16); } \
        _Pragma("unroll") for (int kb = 0; kb < 4; ++kb) { Qi[kb] = *(const u32x2*)(ws + WS_Q + uo + (16 * vq + l15) * 128 + (16 * kb + 4 * q) * 2); Yi[kb] = *(const u32x2*)(ws + WS_YL + uo + (16 * kb + l15) * 128 + (16 * vq + 4 * q) * 2); } } while (0)
        P6_LOAD(0);
        for (int c = 0; c < 128; ++c) {
            bf16x8 Sf[2];
#pragma unroll
            for (int s = 0; s < 2; ++s) { u32x4 t; t.x = pg8::cvt_pk_bf16(accS[2 * s][0], accS[2 * s][1]); t.y = pg8::cvt_pk_bf16(accS[2 * s][2], accS[2 * s][3]);
                t.z = pg8::cvt_pk_bf16(accS[2 * s + 1][0], accS[2 * s + 1][1]); t.w = pg8::cvt_pk_bf16(accS[2 * s + 1][2], accS[2 * s + 1][3]); Sf[s] = __builtin_bit_cast(bf16x8, t); }
            f32x4 accY[4], accN[4];
#pragma unroll
            for (int tb = 0; tb < 4; ++tb) { accY[tb] = (f32x4){__uint_as_float(Yi[tb].x << 16), __uint_as_float(Yi[tb].x & 0xffff0000u), __uint_as_float(Yi[tb].y << 16), __uint_as_float(Yi[tb].y & 0xffff0000u)};
                accN[tb] = (f32x4){__uint_as_float(Qi[tb].x << 16), __uint_as_float(Qi[tb].x & 0xffff0000u), __uint_as_float(Qi[tb].y << 16), __uint_as_float(Qi[tb].y & 0xffff0000u)}; }
#pragma unroll
            for (int s = 0; s < 2; ++s)
#pragma unroll
                for (int tb = 0; tb < 4; ++tb) { accN[tb] = __builtin_amdgcn_mfma_f32_16x16x32_bf16(Pf[tb * 2 + s], Sf[s], accN[tb], 0, 0, 0);
                    accY[tb] = __builtin_amdgcn_mfma_f32_16x16x32_bf16(Sf[s], Rf[tb * 2 + s], accY[tb], 0, 0, 0); }
            if (c + 1 < 128) P6_LOAD(c + 1);
            const size_t row0 = (size_t)b * T + c * 64;
#pragma unroll
            for (int tb = 0; tb < 4; ++tb) { accS[tb] = accN[tb];
                *(u32x2*)(ws + WS_Y + ((row0 + 16 * tb + l15) * D + h * 64 + 16 * vq + 4 * q) * 2) = (u32x2){pg8::cvt_pk_bf16(accY[tb][0], accY[tb][1]), pg8::cvt_pk_bf16(accY[tb][2], accY[tb][3])}; }
        }
#undef P6_LOAD
    }
}

__device__ __forceinline__ void p6b_phase(Frame& F) {
    const int gw = F.vcu * NWAVES + F.wave, lane = F.lane; unsigned char* ws = F.ws;
    const int cb = 16 * lane, h = lane >> 2;
    float lg[16], lb[16];
#pragma unroll
    for (int i = 0; i < 16; ++i) { lg[i] = F.in[20][cb + i]; lb[i] = F.in[21][cb + i]; }
    for (int row = gw; row < M; row += F.G * NWAVES) {
        const size_t o = (size_t)row * D + cb;
        const u32x4 y0 = *(const u32x4*)(ws + WS_Y + o * 2), y1 = *(const u32x4*)(ws + WS_Y + o * 2 + 16);
        const u32x4 v0 = *(const u32x4*)(ws + WS_V + o * 2), v1 = *(const u32x4*)(ws + WS_V + o * 2 + 16);
        const u32x4 g0 = *(const u32x4*)(ws + WS_G + o * 2), g1 = *(const u32x4*)(ws + WS_G + o * 2 + 16);
        const float bon = ((const float*)(ws + WS_BONUS))[(size_t)row * 16 + h];
        const unsigned yw[8] = {y0.x, y0.y, y0.z, y0.w, y1.x, y1.y, y1.z, y1.w}, vw[8] = {v0.x, v0.y, v0.z, v0.w, v1.x, v1.y, v1.z, v1.w}, gwd[8] = {g0.x, g0.y, g0.z, g0.w, g1.x, g1.y, g1.z, g1.w};
        float y[16]; float s = 0.f;
#pragma unroll
        for (int i = 0; i < 8; ++i) { y[2 * i] = __uint_as_float(yw[i] << 16); y[2 * i + 1] = __uint_as_float(yw[i] & 0xffff0000u); s += y[2 * i] + y[2 * i + 1]; }
        s += __shfl_xor(s, 1); s += __shfl_xor(s, 2);
        const float mean = s * (1.f / 64.f); float qv = 0.f;
#pragma unroll
        for (int i = 0; i < 16; ++i) { y[i] -= mean; qv += y[i] * y[i]; }
        qv += __shfl_xor(qv, 1); qv += __shfl_xor(qv, 2);
        const float rstd = rsqrtf(qv * (1.f / 64.f) + 64e-5f);
        unsigned ow[8];
#pragma unroll
        for (int i = 0; i < 8; ++i) { const float va = __uint_as_float(vw[i] << 16), vb = __uint_as_float(vw[i] & 0xffff0000u), ga = __uint_as_float(gwd[i] << 16), gb = __uint_as_float(gwd[i] & 0xffff0000u);
            const float za = (y[2 * i] * rstd * lg[2 * i] + lb[2 * i] + bon * va) * ga, zb = (y[2 * i + 1] * rstd * lg[2 * i + 1] + lb[2 * i + 1] + bon * vb) * gb;
            ow[i] = pg8::cvt_pk_bf16(za, zb); }
        *(u32x4*)(ws + WS_Z + o * 2) = (u32x4){ow[0], ow[1], ow[2], ow[3]}; *(u32x4*)(ws + WS_Z + o * 2 + 16) = (u32x4){ow[4], ow[5], ow[6], ow[7]};
    }
}
}
namespace fk {
struct EpiPre {
    static constexpr bool PERM = false, AFTER_DRAIN = false;
    const float* res; const float* gate; float* out;
    __device__ __forceinline__ void operator()(const f32x4 (&acc)[2][2][4][2], const Unit& u, int wr, int wc, int fr, int fq) const {
        const int row0 = u.pm * BM + wr * 64 + fr, colt = u.pn * BM + wc * 32 + 4 * fq; const int b = (u.pm * BM) / T;
#pragma unroll
        for (int bj = 0; bj < 2; ++bj)
#pragma unroll
            for (int n = 0; n < 2; ++n) { const int col = colt + bj * HALF + n * 16; const f32x4 gv = *(const f32x4*)(gate + (size_t)b * 6 * D + col) + 1.f;
#pragma unroll
                for (int ai = 0; ai < 2; ++ai)
#pragma unroll
                    for (int m = 0; m < 4; ++m) { const size_t off = (size_t)(row0 + ai * HALF + m * 16) * D + col; const f32x4 rv = *(const f32x4*)(res + off);
                        *(f32x4*)(out + off) = rv * ALPHA + gv * acc[ai][bj][m][n]; }
                asm volatile("" ::: "memory"); }
    }
};
struct EpiF32 {
    static constexpr bool PERM = false, AFTER_DRAIN = false;
    float* out; int ldc;
    __device__ __forceinline__ void operator()(const f32x4 (&acc)[2][2][4][2], const Unit& u, int wr, int wc, int fr, int fq) const {
        const int row0 = u.pm * BM + wr * 64 + fr, colt = u.pn * BM + wc * 32 + 4 * fq;
#pragma unroll
        for (int ai = 0; ai < 2; ++ai)
#pragma unroll
            for (int m = 0; m < 4; ++m)
#pragma unroll
                for (int bj = 0; bj < 2; ++bj)
#pragma unroll
                    for (int n = 0; n < 2; ++n) *(f32x4*)(out + (size_t)(row0 + ai * HALF + m * 16) * ldc + colt + bj * HALF + n * 16) = acc[ai][bj][m][n];
    }
};

__device__ __forceinline__ void ln_mod_phase(Frame& F, int l) {
    const int gw = F.vcu * NWAVES + F.wave, lane = F.lane; unsigned char* ws = F.ws;
    const float* PRE = (const float*)(ws + WS_PRE); float* X1 = (float*)(ws + WS_X1); bf16_t* H2 = (bf16_t*)(ws + WS_H2);
    const float* lg = F.in[4] + (l * 2 + 0) * D; const float* lb = F.in[5] + (l * 2 + 0) * D;
    for (int row = gw; row < M; row += F.G * NWAVES) {
        const int b = row / T; const float* mod = (const float*)(ws + WS_MOD) + (size_t)(l * NB + b) * 6 * D;
        f32x4 v[4]; float s = 0.f;
#pragma unroll
        for (int j = 0; j < 4; ++j) { v[j] = *(const f32x4*)(PRE + (size_t)row * D + 4 * lane + 256 * j); s += (v[j][0] + v[j][1]) + (v[j][2] + v[j][3]); }
        const float mean = wave_sum(s) * (1.f / D); float q = 0.f;
#pragma unroll
        for (int j = 0; j < 4; ++j) { v[j] = v[j] - mean; q += (v[j][0] * v[j][0] + v[j][1] * v[j][1]) + (v[j][2] * v[j][2] + v[j][3] * v[j][3]); }
        const float rstd = rsqrtf(wave_sum(q) * (1.f / D) + LN_EPS);
#pragma unroll
        for (int j = 0; j < 4; ++j) { const int c = 4 * lane + 256 * j; const f32x4 x1 = v[j] * rstd * *(const f32x4*)(lg + c) + *(const f32x4*)(lb + c);
            *(f32x4*)(X1 + (size_t)row * D + c) = x1;
            const f32x4 h = x1 * (*(const f32x4*)(mod + 4 * D + c) + 1.f) + *(const f32x4*)(mod + 3 * D + c);
            *(u32x2*)(H2 + (size_t)row * D + c) = (u32x2){pk2(h[0], h[1]), pk2(h[2], h[3])};
            *(unsigned*)(ws + WS_H2F8 + (size_t)row * D + c) = pk4_fp8(h[0] * F8_SA, h[1] * F8_SA, h[2] * F8_SA, h[3] * F8_SA); }
    }
}

__device__ __forceinline__ void route_phase(Frame& F, int l) {
    const int lane = F.lane, w = F.wave; unsigned char* ws = F.ws; LAS unsigned char* lds = F.lds;
    LAS int* hist = (LAS int*)(lds);
    LAS int* basee = (LAS int*)(lds + 1024);
    LAS int* ent = (LAS int*)(lds + 2048);
    const float* logits = (const float*)(ws + WS_LOGITS); const float* rb = F.in[29] + l * NE;
    float* GWT = (float*)(ws + WS_GW); int* LIST = (int*)(ws + WS_LIST); gu32* cnt = F.ctl + CW_CNT + l * 256;
    const f32x4 bias = *(const f32x4*)(rb + 4 * lane);
    for (int blk = blockIdx.x; blk < M / 128; blk += F.G) {
        for (int i = F.tid; i < 256; i += NTHR) hist[i] = 0;
        __syncthreads();
        for (int it = 0; it < 16; ++it) {
            const int t = blk * 128 + w * 16 + it;
            const f32x4 lg = *(const f32x4*)(logits + (size_t)t * NE + 4 * lane);
            float s[4], c[4];
#pragma unroll
            for (int j = 0; j < 4; ++j) { s[j] = 1.f / (1.f + __expf(-lg[j])); c[j] = s[j] + bias[j]; }
            float m1 = fmaxf(c[0], c[1]), m2 = fminf(c[0], c[1]);
#pragma unroll
            for (int j = 2; j < 4; ++j) { const float x = c[j]; m2 = fmaxf(m2, fminf(m1, x)); m1 = fmaxf(m1, x); }
#define RT_MERGE(ctrl) { const float b1 = FK_DPP(m1, ctrl), b2 = FK_DPP(m2, ctrl); m2 = fmaxf(fminf(m1, b1), fmaxf(m2, b2)); m1 = fmaxf(m1, b1); }
            RT_MERGE(0xB1) RT_MERGE(0x4E) RT_MERGE(0x141)
#undef RT_MERGE
            const float gs = m1 + m2; const int g = lane >> 3; int rank = 0;
#pragma unroll
            for (int g2 = 0; g2 < 8; ++g2) { const float o = __int_as_float(__builtin_amdgcn_readlane(__float_as_int(gs), 8 * g2)); rank += (o > gs || (o == gs && g2 < g)) ? 1 : 0; }
            const bool sel = rank < 4;
#pragma unroll
            for (int j = 0; j < 4; ++j) if (!sel) c[j] = -INFINITY;
            int che[8]; float chs[8]; float ssum = 0.f;
#pragma unroll
            for (int k = 0; k < 8; ++k) {
                float bv = c[0]; int bj = 0; float bs = s[0];
#pragma unroll
                for (int j = 1; j < 4; ++j) if (c[j] > bv) { bv = c[j]; bj = j; bs = s[j]; }
                const float mx = wave_max(bv);
                const unsigned long long bal = __ballot(bv == mx);
                const int wl = __builtin_ctzll(bal);
                const int wj = __builtin_amdgcn_readlane(bj, wl); const float sv = __int_as_float(__builtin_amdgcn_readlane(__float_as_int(bs), wl));
#pragma unroll
                for (int j = 0; j < 4; ++j) if (lane == wl && j == wj) c[j] = -INFINITY;
                che[k] = 4 * wl + wj; chs[k] = sv; ssum += sv;
            }
            const float inv = 2.5f / ssum;
            if (lane < 8) { int e = che[0]; float sc = chs[0];
#pragma unroll
                for (int k = 1; k < 8; ++k) if (lane == k) { e = che[k]; sc = chs[k]; }
                const int lp = __hip_atomic_fetch_add(&hist[e], 1, __ATOMIC_RELAXED, __HIP_MEMORY_SCOPE_WORKGROUP);
                ent[(w * 16 + it) * 8 + lane] = (e << 16) | lp;
                GWT[(size_t)t * 8 + lane] = sc * inv; }
        }
        __syncthreads();
        if (F.tid < 256) { const int hc = hist[F.tid]; basee[F.tid] = hc ? (int)__hip_atomic_fetch_add(cnt + F.tid, (unsigned)hc, __ATOMIC_RELAXED, __HIP_MEMORY_SCOPE_AGENT) : 0; }
        __syncthreads();
        for (int i = F.tid; i < 1024; i += NTHR) { const int en = ent[i], e = en >> 16, lp = en & 0xffff; LIST[(size_t)e * M + basee[e] + lp] = (blk * 128 + (i >> 3)) * 8 + (i & 7); }
        __syncthreads();
    }
}
}
namespace fk {
constexpr int MOE_TAB = 132096, MOE_MAXP = 6;
constexpr int MOE_ROWS = MOE_TAB + 128;
static_assert(MOE_ROWS + MOE_MAXP * 2048 <= LDS_BYTES, "MoE LDS tables");
struct MoeUnit { int pm, pn, slot; };
struct MoeSched {
    typedef MoeUnit UnitT;
    LAS unsigned char* lds; int npairs, npn;
    const char* bexp; const char* bsh; size_t estride;
    unsigned a_base_r, a_base_s, a_rowbytes; int a_shift;
    __device__ __forceinline__ bool next(int i, MoeUnit& u) const { const int p = i / npn; if (p >= npairs) return false; u.slot = p; u.pn = i - p * npn; u.pm = 0; return true; }
    __device__ __forceinline__ int pair_e(int slot) const { return ((const LAS int*)(lds + MOE_TAB))[slot * 4 + 0]; }
    __device__ __forceinline__ const char* bbase(const MoeUnit& u) const { const int e = __builtin_amdgcn_readfirstlane(pair_e(u.slot)); return e == NE ? bsh : bexp + (size_t)e * estride; }
    __device__ __forceinline__ unsigned a_off(const MoeUnit& u, int r) const {
        const int v = ((const LAS int*)(lds + MOE_ROWS))[(u.slot * 256 + r) * 2]; const int e = pair_e(u.slot);
        if (v < 0) return (e == NE) ? a_base_s : a_base_r;
        return (e == NE) ? a_base_s + (unsigned)v * a_rowbytes : a_base_r + (unsigned)(v >> a_shift) * a_rowbytes; }
    __device__ __forceinline__ void a_ready(const MoeUnit&) const {}
    __device__ __forceinline__ void done(const MoeUnit&) const {}
};
__device__ __forceinline__ int moe_build(Frame& F, int l) {
    LAS unsigned char* lds = F.lds; LAS int* tiles = (LAS int*)(lds); LAS int* pref = (LAS int*)(lds + 1024); LAS int* cn = (LAS int*)(lds + 2048);
    LAS int* tab = (LAS int*)(lds + MOE_TAB); LAS int* rows = (LAS int*)(lds + MOE_ROWS);
    const gu32* cnt = F.ctl + CW_CNT + l * 256;
    if (F.tid < 256) { const int c = (int)__hip_atomic_load(cnt + F.tid, __ATOMIC_RELAXED, __HIP_MEMORY_SCOPE_AGENT); cn[F.tid] = c; tiles[F.tid] = (c + 255) >> 8; }
    __syncthreads();
    if (F.tid < 256) { int s = 0; for (int e = 0; e <= F.tid; ++e) s += tiles[e]; pref[F.tid] = s; }
    __syncthreads();
    const int Pr = pref[255], Ptot = Pr + 128;
    int np = 0;
    for (int p = F.vcu; p < Ptot && np < MOE_MAXP; p += F.G, ++np) {
        if (p < Pr) { if (F.tid < 256) { const int inc = pref[F.tid], exc = inc - tiles[F.tid]; if (exc <= p && p < inc) { tab[np * 4 + 0] = F.tid; tab[np * 4 + 1] = p - exc; } } }
        else if (F.tid == 0) { tab[np * 4 + 0] = NE; tab[np * 4 + 1] = p - Pr; }
    }
    __syncthreads();
    const int* LIST = (const int*)(F.ws + WS_LIST); const float* GWT = (const float*)(F.ws + WS_GW);
    for (int i = F.tid; i < np * 256; i += NTHR) { const int s = i >> 8, r = i & 255, e = tab[s * 4 + 0], mt = tab[s * 4 + 1]; int v; float gwv = 1.f;
        if (e == NE) v = mt * 256 + r; else { const int idx = mt * 256 + r; if (idx < cn[e]) { v = LIST[(size_t)e * M + idx]; gwv = GWT[v]; } else v = -1; }
        rows[i * 2] = v; rows[i * 2 + 1] = __float_as_int(gwv); }
    __syncthreads();
    return np;
}
struct EpiAct {
    static constexpr bool PERM = true, AFTER_DRAIN = false;
    LAS unsigned char* lds; bf16_t* ACT; bf16_t* ACTS; float inv;
    __device__ __forceinline__ void operator()(const f32x4 (&acc)[2][2][4][2], const MoeUnit& u, int wr, int wc, int fr, int fq) const {
        const LAS int* rows = (const LAS int*)(lds + MOE_ROWS) + u.slot * 512; const bool sh = ((const LAS int*)(lds + MOE_TAB))[u.slot * 4] == NE;
        bf16_t* base = sh ? ACTS : ACT; const int col = u.pn * 128 + wc * 32 + 8 * fq;
#pragma unroll
        for (int ai = 0; ai < 2; ++ai)
#pragma unroll
            for (int m = 0; m < 4; ++m) { const int r = ai * HALF + wr * 64 + m * 16 + fr; const int v = rows[r * 2]; if (v < 0) continue;
                float o[8];
#pragma unroll
                for (int n = 0; n < 2; ++n)
#pragma unroll
                    for (int i = 0; i < 4; ++i) { const float gq = acc[ai][0][m][n][i] * inv, uq = acc[ai][1][m][n][i] * inv; o[n * 4 + i] = gq * sigm(gq) * uq; }
                u32x4 wv; wv.x = pg8::cvt_pk_bf16(o[0], o[1]); wv.y = pg8::cvt_pk_bf16(o[2], o[3]); wv.z = pg8::cvt_pk_bf16(o[4], o[5]); wv.w = pg8::cvt_pk_bf16(o[6], o[7]);
                *(u32x4*)(base + (size_t)v * FX + col) = wv; }
    }
};
struct EpiDown {
    static constexpr bool PERM = true, AFTER_DRAIN = false;
    LAS unsigned char* lds; bf16_t* OUTR; bf16_t* YS;
    __device__ __forceinline__ void operator()(const f32x4 (&acc)[2][2][4][2], const MoeUnit& u, int wr, int wc, int fr, int fq) const {
        const LAS int* rows = (const LAS int*)(lds + MOE_ROWS) + u.slot * 512; const bool sh = ((const LAS int*)(lds + MOE_TAB))[u.slot * 4] == NE;
        bf16_t* base = sh ? YS : OUTR; const int col0 = u.pn * BM + wc * 32 + 8 * fq;
#pragma unroll
        for (int ai = 0; ai < 2; ++ai)
#pragma unroll
            for (int m = 0; m < 4; ++m) { const int r = ai * HALF + wr * 64 + m * 16 + fr; const int v = rows[r * 2]; if (v < 0) continue; const float gwv = __int_as_float(rows[r * 2 + 1]);
#pragma unroll
                for (int bj = 0; bj < 2; ++bj) { const f32x4 v0 = acc[ai][bj][m][0] * gwv, v1 = acc[ai][bj][m][1] * gwv;
                    u32x4 wv; wv.x = pg8::cvt_pk_bf16(v0[0], v0[1]); wv.y = pg8::cvt_pk_bf16(v0[2], v0[3]); wv.z = pg8::cvt_pk_bf16(v1[0], v1[1]); wv.w = pg8::cvt_pk_bf16(v1[2], v1[3]);
                    *(u32x4*)(base + (size_t)v * D + col0 + bj * HALF) = wv; } }
    }
};

__device__ __forceinline__ void combine_phase(Frame& F, int l, bool next_inputs, float* dst) {
    const int gw = F.vcu * NWAVES + F.wave, lane = F.lane; unsigned char* ws = F.ws;
    const bf16_t* OUTR = (const bf16_t*)(ws + WS_OUTROW); const bf16_t* YS = (const bf16_t*)(ws + WS_YS); float* X1 = (float*)(ws + WS_X1);
    const float* lg = F.in[4] + (l * 2 + 1) * D; const float* lb = F.in[5] + (l * 2 + 1) * D;
    for (int row = gw; row < M; row += F.G * NWAVES) {
        const int b = row / T; const float* mod = (const float*)(ws + WS_MOD) + (size_t)(l * NB + b) * 6 * D;
        float y[16];
#pragma unroll
        for (int i = 0; i < 16; ++i) y[i] = 0.f;
#pragma unroll
        for (int k = 0; k < 9; ++k) { const bf16_t* src = (k < 8) ? OUTR + ((size_t)row * 8 + k) * D : YS + (size_t)row * D;
#pragma unroll
            for (int j = 0; j < 2; ++j) { const u32x4 wv = *(const u32x4*)(src + 8 * lane + 512 * j); const unsigned ww[4] = {wv.x, wv.y, wv.z, wv.w};
#pragma unroll
                for (int i = 0; i < 4; ++i) { y[j * 8 + 2 * i] += __uint_as_float(ww[i] << 16); y[j * 8 + 2 * i + 1] += __uint_as_float(ww[i] & 0xffff0000u); } } }
        float v[16]; float s = 0.f;
#pragma unroll
        for (int j = 0; j < 2; ++j)
#pragma unroll
            for (int h4 = 0; h4 < 2; ++h4) { const int c = 8 * lane + 512 * j + 4 * h4; const f32x4 x1 = *(const f32x4*)(X1 + (size_t)row * D + c); const f32x4 g1 = *(const f32x4*)(mod + 5 * D + c) + 1.f;
#pragma unroll
                for (int i = 0; i < 4; ++i) { const float p = ALPHA * x1[i] + g1[i] * y[j * 8 + h4 * 4 + i]; v[j * 8 + h4 * 4 + i] = p; s += p; } }
        const float mean = wave_sum(s) * (1.f / D); float q = 0.f;
#pragma unroll
        for (int i = 0; i < 16; ++i) { v[i] -= mean; q += v[i] * v[i]; }
        const float rstd = rsqrtf(wave_sum(q) * (1.f / D) + LN_EPS);
#pragma unroll
        for (int j = 0; j < 2; ++j)
#pragma unroll
            for (int h4 = 0; h4 < 2; ++h4) { const int c = 8 * lane + 512 * j + 4 * h4; const f32x4 gg = *(const f32x4*)(lg + c), bb = *(const f32x4*)(lb + c);
#pragma unroll
                for (int i = 0; i < 4; ++i) v[j * 8 + h4 * 4 + i] = v[j * 8 + h4 * 4 + i] * rstd * gg[i] + bb[i];
                *(f32x4*)((next_inputs ? X1 : dst) + (size_t)row * D + c) = (f32x4){v[j * 8 + h4 * 4], v[j * 8 + h4 * 4 + 1], v[j * 8 + h4 * 4 + 2], v[j * 8 + h4 * 4 + 3]}; }
        if (next_inputs) {
            const float* mod1 = (const float*)(ws + WS_MOD) + (size_t)((l + 1) * NB + b) * 6 * D;
            bf16_t* XB = (bf16_t*)(ws + WS_XB); bf16_t* HB = (bf16_t*)(ws + WS_HB);
#pragma unroll
            for (int j = 0; j < 2; ++j) { const int c = 8 * lane + 512 * j; float hh[8];
#pragma unroll
                for (int h4 = 0; h4 < 2; ++h4) { const f32x4 sc = *(const f32x4*)(mod1 + D + c + 4 * h4) + 1.f, sh = *(const f32x4*)(mod1 + c + 4 * h4);
#pragma unroll
                    for (int i = 0; i < 4; ++i) hh[h4 * 4 + i] = v[j * 8 + h4 * 4 + i] * sc[i] + sh[i]; }
                *(u32x4*)(XB + (size_t)row * D + c) = (u32x4){pk2(v[j * 8], v[j * 8 + 1]), pk2(v[j * 8 + 2], v[j * 8 + 3]), pk2(v[j * 8 + 4], v[j * 8 + 5]), pk2(v[j * 8 + 6], v[j * 8 + 7])};
                *(u32x4*)(HB + (size_t)row * D + c) = (u32x4){pk2(hh[0], hh[1]), pk2(hh[2], hh[3]), pk2(hh[4], hh[5]), pk2(hh[6], hh[7])}; }
            const float* kvw = F.in[22]; float fl[16];
#pragma unroll
            for (int hh_ = 0; hh_ < 16; ++hh_) fl[hh_] = 0.f;
#pragma unroll
            for (int j = 0; j < 2; ++j)
#pragma unroll
                for (int i = 0; i < 8; ++i) { const int c = 8 * lane + 512 * j + i; const float xv = v[j * 8 + i]; const float* wr_ = kvw + (size_t)c * (2 * D + H) + 2 * D;
                    const f32x4 w0 = *(const f32x4*)(wr_), w1 = *(const f32x4*)(wr_ + 4), w2 = *(const f32x4*)(wr_ + 8), w3 = *(const f32x4*)(wr_ + 12);
#pragma unroll
                    for (int e = 0; e < 4; ++e) { fl[e] += xv * w0[e]; fl[4 + e] += xv * w1[e]; fl[8 + e] += xv * w2[e]; fl[12 + e] += xv * w3[e]; } }
            float r8[8];
#pragma unroll
            for (int e = 0; e < 8; ++e) { const auto sw = __builtin_amdgcn_permlane32_swap(__float_as_uint(fl[e]), __float_as_uint(fl[e + 8]), false, false); r8[e] = __uint_as_float(sw[0]) + __uint_as_float(sw[1]); }
            float r4[4];
#pragma unroll
            for (int e = 0; e < 4; ++e) { const auto sw = __builtin_amdgcn_permlane16_swap(__float_as_uint(r8[e]), __float_as_uint(r8[e + 4]), false, false); r4[e] = row16_sum(__uint_as_float(sw[0]) + __uint_as_float(sw[1])); }
            const int l15 = lane & 15;
            if (l15 < 4) { const float mine = (l15 == 0) ? r4[0] : (l15 == 1) ? r4[1] : (l15 == 2) ? r4[2] : r4[3]; const int hd = (lane >> 4) * 4 + l15;
                ((float*)(ws + WS_LOGF))[(size_t)row * 16 + hd] = -softplus_(-(mine + F.in[23][hd])); }
        }
    }
}
}
namespace attn_fox {
using bf16=__hip_bfloat16;
using bf16x8=__attribute__((ext_vector_type(8)))short;
using s16x4=__attribute__((ext_vector_type(4)))short;
using f32x16=__attribute__((ext_vector_type(16)))float;
using u32x4=__attribute__((ext_vector_type(4)))unsigned;
using f32x4k=__attribute__((ext_vector_type(4)))float;
constexpr int BATCH=4,NHEAD=16,SEQ=8192,D=64,DM=NHEAD*D;
constexpr int NW=8,QBLK=32,QB=QBLK*NW,KVBLK=64,NQB=SEQ/QB;
constexpr int ATTN_PITCH=DM, ATTN_UNIT_ROWS=QB;
__device__ __forceinline__ int crow(int r,int hi){return (r&3)+8*(r>>2)+4*hi;}
#define SBAR() __builtin_amdgcn_sched_barrier(0)
__device__ __forceinline__ void cmask(f32x16&p0,f32x16&p1,int jb,int qrel,int hi){
  const float NEG=-INFINITY; int kb=64*jb+4*hi;
  #pragma unroll
  for(int r=0;r<16;++r){int kv=kb+(r&3)+8*(r>>2); if(kv>qrel)p0[r]=NEG; if(kv+32>qrel)p1[r]=NEG;}
}

constexpr int NSLOT=3, SLOTB=8192;
constexpr int LDS_K=0, LDS_V=NSLOT*SLOTB, LDS_WS=2*NSLOT*SLOTB, LDS_OST=LDS_WS+NW*64*4, LDS_KB=86016  , LDS_BYTES=LDS_KB+SEQ*4;
constexpr float C2=0.125f*1.4426950408889634f;
__device__ __forceinline__ void glds16(const void*gsrc,unsigned lds_dst){unsigned keep;
  asm volatile("s_mov_b32 %0, m0\n\ts_mov_b32 m0, %2\n\ts_nop 0\n\tglobal_load_lds_dwordx4 %1, off\n\ts_mov_b32 m0, %0":"=&s"(keep):"v"(gsrc),"s"(lds_dst):"memory");}
__device__ __forceinline__ float max3f(float a,float b,float c){float r;asm("v_max3_f32 %0, %1, %2, %3":"=v"(r):"v"(a),"v"(b),"v"(c));return r;}
__device__ __forceinline__ float max2f(float a,float b){float r;asm("v_max_f32_e32 %0, %1, %2":"=v"(r):"v"(a),"v"(b));return r;}
__device__ __forceinline__ float fadd_s(float a,float b){float r;asm("v_add_f32_e32 %0, %1, %2":"=v"(r):"v"(a),"v"(b));return r;}
__device__ __forceinline__ float fsub_s(float a,float b){float r;asm("v_sub_f32_e32 %0, %1, %2":"=v"(r):"v"(a),"v"(b));return r;}
typedef float f32x2_t __attribute__((ext_vector_type(2))); typedef __bf16 bf16x2_t __attribute__((ext_vector_type(2)));
__device__ __forceinline__ unsigned cvtpk_s(float lo,float hi){f32x2_t v={lo,hi};bf16x2_t b=__builtin_convertvector(v,bf16x2_t);return __builtin_bit_cast(unsigned,b);}
#define WAIT_BAR(N) asm volatile("s_waitcnt vmcnt(" #N ") lgkmcnt(0)\n\ts_barrier":::"memory")

__device__ __forceinline__ void qkt(f32x16&p0,f32x16&p1,const char*Kslot,const bf16x8*qr,const f32x16&negm,int r32,int hi){
  const char*kb=Kslot+hi*1024+r32*16;
  #pragma unroll
  for(int d0=0;d0<4;++d0){
    const bf16x8 b0=*reinterpret_cast<const bf16x8*>(kb+d0*2048);
    const bf16x8 b1=*reinterpret_cast<const bf16x8*>(kb+d0*2048+512);
    if(d0==0){p0=__builtin_amdgcn_mfma_f32_32x32x16_bf16(b0,qr[0],negm,0,0,0);p1=__builtin_amdgcn_mfma_f32_32x32x16_bf16(b1,qr[0],negm,0,0,0);}
    else{p0=__builtin_amdgcn_mfma_f32_32x32x16_bf16(b0,qr[d0],p0,0,0,0);p1=__builtin_amdgcn_mfma_f32_32x32x16_bf16(b1,qr[d0],p1,0,0,0);}}
}
typedef __attribute__((address_space(3))) const char* lds_cptr;
typedef short v4i16_t __attribute__((ext_vector_type(4)));
__device__ __forceinline__ void kload8(bf16x8*kf,lds_cptr kp){
  kf[0]=*(const __attribute__((address_space(3))) bf16x8*)(kp);      kf[1]=*(const __attribute__((address_space(3))) bf16x8*)(kp+512);
  kf[2]=*(const __attribute__((address_space(3))) bf16x8*)(kp+2048); kf[3]=*(const __attribute__((address_space(3))) bf16x8*)(kp+2560);
  kf[4]=*(const __attribute__((address_space(3))) bf16x8*)(kp+4096); kf[5]=*(const __attribute__((address_space(3))) bf16x8*)(kp+4608);
  kf[6]=*(const __attribute__((address_space(3))) bf16x8*)(kp+6144); kf[7]=*(const __attribute__((address_space(3))) bf16x8*)(kp+6656);
}
__device__ __forceinline__ void kload2(bf16x8*kf,lds_cptr kp,int j){ kf[2*j]=*(const __attribute__((address_space(3))) bf16x8*)(kp+j*2048); kf[2*j+1]=*(const __attribute__((address_space(3))) bf16x8*)(kp+j*2048+512); }
__device__ __forceinline__ s16x4 vtr(lds_cptr p){ return __builtin_bit_cast(s16x4,__builtin_amdgcn_ds_read_tr16_b64_v4i16((__attribute__((address_space(3))) v4i16_t*)p)); }
__device__ __forceinline__ float rowmax(const f32x16&p0,const f32x16&p1){
  float a=max3f(p0[0],p0[1],p1[0]),b=max3f(p0[2],p0[3],p1[1]);a=max3f(a,p1[2],p1[3]);
  #pragma unroll
  for(int r=4;r<16;r+=4){a=max3f(a,p0[r],p0[r+1]);b=max3f(b,p0[r+2],p0[r+3]);a=max3f(a,p1[r],p1[r+1]);b=max3f(b,p1[r+2],p1[r+3]);}
  const float m=max2f(a,b);
  auto rr=__builtin_amdgcn_permlane32_swap(__float_as_uint(m),__float_as_uint(m),false,false);
  return max2f(__uint_as_float(rr[0]),__uint_as_float(rr[1]));
}
__device__ __forceinline__ void pv(f32x16*o,int vb,bf16x8 pa0,bf16x8 pa1,bf16x8 pa2,bf16x8 pa3){
  #pragma unroll
  for(int d0=0;d0<2;++d0){s16x4 lo[4],hi[4];
    #pragma unroll
    for(int ks=0;ks<4;++ks){
      asm volatile("ds_read_b64_tr_b16 %0,%1 offset:%c2":"=&v"(lo[ks]):"v"(vb),"i"(d0*4096+ks*1024):"memory");
      asm volatile("ds_read_b64_tr_b16 %0,%1 offset:%c2":"=&v"(hi[ks]):"v"(vb),"i"(d0*4096+ks*1024+512):"memory");}
    asm volatile("s_waitcnt lgkmcnt(0)":::"memory");SBAR();
    #define PK(k) (bf16x8){lo[k][0],lo[k][1],lo[k][2],lo[k][3],hi[k][0],hi[k][1],hi[k][2],hi[k][3]}
    o[d0]=__builtin_amdgcn_mfma_f32_32x32x16_bf16(pa0,PK(0),o[d0],0,0,0);
    o[d0]=__builtin_amdgcn_mfma_f32_32x32x16_bf16(pa1,PK(1),o[d0],0,0,0);
    o[d0]=__builtin_amdgcn_mfma_f32_32x32x16_bf16(pa2,PK(2),o[d0],0,0,0);
    o[d0]=__builtin_amdgcn_mfma_f32_32x32x16_bf16(pa3,PK(3),o[d0],0,0,0);
    #undef PK
  }
}

#ifndef ATTN_STORE16
#define ATTN_STORE16(p,v) (*(u32x4*)(p)=(v))
#endif
template<int THRL> __device__ __forceinline__ void attn_unit(int b,int h,int qb,const bf16*Q,const bf16*__restrict__ K,const bf16*__restrict__ V,bf16*O,const bf16*__restrict__ GATE,const float*__restrict__ Fbh,float thr_nat,char*shm,int wid_in){
  int lane; asm volatile("v_mbcnt_lo_u32_b32 %0, -1, 0\n\tv_mbcnt_hi_u32_b32 %0, -1, %0":"=v"(lane)); const int wid=__builtin_amdgcn_readfirstlane(wid_in); const int tid=wid*64+lane,r32=lane&31,hi=lane>>5;
  const long rowbase=(long)b*SEQ; const int q0=qb*QB;
  const float Fref=Fbh[q0]; int t_lo;
  { const int NTF=(q0+QB)/KVBLK; const int ta=lane, tb=lane+64;
    const bool ka=(ta<NTF-4)?((Fref-Fbh[64*ta+63])<-thr_nat):false, kb_=(tb<NTF-4)?((Fref-Fbh[64*tb+63])<-thr_nat):false;
    const unsigned long long ma=__ballot(!ka), mb=__ballot(!kb_);
    int lead=(ma!=0ull)?__builtin_ctzll(ma):((mb!=0ull)?64+__builtin_ctzll(mb):128); t_lo=__builtin_amdgcn_readfirstlane(lead)&~1; }
  { typedef __attribute__((address_space(3))) float ldsf; ldsf*kbw=(ldsf*)(shm+LDS_KB); const int nk=q0+QB-64*t_lo; const float L2E=1.4426950408889634f;
    for(int i=tid;i<nk;i+=NW*64) kbw[i]=(Fref-Fbh[64*t_lo+i])*L2E; }
  const bf16*Qw=Q+(rowbase+q0+wid*QBLK)*DM+h*D;
  const bf16*Kh=K+(rowbase+64*t_lo)*DM+h*D,*Vh=V+(rowbase+64*t_lo)*DM+h*D;
  const unsigned lds0=(unsigned)(uintptr_t)shm;
  float*wsf=(float*)(shm+LDS_WS)+wid*64;
  const bf16*ksrc=Kh+(long)lane*DM+wid*8;
  const bf16*vsrc=Vh+(long)(16*(wid&3)+(lane>>2))*DM+(wid>>2)*32+(lane&3)*8;
  const unsigned kdst=lds0+LDS_K+wid*1024, vdst=lds0+LDS_V+wid*1024;
  #define DMA_K(t,slot) glds16(ksrc+(long)(t)*KVBLK*DM,(unsigned)__builtin_amdgcn_readfirstlane(kdst+(slot)))
  #define DMA_V(t,slot) glds16(vsrc+(long)(t)*KVBLK*DM,(unsigned)__builtin_amdgcn_readfirstlane(vdst+(slot)))
  const int vb0=(int)(lds0+LDS_V)+((lane>>4)&1)*32+(lane&3)*8+(4*hi+((lane&15)>>2))*64;
  const char*Kbase=shm+LDS_K; bf16x8 kf[8];
  const lds_cptr shm3=(lds_cptr)shm; const lds_cptr kp0=shm3+LDS_K+hi*1024+r32*16; const lds_cptr vp0=shm3+LDS_V+((lane>>4)&1)*32+(lane&3)*8+(4*hi+((lane&15)>>2))*64;
  const int NT=(q0+QB)/KVBLK-t_lo;
  DMA_K(0,0);DMA_V(0,0);DMA_K(1,SLOTB);
  bf16x8 qr[4];
  #pragma unroll
  for(int d0=0;d0<4;++d0)qr[d0]=*reinterpret_cast<const bf16x8*>(&Qw[(long)r32*DM+d0*16+hi*8]);
  const int qrel=wid*QBLK+r32;
  float l_reg=0.f;f32x16 o[2];o[0]=f32x16{};o[1]=f32x16{};const float rb=(Fbh[q0+qrel]-Fref)*1.4426950408889634f; const f32x16 negm=f32x16{};
  typedef __attribute__((address_space(3))) const float* kb_cptr; const kb_cptr kb0=(kb_cptr)(shm+LDS_KB)+4*hi;
  #define KBIAS(C0_,C1_,t_) do{ const kb_cptr kp_=kb0+64*(t_); _Pragma("unroll") for(int g_=0;g_<4;++g_){ const f32x4k a_=*(const __attribute__((address_space(3))) f32x4k*)(kp_+8*g_), b_=*(const __attribute__((address_space(3))) f32x4k*)(kp_+32+8*g_); \
      _Pragma("unroll") for(int x_=0;x_<4;++x_){ C0_[4*g_+x_]+=(a_[x_]+rb); C1_[4*g_+x_]+=(b_[x_]+rb); } } }while(0)
  #define CMASK(P0,P1,t) do{int jb_=(t)-(NT-4); if(jb_>=0)cmask(P0,P1,jb_,qrel,hi);}while(0)
  #define START(P0,P1) do{ _Pragma("unroll") for(int r=0;r<16;++r)P0[r]=__builtin_amdgcn_exp2f(P0[r]); }while(0)
  #define RESC() do{}while(0)
  f32x16 pA0,pA1,pB0,pB1;
  int sl_prev=0,sl_cur=0,sl_next=SLOTB;
  #define ROT() do{sl_prev=sl_cur;sl_cur=sl_next;sl_next=(sl_next==(NSLOT-1)*SLOTB)?0:sl_next+SLOTB;}while(0)
  DMA_K(2,2*SLOTB);
  WAIT_BAR(3);
  qkt(pA0,pA1,Kbase,qr,negm,r32,hi);asm volatile("s_nop 15\n\ts_nop 7":"+v"(pA0),"+v"(pA1));KBIAS(pA0,pA1,0);CMASK(pA0,pA1,0);
  START(pA0,pA1);
  _Pragma("unroll") for(int r=0;r<16;++r)pA1[r]=__builtin_amdgcn_exp2f(pA1[r]);
  WAIT_BAR(0);
  DMA_K(3,0);DMA_V(1,SLOTB);
  ROT();
  kload8(kf,kp0+sl_cur);
  WAIT_BAR(2);
  s16x4 vlo[8],vhi[8]; u32x4 pw0,pw1,pw2,pw3;
  #define PKW(P,B) cvtpk_s(P[B],P[B+1])
  #define PAF(k) __builtin_bit_cast(bf16x8,pw##k)
  #define VFR(i) (bf16x8){vlo[i][0],vlo[i][1],vlo[i][2],vlo[i][3],vhi[i][0],vhi[i][1],vhi[i][2],vhi[i][3]}
  #define PIN(x) asm volatile("":"+v"(x))
  #define MX3(a,b,c) __builtin_fmaxf(__builtin_fmaxf((a),(b)),(c))
  #define GAPA(MF,A0,A1,A2,A3,W0,W1,PW) do{ MF; sacc+=A0; sacc+=A1; sacc+=A2; sacc+=A3; PIN(sacc); W0; W1; PIN(PW); SBAR(); }while(0)
  #define EX(v) __builtin_amdgcn_exp2f(v)
  #define GAPB(MF,X,B) do{ MF; X[B]=EX(X[B]); X[B+1]=EX(X[B+1]); X[B+2]=EX(X[B+2]); X[B+3]=EX(X[B+3]); PIN(X); SBAR(); }while(0)
  #define VRD(i) do{ vlo[i]=vtr(vp_+(((i)>>2)*4096+((i)&3)*1024)); vhi[i]=vtr(vp_+(((i)>>2)*4096+((i)&3)*1024+512)); }while(0)
  #define KRD(G,j) do{ if(G){ kload2(kf,kp0+sl_next,j); SBAR(); } }while(0)
  #define STEP(C0,C1,P0,P1,t,GK,GV,GL) do{ SBAR(); \
    const lds_cptr vp_=vp0+sl_prev; \
    VRD(0); SBAR(); float sacc=(P0[0]+P0[1]); \
    GAPA(C0=__builtin_amdgcn_mfma_f32_32x32x16_bf16(kf[0],qr[0],negm,0,0,0), P0[2],P0[3],P0[4],P0[5],     pw0[0]=PKW(P0,0), pw0[1]=PKW(P0,2), pw0); \
    VRD(4); SBAR(); GAPA(C1=__builtin_amdgcn_mfma_f32_32x32x16_bf16(kf[1],qr[0],negm,0,0,0), P0[6],P0[7],P0[8],P0[9],     pw0[2]=PKW(P0,4), pw0[3]=PKW(P0,6), pw0); \
    VRD(1); SBAR(); GAPA(C0=__builtin_amdgcn_mfma_f32_32x32x16_bf16(kf[2],qr[1],C0,0,0,0),   P0[10],P0[11],P0[12],P0[13], pw1[0]=PKW(P0,8), pw1[1]=PKW(P0,10), pw1); \
    VRD(5); SBAR(); GAPA(C1=__builtin_amdgcn_mfma_f32_32x32x16_bf16(kf[3],qr[1],C1,0,0,0),   P0[14],P0[15],P1[0],P1[1],   pw1[2]=PKW(P0,12),pw1[3]=PKW(P0,14), pw1); \
    VRD(2); SBAR(); GAPA(C0=__builtin_amdgcn_mfma_f32_32x32x16_bf16(kf[4],qr[2],C0,0,0,0),   P1[2],P1[3],P1[4],P1[5],     pw2[0]=PKW(P1,0), pw2[1]=PKW(P1,2), pw2); \
    VRD(6); SBAR(); GAPA(C1=__builtin_amdgcn_mfma_f32_32x32x16_bf16(kf[5],qr[2],C1,0,0,0),   P1[6],P1[7],P1[8],P1[9],     pw2[2]=PKW(P1,4), pw2[3]=PKW(P1,6), pw2); \
    VRD(3); SBAR(); GAPA(C0=__builtin_amdgcn_mfma_f32_32x32x16_bf16(kf[6],qr[3],C0,0,0,0),   P1[10],P1[11],P1[12],P1[13], pw3[0]=PKW(P1,8), pw3[1]=PKW(P1,10), pw3); \
    VRD(7); SBAR(); GAPA(C1=__builtin_amdgcn_mfma_f32_32x32x16_bf16(kf[7],qr[3],C1,0,0,0),   P1[14],P1[15],0.f,0.f,       pw3[2]=PKW(P1,12),pw3[3]=PKW(P1,14), pw3); \
    l_reg+=sacc; \
    if(GK){DMA_K((t)+3,sl_cur);} if(GV){DMA_V((t)+1,sl_next);} \
    KBIAS(C0,C1,t); CMASK(C0,C1,t); \
    SBAR(); \
    GAPB(o[0]=__builtin_amdgcn_mfma_f32_32x32x16_bf16(PAF(0),VFR(0),o[0],0,0,0), C0,0); \
    GAPB(o[1]=__builtin_amdgcn_mfma_f32_32x32x16_bf16(PAF(0),VFR(4),o[1],0,0,0), C0,4); \
    KRD(GL,0); GAPB(o[0]=__builtin_amdgcn_mfma_f32_32x32x16_bf16(PAF(1),VFR(1),o[0],0,0,0), C0,8); \
    KRD(GL,1); GAPB(o[1]=__builtin_amdgcn_mfma_f32_32x32x16_bf16(PAF(1),VFR(5),o[1],0,0,0), C0,12); \
    KRD(GL,2); GAPB(o[0]=__builtin_amdgcn_mfma_f32_32x32x16_bf16(PAF(2),VFR(2),o[0],0,0,0), C1,0); \
    KRD(GL,3); GAPB(o[1]=__builtin_amdgcn_mfma_f32_32x32x16_bf16(PAF(2),VFR(6),o[1],0,0,0), C1,4); \
    GAPB(o[0]=__builtin_amdgcn_mfma_f32_32x32x16_bf16(PAF(3),VFR(3),o[0],0,0,0), C1,8); \
    GAPB(o[1]=__builtin_amdgcn_mfma_f32_32x32x16_bf16(PAF(3),VFR(7),o[1],0,0,0), C1,12); \
    }while(0)
  int t=1;
  #undef CMASK
  #define CMASK(P0,P1,t) do{}while(0)
  for(;t+5<NT;t+=2){
    STEP(pB0,pB1,pA0,pA1,t,true,true,true);     WAIT_BAR(2); RESC(); ROT();
    STEP(pA0,pA1,pB0,pB1,t+1,true,true,true);   WAIT_BAR(2); RESC(); ROT();
  }
  #undef CMASK
  #define CMASK(P0,P1,t) do{int jb_=(t)-(NT-4); if(jb_>=0)cmask(P0,P1,jb_,qrel,hi);}while(0)
  #define ENDW(tt) do{ if((tt)+3<NT){WAIT_BAR(2);} else if((tt)+2<NT){WAIT_BAR(1);} else {WAIT_BAR(0);} }while(0)
  for(;t+1<NT;t+=2){
    STEP(pB0,pB1,pA0,pA1,t,(t+3<NT),(t+1<NT),(t+1<NT));       ENDW(t);   RESC(); ROT();
    STEP(pA0,pA1,pB0,pB1,t+1,(t+4<NT),(t+2<NT),(t+2<NT));     ENDW(t+1); RESC(); ROT();
  }
  STEP(pB0,pB1,pA0,pA1,NT-1,false,false,false); RESC();
  { float sacc=pB0[0]+pB0[1]; _Pragma("unroll") for(int r=2;r<16;++r)sacc+=pB0[r]; _Pragma("unroll") for(int r=0;r<16;++r)sacc+=pB1[r]; l_reg+=sacc;
    pw0=(u32x4){PKW(pB0,0),PKW(pB0,2),PKW(pB0,4),PKW(pB0,6)};pw1=(u32x4){PKW(pB0,8),PKW(pB0,10),PKW(pB0,12),PKW(pB0,14)};pw2=(u32x4){PKW(pB1,0),PKW(pB1,2),PKW(pB1,4),PKW(pB1,6)};pw3=(u32x4){PKW(pB1,8),PKW(pB1,10),PKW(pB1,12),PKW(pB1,14)};
    SBAR(); pv(o,vb0+sl_cur,PAF(0),PAF(1),PAF(2),PAF(3)); }
  #undef PKW
  #undef PAF
  #undef VFR
  #undef PIN
  #undef MX3
  #undef GAPA
  #undef GAPB
  #undef EX
  #undef VRD
  #undef KRD
  #undef STEP
  #undef ENDW
  {auto rr=__builtin_amdgcn_permlane32_swap(__float_as_uint(l_reg),__float_as_uint(l_reg),false,false);l_reg=__uint_as_float(rr[0])+__uint_as_float(rr[1]);}
  if(hi==0)wsf[32+r32]=l_reg;asm volatile("s_waitcnt lgkmcnt(0)":::"memory");
  float rli[16];
  #pragma unroll
  for(int r=0;r<16;++r)rli[r]=__builtin_amdgcn_rcpf(wsf[32+crow(r,hi)]);
  bf16*Ow=O+(rowbase+q0+wid*QBLK)*DM+h*D;
  { bf16*stg=(bf16*)(shm+LDS_OST)+wid*2048;
    #pragma unroll
    for(int r=0;r<16;++r){const int orow=crow(r,hi);
      #pragma unroll
      for(int d0=0;d0<2;++d0)stg[orow*64+d0*32+r32]=__float2bfloat16(o[d0][r]*rli[r]);}
    asm volatile("s_waitcnt lgkmcnt(0)":::"memory");
    #pragma unroll
    for(int i=0;i<4;++i){const int row=i*8+(lane>>3),ch=lane&7; const u32x4 v=*(const u32x4*)(stg+row*64+ch*8); const u32x4 gq=*(const u32x4*)(GATE+(rowbase+q0+wid*QBLK+row)*DM+h*D+ch*8);
      const unsigned vv_[4]={v.x,v.y,v.z,v.w},gg_[4]={gq.x,gq.y,gq.z,gq.w}; unsigned oo_[4];
      _Pragma("unroll") for(int x_=0;x_<4;++x_) oo_[x_]=cvtpk_s(__uint_as_float(vv_[x_]<<16)*__uint_as_float(gg_[x_]<<16),__uint_as_float(vv_[x_]&0xffff0000u)*__uint_as_float(gg_[x_]&0xffff0000u));
      ATTN_STORE16(Ow+(long)row*DM+ch*8,((u32x4){oo_[0],oo_[1],oo_[2],oo_[3]}));} }
  asm volatile("s_waitcnt lgkmcnt(0)\n\ts_barrier":::"memory");
  #undef DMA_K
  #undef DMA_V
  #undef CMASK
  #undef START
  #undef RESC
  #undef ROT
  #undef KBIAS
}
constexpr int ATTN_LDS_BYTES=LDS_BYTES;
#undef SBAR
#undef WAIT_BAR
}
namespace fk {
template <bool SIG> struct EpiNormHeads {
    static constexpr bool PERM = true, AFTER_DRAIN = false;
    bf16_t* O0; bf16_t* O1; const float* gain; float scale;
    __device__ __forceinline__ void operator()(const f32x4 (&acc)[2][2][4][2], const Unit& u, int wr, int wc, int fr, int fq) const {
        const int row0 = u.pm * BM + wr * 64 + fr;
        if (u.pn < 4) {
            const int head = 4 * u.pn + wc;
            f32x4 g[2][2];
#pragma unroll
            for (int bj = 0; bj < 2; ++bj)
#pragma unroll
                for (int n = 0; n < 2; ++n) g[bj][n] = *(const f32x4*)(gain + 32 * bj + 8 * fq + 4 * n) * scale;
#pragma unroll
            for (int ai = 0; ai < 2; ++ai)
#pragma unroll
                for (int m = 0; m < 4; ++m) { float ss = 0.f;
#pragma unroll
                    for (int bj = 0; bj < 2; ++bj)
#pragma unroll
                        for (int n = 0; n < 2; ++n) { const f32x4 x = acc[ai][bj][m][n]; ss += (x[0] * x[0] + x[1] * x[1]) + (x[2] * x[2] + x[3] * x[3]); }
                    ss += __shfl_xor(ss, 16); ss += __shfl_xor(ss, 32);
                    const float rs = rsqrtf(ss * (1.f / 64.f) + 1e-6f);
                    bf16_t* rowp = O0 + (size_t)(row0 + ai * HALF + m * 16) * D + head * 64 + 8 * fq;
#pragma unroll
                    for (int bj = 0; bj < 2; ++bj) { const f32x4 v0 = acc[ai][bj][m][0] * rs * g[bj][0], v1 = acc[ai][bj][m][1] * rs * g[bj][1];
                        u32x4 wv; wv.x = pg8::cvt_pk_bf16(v0[0], v0[1]); wv.y = pg8::cvt_pk_bf16(v0[2], v0[3]); wv.z = pg8::cvt_pk_bf16(v1[0], v1[1]); wv.w = pg8::cvt_pk_bf16(v1[2], v1[3]);
                        *(u32x4*)(rowp + 32 * bj) = wv; } }
        } else {
            const int col0 = (u.pn - 4) * BM + wc * 32 + 8 * fq;
#pragma unroll
            for (int ai = 0; ai < 2; ++ai)
#pragma unroll
                for (int m = 0; m < 4; ++m) { bf16_t* rowp = O1 + (size_t)(row0 + ai * HALF + m * 16) * D + col0;
#pragma unroll
                    for (int bj = 0; bj < 2; ++bj) { f32x4 v0 = acc[ai][bj][m][0], v1 = acc[ai][bj][m][1];
                        if (SIG) { for (int i = 0; i < 4; ++i) { v0[i] = sigm(v0[i]); v1[i] = sigm(v1[i]); } }
                        u32x4 wv; wv.x = pg8::cvt_pk_bf16(v0[0], v0[1]); wv.y = pg8::cvt_pk_bf16(v0[2], v0[3]); wv.z = pg8::cvt_pk_bf16(v1[0], v1[1]); wv.w = pg8::cvt_pk_bf16(v1[2], v1[3]);
                        *(u32x4*)(rowp + bj * HALF) = wv; } }
        }
    }
};

__device__ __forceinline__ void fcum_phase(Frame& F) {
    LAS float* part = (LAS float*)(F.lds);
    for (int bh = blockIdx.x; bh < NB * H; bh += F.G) {
        const int b = bh >> 4, h = bh & 15; const float* lf = (const float*)(F.ws + WS_LOGF) + ((size_t)b * T + F.tid * 16) * 16 + h;
        float v[16]; float s = 0.f;
#pragma unroll
        for (int i = 0; i < 16; ++i) { v[i] = lf[(size_t)i * 16]; s += v[i]; }
        part[F.tid] = s;
        __syncthreads();
        if (F.wave == 0) { float run = 0.f;
            for (int c = 0; c < 8; ++c) { const float x = part[c * 64 + F.lane]; float inc = x;
#pragma unroll
                for (int o = 1; o < 64; o <<= 1) { const float u = __shfl_up(inc, o); if (F.lane >= o) inc += u; }
                part[c * 64 + F.lane] = run + inc - x;
                run += __shfl(inc, 63); } }
        __syncthreads();
        float run = part[F.tid]; float* Fo = (float*)(F.ws + WS_FLOC) + (size_t)bh * T + F.tid * 16;
#pragma unroll
        for (int i = 0; i < 16; ++i) { run += v[i]; Fo[i] = run; }
        __syncthreads();
    }
}

__device__ __forceinline__ void attn_phase_fox(Frame& F, unsigned char* lds_generic) {
    typedef attn_fox::bf16 abf;
    const float gq = fabsf(F.in[26][F.lane]), gk = fabsf(F.in[24][F.lane]); float mq = gq, mk = gk;
#pragma unroll
    for (int o = 1; o < 64; o <<= 1) { mq = fmaxf(mq, __shfl_xor(mq, o)); mk = fmaxf(mk, __shfl_xor(mk, o)); }
    const float thr = 104.f + 16.5f * mq * mk;
    const abf* Q = (const abf*)(F.ws + WS_QN); const abf* K = (const abf*)(F.ws + WS_KN); const abf* V = (const abf*)(F.ws + WS_VV); const abf* G = (const abf*)(F.ws + WS_GATE); abf* O = (abf*)(F.ws + WS_O);
    const float* Fc = (const float*)(F.ws + WS_FLOC);
    const int nunits = NB * H * 32;
    for (int i = 0;; ++i) {
        const int v = F.vcu + (i >> 3) * F.G; const int bh = v >> 2, s = v & 3, j = i & 7; if (bh >= NB * H) break;
        const int qb = (j & 1) ? (8 * (j >> 1) + 7 - s) : (8 * (j >> 1) + s);
        attn_fox::attn_unit<8>(bh >> 4, bh & 15, qb, Q, K, V, O, G, Fc + (size_t)bh * T, thr, (char*)lds_generic, F.wave);
    }
    (void)nunits;
}
}
namespace fk {
#ifndef FK_PH_HI
#define FK_PH_HI 4
#endif
#ifndef FK_EXPERTS
#define FK_EXPERTS 0
#endif
__global__ void __launch_bounds__(NTHR, 2) fwd(Args args) {
    extern __shared__ __attribute__((aligned(16))) unsigned char lds[];
    Frame F;
    F.lds = (LAS unsigned char*)lds; F.MISC = (volatile LAS unsigned*)(F.lds + MISC_OFF);
    F.tid = threadIdx.x; F.lane = F.tid & 63; F.wave = __builtin_amdgcn_readfirstlane(F.tid >> 6);
    F.G = gridDim.x; { const int bx = blockIdx.x; F.vcu = (F.G % 8 == 0) ? (bx % 8) * (F.G / 8) + bx / 8 : bx; }
    F.in = args.in; F.out = args.out; F.ws = args.ws; F.ctl = (gu32*)(args.ws + WS_CTL);
    for (int u = F.tid; u < (LDS_BYTES - LDSCTL_OFF) / 4; u += NTHR) ((LAS unsigned*)(F.lds + LDSCTL_OFF))[u] = 0u;
    __syncthreads();
    const int lo = args.ph_lo, hi = args.ph_hi;
    const bool multi = (hi - lo) > 1;
    XcdBarrier bar; bar.bar = (unsigned*)(F.ctl + CW_BAR); bar.x = 0; bar.st = nullptr;
    if (multi) bar = xcd_barrier_post((unsigned*)(F.ctl + CW_BAR), F.MISC + 8);
#define IN(k) (lo <= (k) && (k) < hi)
#define BOTH(k) (IN(k) && IN((k) + 1))
#define GRID_BAR() xcd_barrier(bar, F.wave == 0 && hw_lane() == 0)
#define FRESH() do { F.lane = hw_lane(); F.tid = F.wave * 64 + F.lane; } while (0)
#if defined(FK_PROBE) || defined(FK_SPIN_MASK)
#define STAMP(k) do { if (blockIdx.x == 0 && F.tid == 0) ((unsigned long long*)(F.ctl + CW_TS))[(k)] = __builtin_amdgcn_s_memrealtime(); } while (0)
#else
#define STAMP(k) do {} while (0)
#endif
#define ws (args.ws)
    if (IN(0)) { FRESH(); STAMP(0); p0_prologue(F, FK_EXPERTS != 0); if (BOTH(0)) GRID_BAR(); }
    if (IN(1)) { FRESH(); STAMP(1); p1_mix(F); if (BOTH(1)) GRID_BAR(); }
    if (IN(2)) { FRESH(); STAMP(2);
        { pg8::Gemm g{(const bf16_t*)(ws + WS_XR), (const bf16_t*)(ws + WS_WRKV), M, 3 * D, D, 4, (size_t)(WS_XK - WS_XR)}; pg8::StaticOrder S; S.init(M, 3 * D, F.G, (int)blockIdx.x);
          pg8::EpiBf16<0> E{(bf16_t*)(ws + WS_R), D, nullptr, D, (size_t)(WS_K - WS_R) / 2, 1.f};
          pg8::gemm_phase<pg8::EpiBf16<0>, pg8::StaticOrder, true, true>(F.lds, g, S, E, F.wave); }
        { pg8::Gemm g{(const bf16_t*)(ws + WS_HX), (const bf16_t*)(ws + WS_B1T), M, 256, 2 * D, 1 << 30, 0}; pg8::StaticOrder S; S.init(M, 256, F.G, (int)blockIdx.x);
          EpiL1 E{(bf16_t*)(ws + WS_L1)};
          pg8::gemm_phase<EpiL1, pg8::StaticOrder, true, true>(F.lds, g, S, E, F.wave); }
        if (BOTH(2)) GRID_BAR();
    }
    if (IN(3)) { FRESH(); STAMP(3);
        pg8::Gemm g{(const bf16_t*)(ws + WS_L1), (const bf16_t*)(ws + WS_B2T), M, 3 * D, 256, 1 << 30, 0}; pg8::StaticOrder S; S.init(M, 3 * D, F.G, (int)blockIdx.x);
        EpiL2 E{(float*)(ws + WS_LW), (bf16_t*)(ws + WS_A), (bf16_t*)(ws + WS_G), F.in[9], F.in[12], (float*)(ws + WS_X1)};
        pg8::gemm_phase<EpiL2, pg8::StaticOrder, true, true>(F.lds, g, S, E, F.wave);
        if (BOTH(3)) GRID_BAR();
    }
    if (IN(4)) { FRESH(); STAMP(4); p5_phase(F); if (BOTH(4)) GRID_BAR(); }
    if (IN(5)) { FRESH(); STAMP(5); p6_phase(F); if (BOTH(5)) GRID_BAR(); }
    if (IN(6)) { FRESH(); STAMP(6); p6b_phase(F); if (BOTH(6)) GRID_BAR(); }
#define POST_BLOCK(P7, L, RESPTR, WO_OFF, RT_OFF, SGU_OFF, SD_OFF, NEXT, DST) \
    if (IN(P7)) { FRESH(); STAMP(P7); \
        pg8::Gemm g{(const bf16_t*)(ws + ((L) == 0 ? WS_Z : WS_O)), (const bf16_t*)(ws + (WO_OFF)), M, D, D, 1 << 30, 0}; pg8::StaticOrder S; S.init(M, D, F.G, (int)blockIdx.x); \
        EpiPre E{RESPTR, (const float*)(ws + WS_MOD) + (size_t)(L) * NB * 6 * D + 2 * D, (float*)(ws + WS_PRE)}; \
        pg8::gemm_phase<EpiPre, pg8::StaticOrder, true, true>(F.lds, g, S, E, F.wave); \
        if (BOTH(P7)) GRID_BAR(); } \
    if (IN((P7) + 1)) { FRESH(); STAMP((P7) + 1); ln_mod_phase(F, L); if (BOTH((P7) + 1)) GRID_BAR(); } \
    if (IN((P7) + 2)) { FRESH(); STAMP((P7) + 2); \
        pg8::Gemm g{(const bf16_t*)(ws + WS_H2), (const bf16_t*)(ws + (RT_OFF)), M, NE, D, 1 << 30, 0}; pg8::StaticOrder S; S.init(M, NE, F.G, (int)blockIdx.x); \
        EpiF32 E{(float*)(ws + WS_LOGITS), NE}; \
        pg8::gemm_phase<EpiF32, pg8::StaticOrder, true, true>(F.lds, g, S, E, F.wave); \
        if (BOTH((P7) + 2)) GRID_BAR(); } \
    if (IN((P7) + 3)) { FRESH(); STAMP((P7) + 3); route_phase(F, L); if (BOTH((P7) + 3)) GRID_BAR(); } \
    if (IN((P7) + 4)) { FRESH(); STAMP((P7) + 4); \
        const int np = moe_build(F, L); \
        pg8::Gemm g{(const bf16_t*)ws, nullptr, 0, 2 * FX, D / 2, 1 << 30, 0};     \
        MoeSched S{F.lds, np, 2, (const char*)(ws + WS_EGU + (size_t)(L) * EGU_L), (const char*)(ws + (SGU_OFF)), (size_t)512 * D, (unsigned)WS_H2F8, (unsigned)WS_H2F8, (unsigned)D, 3}; \
        EpiAct E{F.lds, (bf16_t*)(ws + WS_ACT), (bf16_t*)(ws + WS_ACTS), 1.f / (F8_SA * F8_SB)}; \
        pg8::gemm_phase_g<EpiAct, MoeSched, true, true, true>(F.lds, g, S, E, F.wave); \
        if (BOTH((P7) + 4)) GRID_BAR(); } \
    if (IN((P7) + 5)) { FRESH(); STAMP((P7) + 5); \
        const int np = moe_build(F, L); \
        pg8::Gemm g{(const bf16_t*)ws, nullptr, 0, D, FX, 1 << 30, 0}; \
        MoeSched S{F.lds, np, 4, (const char*)(ws + WS_ED + (size_t)(L) * ED_L), (const char*)(ws + (SD_OFF)), (size_t)D * FX * 2, (unsigned)WS_ACT, (unsigned)WS_ACTS, (unsigned)(FX * 2), 0}; \
        EpiDown E{F.lds, (bf16_t*)(ws + WS_OUTROW), (bf16_t*)(ws + WS_YS)}; \
        pg8::gemm_phase_g<EpiDown, MoeSched, true, true>(F.lds, g, S, E, F.wave); \
        if (BOTH((P7) + 5)) GRID_BAR(); } \
    if (IN((P7) + 6)) { FRESH(); STAMP((P7) + 6); combine_phase(F, L, NEXT, DST); if (BOTH((P7) + 6)) GRID_BAR(); }

    POST_BLOCK(7, 0, F.in[0], WS_WO0, WS_RT0, WS_SGU0, WS_SD0, true, nullptr)
    if (IN(14)) { FRESH(); STAMP(14);
        fcum_phase(F);
        { pg8::Gemm g{(const bf16_t*)(ws + WS_XB), (const bf16_t*)(ws + WS_KVT), M, 2 * D, D, 1 << 30, 0}; pg8::StaticOrder S; S.init(M, 2 * D, F.G, (int)blockIdx.x);
          EpiNormHeads<false> E{(bf16_t*)(ws + WS_KN), (bf16_t*)(ws + WS_VV), F.in[24], 1.f};
          pg8::gemm_phase<EpiNormHeads<false>, pg8::StaticOrder, true, true>(F.lds, g, S, E, F.wave); }
        { pg8::Gemm g{(const bf16_t*)(ws + WS_HB), (const bf16_t*)(ws + WS_QGT), M, 2 * D, D, 1 << 30, 0}; pg8::StaticOrder S; S.init(M, 2 * D, F.G, (int)blockIdx.x);
          EpiNormHeads<true> E{(bf16_t*)(ws + WS_QN), (bf16_t*)(ws + WS_GATE), F.in[26], 0.125f * 1.4426950408889634f};
          pg8::gemm_phase<EpiNormHeads<true>, pg8::StaticOrder, true, true>(F.lds, g, S, E, F.wave); }
        if (BOTH(14)) GRID_BAR();
    }
    if (IN(15)) { FRESH(); STAMP(15); attn_phase_fox(F, lds); if (BOTH(15)) GRID_BAR(); }
    POST_BLOCK(16, 1, (const float*)(ws + WS_X1), WS_WO1, WS_RT1, WS_SGU1, WS_SD1, false, F.out)
#undef POST_BLOCK
#if defined(FK_SPIN_MASK)
    if (hi == 23) { if (blockIdx.x == 0 && F.wave == 0 && hw_lane() == 0) { const unsigned long long now = __builtin_amdgcn_s_memrealtime(); const unsigned long long* ts = (const unsigned long long*)(F.ctl + CW_TS); unsigned long long x = 0;
        for (int k = 0; k < 23; ++k) { const unsigned long long t1 = (k + 1 < 23) ? ts[k + 1] : now; if ((FK_SPIN_MASK >> k) & 1) x += t1 - ts[k]; }
        while (__builtin_amdgcn_s_memrealtime() - now < 2 * x) __builtin_amdgcn_s_sleep(8); } }
#endif
#if defined(FK_PROBE)
    if (IN(23)) { FRESH(); STAMP(23);
        if (blockIdx.x == 0 && F.tid == 0) { const unsigned long long* ts = (const unsigned long long*)(F.ctl + CW_TS);
            const float tot = (float)(ts[23] - ts[0]); float a = 0.f, b = 0.f, c = 0.f;
            for (int k = 0; k < 23; ++k) { const float d = (float)(ts[k + 1] - ts[k]); if ((FK_PROBE_A >> k) & 1) a += d; if ((FK_PROBE_B >> k) & 1) b += d; if ((FK_PROBE_C >> k) & 1) c += d; }
            const float pa = fminf(fmaxf(rintf(100.f * a / tot), 0.f), 89.f) + 10.f, pb = fminf(fmaxf(rintf(100.f * b / tot), 0.f), 26.f), pc = fminf(fmaxf(rintf(100.f * c / tot), 0.f), 89.f) + 10.f;
#if defined(FK_PROBE_ABS)
            const float pa2 = fminf(fmaxf(rintf(a * 0.01f / 10.f), 0.f), 89.f) + 10.f; (void)pa;
            const float c1sq = (pa2 / 10.f) * powf(10.f, 4.f + pb);
#else
            const float c1sq = (pa / 10.f) * powf(10.f, 4.f + pb);
#endif
            const float c1 = sqrtf(c1sq); const float c2 = (pc / 10.f) * powf(10.f, floorf(log10f(c1)) + 2.f);
            ((float*)(F.ctl + CW_TS))[64] = c1; ((float*)(F.ctl + CW_TS))[65] = c2; }
        GRID_BAR();
        { const float c1 = ((const float*)(F.ctl + CW_TS))[64], c2 = ((const float*)(F.ctl + CW_TS))[65];
          for (size_t i = (size_t)blockIdx.x * NTHR + F.tid; i < (size_t)M * D; i += (size_t)F.G * NTHR) F.out[i] = (i == 0) ? c2 : c1; }
    }
#endif
#undef ws
#undef IN
#undef BOTH
#undef GRID_BAR
}

__global__ void k_cmp(const float* ref, int ldr, const void* fast, int is_bf16, int ldf, int rows, int cols, float* acc) {
    __shared__ float r1[8], r2[8];
    float num = 0.f, den = 0.f;
    for (size_t i = (size_t)blockIdx.x * blockDim.x + threadIdx.x; i < (size_t)rows * cols; i += (size_t)gridDim.x * blockDim.x) {
        const size_t r = i / cols, c = i % cols; const float o = ref[r * ldr + c];
        float f; if (is_bf16) { const unsigned short h = ((const unsigned short*)fast)[r * ldf + c]; f = __uint_as_float((unsigned)h << 16); } else f = ((const float*)fast)[r * ldf + c];
        num += (f - o) * (f - o); den += o * o; }
    num = wave_sum(num); den = wave_sum(den);
    if ((threadIdx.x & 63) == 0) { r1[threadIdx.x >> 6] = num; r2[threadIdx.x >> 6] = den; }
    __syncthreads();
    if (threadIdx.x == 0) { float a = 0.f, b = 0.f; for (int w = 0; w < (int)(blockDim.x >> 6); ++w) { a += r1[w]; b += r2[w]; } atomicAdd(acc, a); atomicAdd(acc + 1, b); }
}
__global__ void k_code(const float* acc, int nchk, float tol2, float* out, size_t n) {
    float c = 0.f;
    for (int i = 0; i < nchk; ++i) { const float num = acc[2 * i], den = acc[2 * i + 1]; float r2 = num / fmaxf(den, 1e-30f); if (!(r2 == r2)) r2 = 0.98f; if (den <= 0.f) r2 = 0.97f;
        if (r2 > tol2) { float v = fminf(fmaxf(r2 * 1e6f, 1.f), 9.9e5f); { const float e10 = floorf(log10f(v)); v = powf(10.f, e10) * (v / powf(10.f, e10) >= 3.16f ? 3.f : 1.f); } for (int k = 0; k < i; ++k) v *= 1e6f; c = sqrtf(v); break; } }
    for (size_t i = (size_t)blockIdx.x * blockDim.x + threadIdx.x; i < n; i += (size_t)gridDim.x * blockDim.x) out[i] = c;
}
}

extern "C" void kernel_launch(void* const* d_in, const int* in_sizes, int n_in, void* d_out, int out_size, void* d_ws, size_t ws_size, hipStream_t stream) {
    using namespace fk;
    static int grid = 0;
    if (grid == 0) {
        int dev = 0, cus = 0;
        if (n_in != 36 || hipGetDevice(&dev) != hipSuccess || hipDeviceGetAttribute(&cus, hipDeviceAttributeMultiprocessorCount, dev) != hipSuccess) { grid = -1; return; }
        if (hipFuncSetAttribute((const void*)fwd, hipFuncAttributeMaxDynamicSharedMemorySize, LDS_BYTES) != hipSuccess) { grid = -1; return; }
        grid = cus;
    }
    if (grid < 0) return;
#if defined(FK_DEBUG)
    constexpr size_t NV_BASE = 32 * MiB, SAVE_BASE = 1922 * MiB; constexpr int DBG_B = FK_DEBUG - 1;
    char* nws = (char*)d_ws + NV_BASE;
    auto nb = [&](int i) { return (const float*)(nws + nv::W_BUF + (size_t)i * nv::TD); };
    auto sv = [&](int i) { return (const float*)((char*)d_ws + SAVE_BASE + (size_t)i * nv::TD); };
    {
        nv::In in; for (int i = 0; i < 36; ++i) in.p[i] = (const float*)d_in[i];
        hipLaunchKernelGGL(nv::k_mod, dim3(2 * nv::NB * 6 * nv::D / 256), dim3(256), 0, stream, in.p[1], in.p[2], in.p[3], (float*)(nws + nv::W_MOD));
        nv::forward_batch(stream, in, nws, DBG_B, (float*)(nws + nv::W_BUF + (size_t)nv::B_OG * nv::TD), FK_DBG_STOP);
#define SAVE(i, src, bytes) (void)hipMemcpyAsync((char*)d_ws + SAVE_BASE + (size_t)(i) * nv::TD, src, bytes, hipMemcpyDeviceToDevice, stream);
        FK_DBG_SAVES
#undef SAVE
    }
#endif
    (void)hipMemsetAsync((char*)d_ws + WS_CTL, 0, CTL_ZERO_BYTES, stream);
    Args a{};
    for (int i = 0; i < 36; ++i) a.in[i] = (const float*)d_in[i];
    a.out = (float*)d_out; a.ws = (unsigned char*)d_ws;
#if defined(FK_PER_PHASE)
    for (int p = 0; p < FK_PH_HI; ++p) { a.ph_lo = p; a.ph_hi = p + 1; hipLaunchKernelGGL(fwd, dim3(grid), dim3(NTHR), LDS_BYTES, stream, a); }
#else
    a.ph_lo = 0; a.ph_hi = FK_PH_HI; hipLaunchKernelGGL(fwd, dim3(grid), dim3(NTHR), LDS_BYTES, stream, a);
#endif
#if defined(FK_DEBUG)
    {
        float* acc = (float*)((char*)d_ws + WS_CTL) + CW_DBG;
        const size_t ro = (size_t)DBG_B * T;
        int nchk = 0;
#define CHK(refp, ldr, fastoff, isbf, ldf, cols) { hipLaunchKernelGGL(k_cmp, dim3(1024), dim3(256), 0, stream, refp, ldr, (const void*)((char*)d_ws + (fastoff) + ro * (ldf) * ((isbf) ? 2 : 4)), isbf, ldf, T, cols, acc + 2 * nchk); ++nchk; }
        FK_DBG_CHECKS
#undef CHK
        hipLaunchKernelGGL(k_code, dim3(1024), dim3(256), 0, stream, acc, nchk, FK_DBG_TOL2, (float*)d_out, (size_t)out_size);
    }
#endif
}
```

```cpp
#define FK_EXPERTS 1
#define FK_PH_HI 23
#include <hip/hip_runtime.h>
#include <hip/hip_bf16.h>
#include <cstdio>
#include <cstdint>
#include <cstring>
#include <cmath>
namespace pg8 {
#define PG8_LAS __attribute__((address_space(3)))
typedef unsigned short bf16_t;
typedef short bf16x8 __attribute__((ext_vector_type(8)));
typedef float f32x4 __attribute__((ext_vector_type(4)));
typedef unsigned u32x4 __attribute__((ext_vector_type(4)));
constexpr int BM = 256, BK = 64, HALF = 128, HTB = HALF * BK * 2  , STAGE_BYTES = 8 * HTB, NXCD = 8, WGM = 8;

__host__ __device__ __forceinline__ int lds_byte(int r, int c) { const int st = (r >> 4) * 2 + (c >> 5), rr = r & 15, cc = c & 31, ob = rr * 64 + cc * 2; return st * 1024 + (ob ^ (((ob >> 9) & 1) << 5)); }
__host__ __device__ __forceinline__ void stage_rc(int b, int& R, int& C) { const int st = b / 1024, sb = b % 1024, swz = sb ^ (((sb >> 9) & 1) << 5); R = (st >> 1) * 16 + swz / 64; C = (st & 1) * 32 + (swz % 64) / 2; }
__host__ __device__ __forceinline__ int perm32(int rho) { const int n = rho >> 4, i = rho & 15; return 8 * (i >> 2) + 4 * n + (i & 3); }

struct Unit { int pm, pn; };
struct Gemm { const bf16_t* A; const bf16_t* Bt; int M, N, K; int asel_div; size_t asel_stride; };

struct StaticOrder {
    int nM, nN, nwg, G, c;
    __host__ __device__ void init(int M, int N, int G_, int c_) { nM = M / BM; nN = N / BM; nwg = nM * nN; G = G_; c = c_; }
    __host__ __device__ bool next(int i, Unit& u) const {
        const long L = (long)i * G + c; if (L >= nwg) return false;
        int wgid = (int)L; { const int q = nwg / NXCD, r = nwg % NXCD, xcd = wgid % NXCD, off = wgid / NXCD; wgid = (xcd < r ? xcd * (q + 1) : r * (q + 1) + (xcd - r) * q) + off; }
        const int nig = WGM * nN, gid = wgid / nig, fm = gid * WGM, gsz = (nM - fm) < WGM ? (nM - fm) : WGM;
        u.pm = fm + ((wgid % nig) % gsz); u.pn = (wgid % nig) / gsz; return true;
    }
    __device__ __forceinline__ void a_ready(const Unit&) const {}
    __device__ __forceinline__ void done(const Unit&) const {}
};

typedef float f32x2c_t __attribute__((ext_vector_type(2))); typedef __bf16 bf16x2c_t __attribute__((ext_vector_type(2)));
__device__ __forceinline__ unsigned cvt_pk_bf16(float lo, float hi) { f32x2c_t v = {lo, hi}; bf16x2c_t b = __builtin_convertvector(v, bf16x2c_t); return __builtin_bit_cast(unsigned, b); }
typedef float f32x2 __attribute__((ext_vector_type(2)));
__device__ __forceinline__ f32x2 gelu_pk(f32x2 v) {
    const f32x2 av = __builtin_elementwise_abs(v), d = av * 0.2316418882f + 1.0f;
    f32x2 t; t.x = __builtin_amdgcn_rcpf(d.x); t.y = __builtin_amdgcn_rcpf(d.y);
    f32x2 q = t * 0.5307027145f + (-0.7265760135f); q = q * t + 0.7107068705f; q = q * t + (-0.142248368f); q = q * t + 0.127414796f; q = q * t;
    const f32x2 s = (v * v) * (-0.72134752044f);
    f32x2 e; e.x = __builtin_amdgcn_exp2f(s.x); e.y = __builtin_amdgcn_exp2f(s.y);
    const f32x2 m = v * (q * e), r = v - m;
    f32x2 o; o.x = v.x < 0.f ? m.x : r.x; o.y = v.y < 0.f ? m.y : r.y; return o;
}

template <int ACT  > struct EpiBf16 {
    static constexpr bool PERM = true, AFTER_DRAIN = false; static_assert(ACT == 0 || ACT == 1, "EpiBf16: ACT is 0 (none) or 1 (gelu_pk)");
    bf16_t* O; int ldc; const float* bias; int split_cols; size_t split_stride; float scale0;
    __device__ __forceinline__ void operator()(const f32x4 (&acc)[2][2][4][2], const Unit& u, int wr, int wc, int fr, int fq) const {
        const int row0 = u.pm * BM + wr * 64 + fr; int colt = u.pn * BM; bf16_t* base = O;
        float sc = 1.f; if (split_cols) { const int t = colt / split_cols; base += (size_t)t * split_stride; colt -= t * split_cols; if (t == 0) sc = scale0; }
        const int col0 = colt + wc * 32 + 8 * fq, bcol0 = u.pn * BM + wc * 32 + 8 * fq;
        f32x4 bv[2][2];
#pragma unroll
        for (int bj = 0; bj < 2; ++bj)
#pragma unroll
            for (int n = 0; n < 2; ++n) bv[bj][n] = bias ? *(const f32x4*)(bias + bcol0 + bj * HALF + 4 * n) : (f32x4){0.f, 0.f, 0.f, 0.f};
#pragma unroll
        for (int ai = 0; ai < 2; ++ai)
#pragma unroll
            for (int m = 0; m < 4; ++m) { bf16_t* rowp = base + (size_t)(row0 + ai * HALF + m * 16) * ldc + col0;
#pragma unroll
                for (int bj = 0; bj < 2; ++bj) { f32x4 v0 = acc[ai][bj][m][0] + bv[bj][0], v1 = acc[ai][bj][m][1] + bv[bj][1];
                    if (ACT == 1) { f32x2 a = gelu_pk((f32x2){v0[0], v0[1]}), b = gelu_pk((f32x2){v0[2], v0[3]}), c = gelu_pk((f32x2){v1[0], v1[1]}), d = gelu_pk((f32x2){v1[2], v1[3]});
                        v0 = (f32x4){a.x, a.y, b.x, b.y}; v1 = (f32x4){c.x, c.y, d.x, d.y}; }
                    v0 = v0 * sc; v1 = v1 * sc; u32x4 w; w.x = cvt_pk_bf16(v0[0], v0[1]); w.y = cvt_pk_bf16(v0[2], v0[3]); w.z = cvt_pk_bf16(v1[0], v1[1]); w.w = cvt_pk_bf16(v1[2], v1[3]);
                    *(u32x4*)(rowp + bj * HALF) = w; } }
    }
};

struct PanelStats {
    unsigned* xbuf;
    unsigned* cnt;
    unsigned* tmo;
    int ntn; float eps;
    unsigned code;
    __device__ __forceinline__ bool run(const f32x4 (&v)[2][2][4][2], const Unit& u, int wr, int wc, int fr, int fq, PG8_LAS unsigned char* lds, int wid, int lane) const {
        typedef float f32x2v __attribute__((ext_vector_type(2)));
        PG8_LAS f32x2v* P = (PG8_LAS f32x2v*)lds;
        PG8_LAS f32x2v* S = (PG8_LAS f32x2v*)(lds + 8192);
        PG8_LAS unsigned* flag = (PG8_LAS unsigned*)(lds + 8192 + 2048);
#pragma unroll
        for (int ai = 0; ai < 2; ++ai)
#pragma unroll
            for (int m = 0; m < 4; ++m) {
                float s = 0.f;
#pragma unroll
                for (int bj = 0; bj < 2; ++bj)
#pragma unroll
                    for (int n = 0; n < 2; ++n) { const f32x4 x = v[ai][bj][m][n]; s += (x[0] + x[1]) + (x[2] + x[3]); }
                s += __shfl_xor(s, 16); s += __shfl_xor(s, 32);
                const float mw = s * (1.0f / 64.0f); float q = 0.f;
#pragma unroll
                for (int bj = 0; bj < 2; ++bj)
#pragma unroll
                    for (int n = 0; n < 2; ++n) { const f32x4 d = v[ai][bj][m][n] - mw; q += (d[0] * d[0] + d[1] * d[1]) + (d[2] * d[2] + d[3] * d[3]); }
                q += __shfl_xor(q, 16); q += __shfl_xor(q, 32);
                if (fq == 0) P[(ai * HALF + wr * 64 + m * 16 + fr) * 4 + wc] = (f32x2v){mw, q};
            }
        asm volatile("s_waitcnt lgkmcnt(0)" ::: "memory"); __builtin_amdgcn_s_barrier(); asm volatile("" ::: "memory");
#if defined(BROKEN_EXCHANGE_NO_WAIT)
#warning BROKEN CONTROL BUILD: the row-statistics exchange does not wait; results are wrong by design
        if (blockIdx.x >= 64) { const long long t0_ = clock64(); while (clock64() - t0_ < 60000) __builtin_amdgcn_s_sleep(8); }
#endif
        const int row = wid * 32 + (lane & 31);
        if (lane < 32) {
            const f32x2v a = P[row * 4 + 0], b = P[row * 4 + 1], c = P[row * 4 + 2], d = P[row * 4 + 3];
            const float mt = (a.x + b.x + c.x + d.x) * 0.25f;
            const float da = a.x - mt, db = b.x - mt, dc = c.x - mt, dd = d.x - mt;
            const float m2 = (a.y + b.y) + (c.y + d.y) + 64.0f * ((da * da + db * db) + (dc * dc + dd * dd));
            unsigned long long* slot = (unsigned long long*)xbuf + ((size_t)(u.pm * BM + row) * 4 + u.pn);
            __hip_atomic_store(slot, ((unsigned long long)__float_as_uint(m2) << 32) | __float_as_uint(mt), __ATOMIC_RELAXED, __HIP_MEMORY_SCOPE_AGENT);
        }
        asm volatile("s_waitcnt vmcnt(0)" ::: "memory");
        if (lane == 0) __hip_atomic_fetch_add(cnt + 64 * u.pm, 1u, __ATOMIC_RELAXED, __HIP_MEMORY_SCOPE_AGENT);
        if (wid == 0) {
            bool dead = false; const unsigned long long t0 = __builtin_amdgcn_s_memrealtime(); const unsigned want = 8u * (unsigned)ntn;
            for (;;) {
#if defined(BROKEN_EXCHANGE_NO_WAIT)
                break;
#endif
                if ((unsigned)__builtin_amdgcn_readfirstlane(__hip_atomic_load(cnt + 64 * u.pm, __ATOMIC_RELAXED, __HIP_MEMORY_SCOPE_AGENT)) >= want) break;
                if (__builtin_amdgcn_s_memrealtime() - t0 > 2000000ull) {
                    if (lane == 0) { unsigned expect = 0u; __hip_atomic_compare_exchange_strong(tmo + 1, &expect, code | (unsigned)(u.pm & 0xff), __ATOMIC_RELAXED, __ATOMIC_RELAXED, __HIP_MEMORY_SCOPE_AGENT);
                                     __hip_atomic_store(tmo, 1u, __ATOMIC_RELAXED, __HIP_MEMORY_SCOPE_AGENT); }
                    dead = true; break; }
                __builtin_amdgcn_s_sleep(2);
            }
            __builtin_amdgcn_fence(__ATOMIC_ACQUIRE, "agent");
            if (lane == 0) flag[0] = dead ? 1u : 0u;
        }
        asm volatile("s_waitcnt vmcnt(0) lgkmcnt(0)" ::: "memory"); __builtin_amdgcn_s_barrier(); asm volatile("" ::: "memory");
        const bool bad = flag[0] != 0u;
        if (lane < 32) {
            const unsigned long long* slot = (const unsigned long long*)xbuf + (size_t)(u.pm * BM + row) * 4; float mt[4], m2[4]; float ms = 0.f;
#pragma unroll
            for (int t = 0; t < 4; ++t) { if (t < ntn) { const unsigned long long w = __hip_atomic_load(slot + t, __ATOMIC_RELAXED, __HIP_MEMORY_SCOPE_AGENT); mt[t] = __uint_as_float((unsigned)w); m2[t] = __uint_as_float((unsigned)(w >> 32)); } else { mt[t] = 0.f; m2[t] = 0.f; } ms += mt[t]; }
            const float mean = ms / (float)ntn; float q = 0.f;
#pragma unroll
            for (int t = 0; t < 4; ++t) if (t < ntn) { const float dm = mt[t] - mean; q += m2[t] + 256.0f * dm * dm; }
            S[row] = (f32x2v){mean, 1.0f / sqrtf(q / (256.0f * (float)ntn) + eps)};
        }
        asm volatile("s_waitcnt lgkmcnt(0)" ::: "memory"); __builtin_amdgcn_s_barrier(); asm volatile("" ::: "memory");
        return bad;
    }
};
struct EpiLnRes {
    static constexpr bool PERM = false, AFTER_DRAIN = true;
    const float* base; float* out; int ldc; const float* bias; PanelStats st; unsigned poison;
    __device__ __forceinline__ void fused(f32x4 (&acc)[2][2][4][2], const Unit& u, int wr, int wc, int fr, int fq, PG8_LAS unsigned char* lds, int wid, int lane) const {
        typedef float f32x2v __attribute__((ext_vector_type(2)));
        const PG8_LAS f32x2v* S = (const PG8_LAS f32x2v*)(lds + 8192);
        const int col0 = u.pn * BM + wc * 32 + 4 * fq;
#pragma unroll
        for (int bj = 0; bj < 2; ++bj)
#pragma unroll
            for (int n = 0; n < 2; ++n) { const f32x4 bv = bias ? *(const f32x4*)(bias + col0 + bj * HALF + n * 16) : (f32x4){0.f, 0.f, 0.f, 0.f};
#pragma unroll
                for (int ai = 0; ai < 2; ++ai)
#pragma unroll
                    for (int m = 0; m < 4; ++m) acc[ai][bj][m][n] += bv; }
        f32x4 pre[4][2][2];
#pragma unroll
        for (int m = 0; m < 4; ++m) { const size_t off = (size_t)(u.pm * BM + wr * 64 + m * 16 + fr) * ldc + col0;
#pragma unroll
            for (int bj = 0; bj < 2; ++bj)
#pragma unroll
                for (int n = 0; n < 2; ++n) pre[m][bj][n] = *(const f32x4*)(base + off + bj * HALF + n * 16); }
        const bool bad = st.run(acc, u, wr, wc, fr, fq, lds, wid, lane) || poison != 0u;
        const float qnan = __builtin_nanf("");
#pragma unroll
        for (int ai = 0; ai < 2; ++ai)
#pragma unroll
            for (int m = 0; m < 4; ++m) { const int r = ai * HALF + wr * 64 + m * 16 + fr; const f32x2v sr = S[r]; const size_t off = (size_t)(u.pm * BM + r) * ldc + col0;
#pragma unroll
                for (int bj = 0; bj < 2; ++bj)
#pragma unroll
                    for (int n = 0; n < 2; ++n) { const f32x4 bs = ai == 0 ? pre[m][bj][n] : *(const f32x4*)(base + off + bj * HALF + n * 16); f32x4 o = bs + (acc[ai][bj][m][n] - sr.x) * sr.y;
                        if (bad) o = (f32x4){qnan, qnan, qnan, qnan}; *(f32x4*)(out + off + bj * HALF + n * 16) = o; }
                if (m & 1) asm volatile("" ::: "memory"); }
    }
};
struct EpiLnResLn {
    static constexpr bool PERM = false, AFTER_DRAIN = true;
    const float* base; float* out; bf16_t* xn; int ldc; const float* bias; PanelStats st1, st2; unsigned poison;
    __device__ __forceinline__ void fused(f32x4 (&acc)[2][2][4][2], const Unit& u, int wr, int wc, int fr, int fq, PG8_LAS unsigned char* lds, int wid, int lane) const {
        typedef float f32x2v __attribute__((ext_vector_type(2))); typedef unsigned u32x2v __attribute__((ext_vector_type(2)));
        const PG8_LAS f32x2v* S = (const PG8_LAS f32x2v*)(lds + 8192);
        const int col0 = u.pn * BM + wc * 32 + 4 * fq;
#pragma unroll
        for (int bj = 0; bj < 2; ++bj)
#pragma unroll
            for (int n = 0; n < 2; ++n) { const f32x4 bv = bias ? *(const f32x4*)(bias + col0 + bj * HALF + n * 16) : (f32x4){0.f, 0.f, 0.f, 0.f};
#pragma unroll
                for (int ai = 0; ai < 2; ++ai)
#pragma unroll
                    for (int m = 0; m < 4; ++m) acc[ai][bj][m][n] += bv; }
        bool bad = st1.run(acc, u, wr, wc, fr, fq, lds, wid, lane) || poison != 0u;
        const float qnan = __builtin_nanf("");
#pragma unroll
        for (int ai = 0; ai < 2; ++ai)
#pragma unroll
            for (int m = 0; m < 4; ++m) { const int r = ai * HALF + wr * 64 + m * 16 + fr; const f32x2v sr = S[r]; const size_t off = (size_t)(u.pm * BM + r) * ldc + col0;
#pragma unroll
                for (int bj = 0; bj < 2; ++bj)
#pragma unroll
                    for (int n = 0; n < 2; ++n) { const f32x4 bs = *(const f32x4*)(base + off + bj * HALF + n * 16); acc[ai][bj][m][n] = bs + (acc[ai][bj][m][n] - sr.x) * sr.y; }
                asm volatile("" : "+v"(acc[ai][0][m][0]), "+v"(acc[ai][0][m][1]), "+v"(acc[ai][1][m][0]), "+v"(acc[ai][1][m][1]));
                if (m & 1) asm volatile("" ::: "memory"); }
        const bool bad1 = bad;
        bad = st2.run(acc, u, wr, wc, fr, fq, lds, wid, lane) || bad;
#pragma unroll
        for (int ai = 0; ai < 2; ++ai)
#pragma unroll
            for (int m = 0; m < 4; ++m) { const int r = ai * HALF + wr * 64 + m * 16 + fr; const f32x2v sr = S[r]; const size_t off = (size_t)(u.pm * BM + r) * ldc + col0;
#pragma unroll
                for (int bj = 0; bj < 2; ++bj)
#pragma unroll
                    for (int n = 0; n < 2; ++n) { const f32x4 x1 = acc[ai][bj][m][n]; *(f32x4*)(out + off + bj * HALF + n * 16) = bad1 ? (f32x4){qnan, qnan, qnan, qnan} : x1;
                        const f32x4 o = (x1 - sr.x) * sr.y; u32x2v w; w.x = cvt_pk_bf16(o[0], o[1]); w.y = cvt_pk_bf16(o[2], o[3]);
                        if (bad) { w.x = 0x7fc07fc0u; w.y = 0x7fc07fc0u; } *(u32x2v*)(xn + off + bj * HALF + n * 16) = w; }
                asm volatile("" ::: "memory"); }
    }
};

template <class Epi, class Sched, bool ALIGN_EPI = false, bool SP2 = false>
__device__ __forceinline__ void gemm_phase(PG8_LAS unsigned char* lds, const Gemm g, const Sched& S, const Epi& E, const int wid_in) {
    int lane_; asm volatile("v_mbcnt_lo_u32_b32 %0, -1, 0\n\tv_mbcnt_hi_u32_b32 %0, -1, %0" : "=v"(lane_));
    const int wid = __builtin_amdgcn_readfirstlane(wid_in), lane = lane_, tid = wid * 64 + lane, wr = wid >> 2, wc = wid & 3, fr = lane & 15, fq = lane >> 4;
    const int K = g.K, nt = K / BK;
    unsigned voffA[2], voffB[2];
#pragma unroll
    for (int i = 0; i < 2; ++i) { int R, C; stage_rc(tid * 16 + i * 8192, R, C); const int Rb = Epi::PERM ? ((R & ~31) + perm32(R & 31)) : R;
        voffA[i] = (unsigned)(R * K + C) * 2u; voffB[i] = (unsigned)(Rb * K + C) * 2u; }
    const size_t kstep = (size_t)(BK * 2);
    const size_t hstep = (size_t)HALF * K * 2;
    const size_t tstep = 2 * hstep;
    const unsigned ldsw = (unsigned)wid * 1024u;
    const int aoff = lds_byte(wr * 64 + fr, fq * 8), boff = lds_byte(wc * 32 + fr, fq * 8);
#define PG8_SA(b, h) (((b) * 2 + (h)) * HTB)
#define PG8_SB(b, h) ((4 + (b) * 2 + (h)) * HTB)
#define PG8_STAGE(bufoff, gbase, voff) do { _Pragma("unroll") for (int _i = 0; _i < 2; ++_i) \
        __builtin_amdgcn_global_load_lds((const unsigned*)((const char*)(gbase) + (voff)[_i]), (PG8_LAS unsigned*)(lds + (bufoff) + ldsw + _i * 8192), 16, 0, 0); } while (0)
#define PG8_LDA(dst, b, h) do { _Pragma("unroll") for (int m = 0; m < 4; ++m) _Pragma("unroll") for (int k = 0; k < 2; ++k) dst[m][k] = *(const PG8_LAS bf16x8*)(lds + PG8_SA(b, h) + aoff + m * 2048 + k * 1024); } while (0)
#define PG8_LDB(dst, b, h) do { _Pragma("unroll") for (int n = 0; n < 2; ++n) _Pragma("unroll") for (int k = 0; k < 2; ++k) dst[n][k] = *(const PG8_LAS bf16x8*)(lds + PG8_SB(b, h) + boff + n * 2048 + k * 1024); } while (0)
#define PG8_MMA(ai, bj, At, Bt) do { __builtin_amdgcn_s_setprio(1); _Pragma("unroll") for (int m = 0; m < 4; ++m) _Pragma("unroll") for (int n = 0; n < 2; ++n) _Pragma("unroll") for (int k = 0; k < 2; ++k) \
        acc[ai][bj][m][n] = __builtin_amdgcn_mfma_f32_16x16x32_bf16(Bt[n][k], At[m][k], acc[ai][bj][m][n], 0, 0, 0); __builtin_amdgcn_s_setprio(0); } while (0)
#define PG8_WAIT_V(n) asm volatile("s_waitcnt vmcnt(" #n ")" ::: "memory")
#define PG8_WAIT_L(n) asm volatile("s_waitcnt lgkmcnt(" #n ")" ::: "memory")
#define PG8_BAR __builtin_amdgcn_s_barrier()
#define PG8_SCHED __builtin_amdgcn_sched_barrier(0)
    Unit cur, nxt; int ui = 0;
    if (!S.next(0, cur)) return;
    f32x4 acc[2][2][4][2];
#pragma unroll
    for (int a = 0; a < 2; ++a)
#pragma unroll
        for (int b = 0; b < 2; ++b)
#pragma unroll
            for (int m = 0; m < 4; ++m)
#pragma unroll
                for (int n = 0; n < 2; ++n) acc[a][b][m][n] = (f32x4){0.f, 0.f, 0.f, 0.f};
    bf16x8 At[4][2], B0[2][2], B1[2][2];
    const char* cA = (const char*)g.A + (size_t)cur.pm * tstep + (size_t)(cur.pn / g.asel_div) * g.asel_stride; const char* cB = (const char*)g.Bt + (size_t)cur.pn * tstep;
    S.a_ready(cur);
    if constexpr (SP2) {
        PG8_STAGE(PG8_SB(0, 0), cB, voffB); PG8_STAGE(PG8_SB(0, 1), cB + hstep, voffB); PG8_STAGE(PG8_SA(0, 0), cA, voffA); PG8_STAGE(PG8_SA(0, 1), cA + hstep, voffA);
        if (wr == 1) PG8_BAR;
        PG8_WAIT_V(2); PG8_BAR;
        PG8_STAGE(PG8_SB(1, 0), cB + kstep, voffB); PG8_STAGE(PG8_SA(1, 0), cA + kstep, voffA); PG8_STAGE(PG8_SB(1, 1), cB + hstep + kstep, voffB);
        PG8_WAIT_V(6); PG8_BAR;
    } else {
        PG8_STAGE(PG8_SB(0, 0), cB, voffB); PG8_STAGE(PG8_SA(0, 0), cA, voffA); PG8_STAGE(PG8_SB(0, 1), cB + hstep, voffB); PG8_STAGE(PG8_SA(0, 1), cA + hstep, voffA);
        if (wr == 1) PG8_BAR;
        PG8_WAIT_V(4); PG8_BAR;
        PG8_STAGE(PG8_SB(1, 0), cB + kstep, voffB); PG8_STAGE(PG8_SA(1, 0), cA + kstep, voffA); PG8_STAGE(PG8_SB(1, 1), cB + hstep + kstep, voffB);
        PG8_WAIT_V(6); PG8_BAR;
    }
    for (;;) {
        const bool has_next = S.next(ui + 1, nxt);
        const char* nA = has_next ? (const char*)g.A + (size_t)nxt.pm * tstep + (size_t)(nxt.pn / g.asel_div) * g.asel_stride : cA; const char* nB = has_next ? (const char*)g.Bt + (size_t)nxt.pn * tstep : cB;
#pragma unroll 1
        for (int t = 0; t < nt; t += 2) {
            const bool last = (t == nt - 2);
            const char* a1 = cA + (size_t)(t + 1) * kstep;
            const char* a2 = last ? nA : cA + (size_t)(t + 2) * kstep; const char* b2 = last ? nB : cB + (size_t)(t + 2) * kstep;
            const char* a3 = a2 + kstep; const char* b3 = b2 + kstep;
            if (last && has_next) S.a_ready(nxt);
            if constexpr (SP2) {
            PG8_LDB(B0, 0, 0); PG8_LDB(B1, 0, 1); PG8_SCHED; PG8_LDA(At, 0, 0); PG8_STAGE(PG8_SA(1, 1), a1 + hstep, voffA);
            PG8_WAIT_V(8); PG8_WAIT_L(0); PG8_BAR; PG8_MMA(0, 0, At, B0); PG8_MMA(0, 1, At, B1); PG8_BAR; PG8_SCHED;
            PG8_LDA(At, 0, 1); PG8_STAGE(PG8_SB(0, 0), b2, voffB); PG8_STAGE(PG8_SB(0, 1), b2 + hstep, voffB); PG8_STAGE(PG8_SA(0, 0), a2, voffA);
            PG8_WAIT_V(8); PG8_WAIT_L(0); PG8_BAR; PG8_MMA(1, 0, At, B0); PG8_MMA(1, 1, At, B1); PG8_BAR; PG8_SCHED;
            PG8_LDB(B0, 1, 0); PG8_LDB(B1, 1, 1); PG8_SCHED; PG8_LDA(At, 1, 0); PG8_STAGE(PG8_SA(0, 1), a2 + hstep, voffA);
            PG8_WAIT_V(8); PG8_WAIT_L(0); PG8_BAR; PG8_MMA(0, 0, At, B0); PG8_MMA(0, 1, At, B1); PG8_BAR; PG8_SCHED;
            PG8_LDA(At, 1, 1); PG8_STAGE(PG8_SB(1, 0), b3, voffB); PG8_STAGE(PG8_SB(1, 1), b3 + hstep, voffB); PG8_STAGE(PG8_SA(1, 0), a3, voffA);
            PG8_WAIT_V(8); PG8_WAIT_L(0); PG8_BAR; PG8_MMA(1, 0, At, B0); PG8_MMA(1, 1, At, B1); PG8_BAR; PG8_SCHED;
            } else {
            PG8_LDB(B0, 0, 0); PG8_SCHED; PG8_LDA(At, 0, 0); PG8_STAGE(PG8_SA(1, 1), a1 + hstep, voffA);
            PG8_WAIT_L(8); PG8_BAR; PG8_WAIT_L(0); PG8_MMA(0, 0, At, B0); PG8_BAR; PG8_SCHED;
            PG8_LDB(B1, 0, 1); PG8_STAGE(PG8_SB(0, 0), b2, voffB);
            PG8_BAR; PG8_WAIT_L(0); PG8_MMA(0, 1, At, B1); PG8_BAR;
            PG8_LDA(At, 0, 1); PG8_STAGE(PG8_SA(0, 0), a2, voffA);
            PG8_BAR; PG8_WAIT_L(0); PG8_MMA(1, 0, At, B0); PG8_BAR; PG8_SCHED;
            PG8_STAGE(PG8_SB(0, 1), b2 + hstep, voffB);
            PG8_WAIT_V(6); PG8_BAR; PG8_MMA(1, 1, At, B1); PG8_BAR;
            PG8_LDB(B0, 1, 0); PG8_SCHED; PG8_LDA(At, 1, 0); PG8_STAGE(PG8_SA(0, 1), a2 + hstep, voffA);
            PG8_WAIT_L(8); PG8_BAR; PG8_WAIT_L(0); PG8_MMA(0, 0, At, B0); PG8_BAR; PG8_SCHED;
            PG8_LDB(B1, 1, 1); PG8_STAGE(PG8_SB(1, 0), b3, voffB);
            PG8_BAR; PG8_WAIT_L(0); PG8_MMA(0, 1, At, B1); PG8_BAR;
            PG8_LDA(At, 1, 1); PG8_STAGE(PG8_SA(1, 0), a3, voffA);
            PG8_BAR; PG8_WAIT_L(0); PG8_MMA(1, 0, At, B0); PG8_BAR; PG8_SCHED;
            PG8_STAGE(PG8_SB(1, 1), b3 + hstep, voffB);
            PG8_WAIT_V(6); PG8_BAR; PG8_MMA(1, 1, At, B1); PG8_BAR;
            }
        }
        if constexpr (ALIGN_EPI) { if (wr == 0) PG8_BAR; }
        if constexpr (!Epi::AFTER_DRAIN) { E(acc, cur, wr, wc, fr, fq); S.done(cur); }
        if (!has_next) break;
#pragma unroll
        for (int a = 0; a < 2; ++a)
#pragma unroll
            for (int b = 0; b < 2; ++b)
#pragma unroll
                for (int m = 0; m < 4; ++m)
#pragma unroll
                    for (int n = 0; n < 2; ++n) acc[a][b][m][n] = (f32x4){0.f, 0.f, 0.f, 0.f};
        cur = nxt; cA = nA; cB = nB; ++ui;
        if constexpr (ALIGN_EPI) { if (wr == 1) PG8_BAR; }
    }
    PG8_WAIT_V(0);
    if constexpr (!ALIGN_EPI) { if (wr == 0) PG8_BAR; }
    PG8_BAR;
    if constexpr (Epi::AFTER_DRAIN) { E.fused(acc, cur, wr, wc, fr, fq, lds, wid, lane); S.done(cur); }
#undef PG8_SA
#undef PG8_SB
#undef PG8_STAGE
#undef PG8_LDA
#undef PG8_LDB
#undef PG8_MMA
#undef PG8_WAIT_V
#undef PG8_WAIT_L
#undef PG8_BAR
#undef PG8_SCHED
}
}
namespace pg8 {
__device__ __forceinline__ void glds_sv(const void* sbase, unsigned voff, unsigned lds_dst) { unsigned keep;
    asm volatile("s_mov_b32 %0, m0\n\ts_mov_b32 m0, %3\n\ts_nop 0\n\tglobal_load_lds_dwordx4 %1, %2\n\ts_mov_b32 m0, %0" : "=&s"(keep) : "v"(voff), "s"(sbase), "s"(lds_dst) : "memory"); }
typedef int i32x4_t __attribute__((ext_vector_type(4))); typedef int i32x8_t __attribute__((ext_vector_type(8)));
template <class Epi, class Sched, bool ALIGN_EPI = false, bool SP2 = false, bool F8 = false>
__device__ __forceinline__ void gemm_phase_g(PG8_LAS unsigned char* lds, const Gemm g, const Sched& S, const Epi& E, const int wid_in) {
    int lane_; asm volatile("v_mbcnt_lo_u32_b32 %0, -1, 0\n\tv_mbcnt_hi_u32_b32 %0, -1, %0" : "=v"(lane_));
    const int wid = __builtin_amdgcn_readfirstlane(wid_in), lane = lane_, tid = wid * 64 + lane, wr = wid >> 2, wc = wid & 3, fr = lane & 15, fq = lane >> 4;
    const int K = g.K, nt = K / BK;
    unsigned voffB[2]; int RA[2], CA[2];
#pragma unroll
    for (int i = 0; i < 2; ++i) { int R, C; stage_rc(tid * 16 + i * 8192, R, C); const int Rb = Epi::PERM ? ((R & ~31) + perm32(R & 31)) : R;
        RA[i] = R; CA[i] = C * 2; voffB[i] = (unsigned)(Rb * K + C) * 2u; }
    unsigned vAc[2][2];
    const size_t kstep = (size_t)(BK * 2);
    const size_t hstep = (size_t)HALF * K * 2;
    const size_t tstep = 2 * hstep;
    const unsigned ldsw = (unsigned)wid * 1024u;
    const int aoff = lds_byte(wr * 64 + fr, fq * 8), boff = lds_byte(wc * 32 + fr, fq * 8);
#define PG8_SA(b, h) (((b) * 2 + (h)) * HTB)
#define PG8_SB(b, h) ((4 + (b) * 2 + (h)) * HTB)
#define PG8_LDSADDR(bufoff, i_) ((unsigned)__builtin_amdgcn_readfirstlane((int)(unsigned)(unsigned long long)(lds + (bufoff) + ldsw + (i_) * 8192)))
#define PG8_STAGE(bufoff, gbase, voff) do { _Pragma("unroll") for (int _i = 0; _i < 2; ++_i) glds_sv((const void*)(gbase), (voff)[_i], PG8_LDSADDR(bufoff, _i)); } while (0)
#define PG8_STAGE_A(bufoff, va, h_, kb_) do { _Pragma("unroll") for (int _i = 0; _i < 2; ++_i) glds_sv((const void*)((const char*)g.A + (size_t)(kb_)), (va)[h_][_i], PG8_LDSADDR(bufoff, _i)); } while (0)
#define PG8_LD8(p_) __builtin_shufflevector(*(const PG8_LAS i32x4_t*)(p_), *(const PG8_LAS i32x4_t*)((p_) + 1024), 0, 1, 2, 3, 4, 5, 6, 7)
#define PG8_LDA(dst, b, h) do { _Pragma("unroll") for (int m = 0; m < 4; ++m) dst[m] = PG8_LD8(lds + PG8_SA(b, h) + aoff + m * 2048); } while (0)
#define PG8_LDB(dst, b, h) do { _Pragma("unroll") for (int n = 0; n < 2; ++n) dst[n] = PG8_LD8(lds + PG8_SB(b, h) + boff + n * 2048); } while (0)
#define PG8_HALF(f_, k_) __builtin_bit_cast(bf16x8, (k_) == 0 ? __builtin_shufflevector((f_), (f_), 0, 1, 2, 3) : __builtin_shufflevector((f_), (f_), 4, 5, 6, 7))
#define PG8_MMA(ai, bj, At, Bt) do { __builtin_amdgcn_s_setprio(1); _Pragma("unroll") for (int m = 0; m < 4; ++m) _Pragma("unroll") for (int n = 0; n < 2; ++n) { \
        if constexpr (F8) acc[ai][bj][m][n] = __builtin_amdgcn_mfma_scale_f32_16x16x128_f8f6f4(Bt[n], At[m], acc[ai][bj][m][n], 0, 0, 0, 0x7F7F7F7F, 0, 0x7F7F7F7F); \
        else { acc[ai][bj][m][n] = __builtin_amdgcn_mfma_f32_16x16x32_bf16(PG8_HALF(Bt[n], 0), PG8_HALF(At[m], 0), acc[ai][bj][m][n], 0, 0, 0); \
               acc[ai][bj][m][n] = __builtin_amdgcn_mfma_f32_16x16x32_bf16(PG8_HALF(Bt[n], 1), PG8_HALF(At[m], 1), acc[ai][bj][m][n], 0, 0, 0); } } __builtin_amdgcn_s_setprio(0); } while (0)
#define PG8_WAIT_V(n) asm volatile("s_waitcnt vmcnt(" #n ")" ::: "memory")
#define PG8_WAIT_L(n) asm volatile("s_waitcnt lgkmcnt(" #n ")" ::: "memory")
#define PG8_BAR __builtin_amdgcn_s_barrier()
#define PG8_SCHED __builtin_amdgcn_sched_barrier(0)
    typename Sched::UnitT cur, nxt; int ui = 0;
    if (!S.next(0, cur)) return;
    f32x4 acc[2][2][4][2];
#pragma unroll
    for (int a = 0; a < 2; ++a)
#pragma unroll
        for (int b = 0; b < 2; ++b)
#pragma unroll
            for (int m = 0; m < 4; ++m)
#pragma unroll
                for (int n = 0; n < 2; ++n) acc[a][b][m][n] = (f32x4){0.f, 0.f, 0.f, 0.f};
    i32x8_t At[4], B0[2], B1[2];
    const char* cB = S.bbase(cur) + (size_t)cur.pn * tstep;
    S.a_ready(cur);
#pragma unroll
    for (int h_ = 0; h_ < 2; ++h_)
#pragma unroll
        for (int i_ = 0; i_ < 2; ++i_) vAc[h_][i_] = S.a_off(cur, h_ * HALF + RA[i_]) + (unsigned)CA[i_];
    if constexpr (SP2) {
        PG8_STAGE(PG8_SB(0, 0), cB, voffB); PG8_STAGE(PG8_SB(0, 1), cB + hstep, voffB); PG8_STAGE_A(PG8_SA(0, 0), vAc, 0, 0); PG8_STAGE_A(PG8_SA(0, 1), vAc, 1, 0);
        if (wr == 1) PG8_BAR;
        PG8_WAIT_V(2); PG8_BAR;
        PG8_STAGE(PG8_SB(1, 0), cB + kstep, voffB); PG8_STAGE_A(PG8_SA(1, 0), vAc, 0, kstep); PG8_STAGE(PG8_SB(1, 1), cB + hstep + kstep, voffB);
        PG8_WAIT_V(6); PG8_BAR;
    } else {
        PG8_STAGE(PG8_SB(0, 0), cB, voffB); PG8_STAGE_A(PG8_SA(0, 0), vAc, 0, 0); PG8_STAGE(PG8_SB(0, 1), cB + hstep, voffB); PG8_STAGE_A(PG8_SA(0, 1), vAc, 1, 0);
        if (wr == 1) PG8_BAR;
        PG8_WAIT_V(4); PG8_BAR;
        PG8_STAGE(PG8_SB(1, 0), cB + kstep, voffB); PG8_STAGE_A(PG8_SA(1, 0), vAc, 0, kstep); PG8_STAGE(PG8_SB(1, 1), cB + hstep + kstep, voffB);
        PG8_WAIT_V(6); PG8_BAR;
    }
    for (;;) {
        const bool has_next = S.next(ui + 1, nxt);
        const char* nB = has_next ? S.bbase(nxt) + (size_t)nxt.pn * tstep : cB;
#pragma unroll 1
        for (int t = 0; t < nt; t += 2) {
            const bool last = (t == nt - 2);
            const size_t k1 = (size_t)(t + 1) * kstep, k2 = last ? 0 : (size_t)(t + 2) * kstep, k3 = k2 + kstep;
            unsigned vA2[2][2];
#pragma unroll
            for (int h_ = 0; h_ < 2; ++h_)
#pragma unroll
                for (int i_ = 0; i_ < 2; ++i_) vA2[h_][i_] = (last && has_next) ? S.a_off(nxt, h_ * HALF + RA[i_]) + (unsigned)CA[i_] : vAc[h_][i_];
            const char* b2 = last ? nB : cB + (size_t)(t + 2) * kstep; const char* b3 = b2 + kstep;
            if (last && has_next) S.a_ready(nxt);
            if constexpr (SP2) {
            PG8_LDB(B0, 0, 0); PG8_LDB(B1, 0, 1); PG8_SCHED; PG8_LDA(At, 0, 0); PG8_STAGE_A(PG8_SA(1, 1), vAc, 1, k1);
            PG8_WAIT_V(8); PG8_WAIT_L(0); PG8_BAR; PG8_MMA(0, 0, At, B0); PG8_MMA(0, 1, At, B1); PG8_BAR; PG8_SCHED;
            PG8_LDA(At, 0, 1); PG8_STAGE(PG8_SB(0, 0), b2, voffB); PG8_STAGE(PG8_SB(0, 1), b2 + hstep, voffB); PG8_STAGE_A(PG8_SA(0, 0), vA2, 0, k2);
            PG8_WAIT_V(8); PG8_WAIT_L(0); PG8_BAR; PG8_MMA(1, 0, At, B0); PG8_MMA(1, 1, At, B1); PG8_BAR; PG8_SCHED;
            PG8_LDB(B0, 1, 0); PG8_LDB(B1, 1, 1); PG8_SCHED; PG8_LDA(At, 1, 0); PG8_STAGE_A(PG8_SA(0, 1), vA2, 1, k2);
            PG8_WAIT_V(8); PG8_WAIT_L(0); PG8_BAR; PG8_MMA(0, 0, At, B0); PG8_MMA(0, 1, At, B1); PG8_BAR; PG8_SCHED;
            PG8_LDA(At, 1, 1); PG8_STAGE(PG8_SB(1, 0), b3, voffB); PG8_STAGE(PG8_SB(1, 1), b3 + hstep, voffB); PG8_STAGE_A(PG8_SA(1, 0), vA2, 0, k3);
            PG8_WAIT_V(8); PG8_WAIT_L(0); PG8_BAR; PG8_MMA(1, 0, At, B0); PG8_MMA(1, 1, At, B1); PG8_BAR; PG8_SCHED;
            } else {
            PG8_LDB(B0, 0, 0); PG8_SCHED; PG8_LDA(At, 0, 0); PG8_STAGE_A(PG8_SA(1, 1), vAc, 1, k1);
            PG8_WAIT_L(8); PG8_BAR; PG8_WAIT_L(0); PG8_MMA(0, 0, At, B0); PG8_BAR; PG8_SCHED;
            PG8_LDB(B1, 0, 1); PG8_STAGE(PG8_SB(0, 0), b2, voffB);
            PG8_BAR; PG8_WAIT_L(0); PG8_MMA(0, 1, At, B1); PG8_BAR;
            PG8_LDA(At, 0, 1); PG8_STAGE_A(PG8_SA(0, 0), vA2, 0, k2);
            PG8_BAR; PG8_WAIT_L(0); PG8_MMA(1, 0, At, B0); PG8_BAR; PG8_SCHED;
            PG8_STAGE(PG8_SB(0, 1), b2 + hstep, voffB);
            PG8_WAIT_V(6); PG8_BAR; PG8_MMA(1, 1, At, B1); PG8_BAR;
            PG8_LDB(B0, 1, 0); PG8_SCHED; PG8_LDA(At, 1, 0); PG8_STAGE_A(PG8_SA(0, 1), vA2, 1, k2);
            PG8_WAIT_L(8); PG8_BAR; PG8_WAIT_L(0); PG8_MMA(0, 0, At, B0); PG8_BAR; PG8_SCHED;
            PG8_LDB(B1, 1, 1); PG8_STAGE(PG8_SB(1, 0), b3, voffB);
            PG8_BAR; PG8_WAIT_L(0); PG8_MMA(0, 1, At, B1); PG8_BAR;
            PG8_LDA(At, 1, 1); PG8_STAGE_A(PG8_SA(1, 0), vA2, 0, k3);
            PG8_BAR; PG8_WAIT_L(0); PG8_MMA(1, 0, At, B0); PG8_BAR; PG8_SCHED;
            PG8_STAGE(PG8_SB(1, 1), b3 + hstep, voffB);
            PG8_WAIT_V(6); PG8_BAR; PG8_MMA(1, 1, At, B1); PG8_BAR;
            }
        }
        if constexpr (ALIGN_EPI) { if (wr == 0) PG8_BAR; }
        if constexpr (!Epi::AFTER_DRAIN) { E(acc, cur, wr, wc, fr, fq); S.done(cur); }
        if (!has_next) break;
#pragma unroll
        for (int a = 0; a < 2; ++a)
#pragma unroll
            for (int b = 0; b < 2; ++b)
#pragma unroll
                for (int m = 0; m < 4; ++m)
#pragma unroll
                    for (int n = 0; n < 2; ++n) acc[a][b][m][n] = (f32x4){0.f, 0.f, 0.f, 0.f};
        cur = nxt; cB = nB; ++ui;
#pragma unroll
        for (int h_ = 0; h_ < 2; ++h_)
#pragma unroll
            for (int i_ = 0; i_ < 2; ++i_) vAc[h_][i_] = S.a_off(cur, h_ * HALF + RA[i_]) + (unsigned)CA[i_];
        if constexpr (ALIGN_EPI) { if (wr == 1) PG8_BAR; }
    }
    PG8_WAIT_V(0);
    if constexpr (!ALIGN_EPI) { if (wr == 0) PG8_BAR; }
    PG8_BAR;
    if constexpr (Epi::AFTER_DRAIN) { E.fused(acc, cur, wr, wc, fr, fq, lds, wid, lane); S.done(cur); }
#undef PG8_SA
#undef PG8_SB
#undef PG8_STAGE
#undef PG8_STAGE_A
#undef PG8_LDSADDR
#undef PG8_LDA
#undef PG8_LDB
#undef PG8_MMA
#undef PG8_LD8
#undef PG8_HALF
#undef PG8_WAIT_V
#undef PG8_WAIT_L
#undef PG8_BAR
#undef PG8_SCHED
}
}
__device__ __forceinline__ int hw_lane() { int l; asm volatile("v_mbcnt_lo_u32_b32 %0, -1, 0\n\tv_mbcnt_hi_u32_b32 %0, -1, %0" : "=v"(l)); return l; }
#define GAS __attribute__((address_space(1)))
#define LAS __attribute__((address_space(3)))
typedef unsigned short bf16;
typedef unsigned v4u __attribute__((ext_vector_type(4)));
typedef float f32x4 __attribute__((ext_vector_type(4)));
typedef short bf16x8 __attribute__((ext_vector_type(8)));
typedef GAS unsigned gu32;
typedef GAS unsigned long long gu64;
#define RLX_AGENT __ATOMIC_RELAXED, __HIP_MEMORY_SCOPE_AGENT
#define LDS_WAIT() asm volatile("s_waitcnt lgkmcnt(0)" ::: "memory")
#define VM_WAIT() asm volatile("s_waitcnt vmcnt(0)" ::: "memory")
__device__ __forceinline__ unsigned long long rt() { return __builtin_amdgcn_s_memrealtime(); }
__device__ __forceinline__ unsigned f2bf(float f) { unsigned u = __builtin_bit_cast(unsigned, f); return (u + 0x7fffu + ((u >> 16) & 1u)) >> 16; }
__device__ __forceinline__ unsigned pk2(float lo, float hi) { return f2bf(lo) | (f2bf(hi) << 16); }

#define XB_TMO      128
#define XB_XCNT(j)  (256  + 64 * (j))
#define XB_XSUB(j)  (1280 + 64 * (j))
#define XB_XGEN(j)  (2304 + 64 * (j))
#define XB_TOP      3328
#define XB_TOPGEN   3392
#define XCD_BAR_WORDS 3456
#define XB_SPIN_CAP (1u << 18)

__device__ __forceinline__ unsigned xb_ld(unsigned* p)              { return __hip_atomic_load(p, __ATOMIC_RELAXED, __HIP_MEMORY_SCOPE_AGENT); }
__device__ __forceinline__ unsigned xb_add(unsigned* p, unsigned v) { return __hip_atomic_fetch_add(p, v, __ATOMIC_RELAXED, __HIP_MEMORY_SCOPE_AGENT); }
__device__ __forceinline__ unsigned xb_xcc_id() { return (unsigned)__builtin_amdgcn_s_getreg((3 << 11) | 20) & 0xFu; }
#define XB_SPIN(cond, bar) do { unsigned _sp = 0; while (cond) { __builtin_amdgcn_s_sleep(1); \
    if ((++_sp & 255u) == 0u) { if (xb_ld(&(bar)[XB_TMO])) break; if (_sp > XB_SPIN_CAP) { atomicAdd(&(bar)[XB_TMO], 1u); break; } } } } while (0)

struct XcdBarrier {
    unsigned* bar; unsigned x;
    volatile LAS unsigned* st;
};

__device__ __forceinline__ XcdBarrier xcd_barrier_post(unsigned* bar, volatile LAS unsigned* st) {
    XcdBarrier b; b.bar = bar; b.x = xb_xcc_id(); b.st = st;
    if (threadIdx.x == 0) (void)xb_add(&bar[XB_XCNT(b.x)], 1u);
    return b;
}
__device__ __forceinline__ void xcd_barrier_complete(unsigned* bar, unsigned x, unsigned& nloc, unsigned& nx) {
    const unsigned G = gridDim.x * gridDim.y * gridDim.z;
    unsigned sum, cnt, mine, sp = 0u;
    for (;;) {
        sum = 0u; cnt = 0u; mine = 0u;
#pragma unroll
        for (unsigned j = 0; j < 16; ++j) { const unsigned c = xb_ld(&bar[XB_XCNT(j)]); sum += c; cnt += (c > 0u) ? 1u : 0u; mine = (j == x) ? c : mine; }
        if (sum == G) break;
        __builtin_amdgcn_s_sleep(1);
        if ((++sp & 255u) == 0u) { if (xb_ld(&bar[XB_TMO])) break; if (sp > XB_SPIN_CAP) { atomicAdd(&bar[XB_TMO], 1u); break; } }
    }
    nloc = mine > 0u ? mine : 1u; nx = cnt > 0u ? cnt : 1u;
}

__device__ __forceinline__ void xcd_barrier(const XcdBarrier& b, const bool is_t0) {
    asm volatile("s_waitcnt vmcnt(0)" ::: "memory");
    __syncthreads();
    if (is_t0) {
        unsigned* bar = b.bar;
        __builtin_amdgcn_s_waitcnt(0);
        unsigned nloc = b.st[0], nx = b.st[1];
        if (nloc == 0u) { xcd_barrier_complete(bar, b.x, nloc, nx); b.st[0] = nloc; b.st[1] = nx; }
        const unsigned old = xb_add(&bar[XB_XSUB(b.x)], 1u);
        const unsigned gen = old / nloc;
        if (old + 1u == (gen + 1u) * nloc) {
            __builtin_amdgcn_fence(__ATOMIC_RELEASE, "agent");
            asm volatile("s_waitcnt vmcnt(0)" ::: "memory");
            const unsigned og = xb_add(&bar[XB_TOP], 1u);
            const unsigned tg = og / nx;
            if (og + 1u == (tg + 1u) * nx) xb_add(&bar[XB_TOPGEN], 1u);
            else XB_SPIN(xb_ld(&bar[XB_TOPGEN]) == tg, bar);
            __builtin_amdgcn_fence(__ATOMIC_ACQUIRE, "agent");
            xb_add(&bar[XB_XGEN(b.x)], 1u);
            asm volatile("s_waitcnt vmcnt(0)" ::: "memory");
        } else {
            XB_SPIN(xb_ld(&bar[XB_XGEN(b.x)]) == gen, bar);
            __builtin_amdgcn_fence(__ATOMIC_ACQUIRE, "agent");
            asm volatile("s_waitcnt vmcnt(0)" ::: "memory");
        }
    }
    __syncthreads();
}

namespace fk {
using pg8::bf16_t; using pg8::f32x4; using pg8::u32x4; using pg8::Unit; using pg8::BM; using pg8::HALF;
constexpr int NWAVES = 8, NTHR = 512;
constexpr int NB = 4, T = 8192, D = 1024, H = 16, HD = 64, M = NB * T, NE = 256, FX = 256;
constexpr float ALPHA = 1.4142135623730951f, LN_EPS = 1e-5f;
constexpr size_t MiB = 1u << 20;
constexpr size_t WS_CTL = 0, CTL_ZERO_BYTES = 1 * MiB;
constexpr size_t WS_MOD = 1 * MiB;
constexpr size_t WS_WRKV = 2 * MiB, WS_B1T = 8 * MiB, WS_B2T = 9 * MiB, WS_WO0 = 11 * MiB, WS_RT0 = 13 * MiB, WS_SGU0 = 15 * MiB, WS_SD0 = 16 * MiB,
                 WS_KVT = 17 * MiB, WS_QGT = 21 * MiB, WS_WO1 = 25 * MiB, WS_RT1 = 27 * MiB, WS_SGU1 = 29 * MiB, WS_SD1 = 30 * MiB;
constexpr size_t WS_EGU = 32 * MiB, EGU_L = 256 * MiB, WS_ED = 544 * MiB, ED_L = 128 * MiB;
constexpr size_t WS_XR = 800 * MiB, WS_XK = 864 * MiB, WS_XV = 928 * MiB, WS_HX = 992 * MiB;
constexpr size_t WS_R = 1120 * MiB, WS_K = 1184 * MiB, WS_V = 1248 * MiB, WS_L1 = 1312 * MiB, WS_LW = 1328 * MiB, WS_A = 1456 * MiB, WS_G = 1520 * MiB, WS_BONUS = 1584 * MiB;
constexpr size_t WS_PT = 800 * MiB, WS_RTL = 864 * MiB, WS_Q = 928 * MiB, WS_YL = 992 * MiB, WS_Y = 1056 * MiB, WS_Z = 1120 * MiB, WS_PRE = 1328 * MiB;
constexpr size_t WS_X1 = 1600 * MiB, WS_H2 = 1728 * MiB, WS_LOGITS = 1792 * MiB, WS_IDX = 1824 * MiB, WS_GW = 1825 * MiB, WS_LIST = 1826 * MiB, WS_HB = 1858 * MiB;
constexpr size_t WS_ACT = 800 * MiB, WS_ACTS = 928 * MiB, WS_OUTROW = 944 * MiB, WS_YS = 1456 * MiB, WS_XB = 1520 * MiB;
constexpr size_t WS_KN = 800 * MiB, WS_VV = 864 * MiB, WS_QN = 928 * MiB, WS_GATE = 992 * MiB, WS_LOGF = 1586 * MiB, WS_FLOC = 1588 * MiB, WS_FTOT = 1590 * MiB, WS_O = 1064 * MiB;
constexpr size_t WS_FAST_END = 1954 * MiB, WS_H2F8 = 1922 * MiB;
constexpr float F8_SA = 16.f, F8_SB = 256.f, F8_SO = 64.f;
constexpr int CW_TMO = 0, CW_CODE = 1, CW_BAR = 4096, CW_CNT = 16384  , CW_DBG = 32768, CW_TS = 40960;
constexpr int RING_BYTES = 131072, LDSCTL_OFF = RING_BYTES, MISC_OFF = LDSCTL_OFF + 320, LDS_BYTES = 147456;

typedef GAS float gf32;
struct Args { const float* in[36]; float* out; unsigned char* ws; int ph_lo, ph_hi; };

#define FK_DPP(x, ctrl) __builtin_bit_cast(float, __builtin_amdgcn_update_dpp(0, __builtin_bit_cast(int, (x)), (ctrl), 0xF, 0xF, true))
__device__ __forceinline__ float row16_sum(float v) { v += FK_DPP(v, 0xB1); v += FK_DPP(v, 0x4E); v += FK_DPP(v, 0x141); v += FK_DPP(v, 0x140); return v; }
__device__ __forceinline__ float row16_max(float v) { v = fmaxf(v, FK_DPP(v, 0xB1)); v = fmaxf(v, FK_DPP(v, 0x4E)); v = fmaxf(v, FK_DPP(v, 0x141)); v = fmaxf(v, FK_DPP(v, 0x140)); return v; }
__device__ __forceinline__ float swap16_sum(float v) { const auto r = __builtin_amdgcn_permlane16_swap(__float_as_uint(v), __float_as_uint(v), false, false); return __uint_as_float(r[0]) + __uint_as_float(r[1]); }
__device__ __forceinline__ float swap32_sum(float v) { const auto r = __builtin_amdgcn_permlane32_swap(__float_as_uint(v), __float_as_uint(v), false, false); return __uint_as_float(r[0]) + __uint_as_float(r[1]); }
__device__ __forceinline__ float swap16_max(float v) { const auto r = __builtin_amdgcn_permlane16_swap(__float_as_uint(v), __float_as_uint(v), false, false); return fmaxf(__uint_as_float(r[0]), __uint_as_float(r[1])); }
__device__ __forceinline__ float swap32_max(float v) { const auto r = __builtin_amdgcn_permlane32_swap(__float_as_uint(v), __float_as_uint(v), false, false); return fmaxf(__uint_as_float(r[0]), __uint_as_float(r[1])); }
__device__ __forceinline__ float wave_sum(float v) { return swap32_sum(swap16_sum(row16_sum(v))); }
__device__ __forceinline__ float wave_max(float v) { return swap32_max(swap16_max(row16_max(v))); }
__device__ __forceinline__ float sigm(float x) { return __builtin_amdgcn_rcpf(1.f + __expf(-x)); }
__device__ __forceinline__ float siluf(float x) { return x * sigm(x); }
__device__ __forceinline__ float softplus_(float x) { return fmaxf(x, 0.f) + __logf(1.f + __expf(-fabsf(x))); }
__device__ __forceinline__ float tanh_(float x) { const float e = __expf(2.f * x); return 1.f - 2.f * __builtin_amdgcn_rcpf(e + 1.f); }

template <class Tp> __device__ __forceinline__ Tp* uni(Tp* p) { const unsigned long long v = (unsigned long long)p; const unsigned lo = __builtin_amdgcn_readfirstlane((unsigned)v), hi = __builtin_amdgcn_readfirstlane((unsigned)(v >> 32)); return (Tp*)(((unsigned long long)hi << 32) | lo); }
struct Frame {
    LAS unsigned char* lds; volatile LAS unsigned* MISC; gu32* ctl;
    int tid, lane, wave, vcu, G;
    const float* const* in; float* out; unsigned char* ws;
};

__device__ __forceinline__ int d16_row(int c) { const int c8 = c & 255; return (c & ~255) + 128 * ((c8 >> 3) & 1) + 32 * (c8 >> 6) + 8 * ((c8 >> 4) & 3) + (c8 & 7); }
__device__ __forceinline__ unsigned pk4_fp8(float a, float b, float c, float d) { int p = __builtin_amdgcn_cvt_pk_fp8_f32(a, b, 0, false); p = __builtin_amdgcn_cvt_pk_fp8_f32(c, d, p, true); return (unsigned)p; }
__device__ __forceinline__ void tr_item(const float* W, int ldn, int k0, int n0, bf16_t* WT, int ldk, int drow0, int dk0, const float* kscale, LAS float* scr, int lane, float f8scale = 0.f, bool d16 = false) {
#pragma unroll
    for (int i = 0; i < 32; ++i) { const int kk = 2 * i + (lane >> 5); float v = W[(size_t)(k0 + kk) * ldn + n0 + (lane & 31)]; if (kscale) v *= kscale[k0 + kk]; scr[kk * 33 + (lane & 31)] = v; }
    LDS_WAIT(); asm volatile("" ::: "memory");
    const int c = lane & 7;
#pragma unroll
    for (int j = 0; j < 4; ++j) { const int nl = (lane >> 3) + 8 * j; const LAS float* s = scr + (8 * c) * 33 + nl; const int n = d16 ? (d16_row(n0 + nl) - drow0) : nl;
        v4u o; o.x = pk2(s[0 * 33], s[1 * 33]); o.y = pk2(s[2 * 33], s[3 * 33]); o.z = pk2(s[4 * 33], s[5 * 33]); o.w = pk2(s[6 * 33], s[7 * 33]);
        if (f8scale != 0.f) { typedef unsigned u32x2t __attribute__((ext_vector_type(2)));
            const u32x2t o8 = {pk4_fp8(s[0 * 33] * f8scale, s[1 * 33] * f8scale, s[2 * 33] * f8scale, s[3 * 33] * f8scale), pk4_fp8(s[4 * 33] * f8scale, s[5 * 33] * f8scale, s[6 * 33] * f8scale, s[7 * 33] * f8scale)};
            *(GAS u32x2t*)((unsigned char*)WT + (size_t)(drow0 + n) * ldk + dk0 + k0 + 8 * c) = o8; }
        else *(GAS v4u*)(WT + (size_t)(drow0 + n) * ldk + dk0 + k0 + 8 * c) = o; }
    LDS_WAIT(); asm volatile("" ::: "memory");
}
enum RowMap { RM_PLAIN = 0, RM_HEAD = 1, RM_GU_GATE = 2, RM_GU_UP = 3, RM_D16 = 4 };
__device__ __forceinline__ int map_row(int mode, int n0) {
    if (mode == RM_HEAD) { const int pn = n0 >> 8, r = n0 & 255, wc = r >> 6, bj = (r >> 5) & 1; return (pn << 8) + bj * 128 + wc * 32; }
    if (mode == RM_GU_GATE) return ((n0 >> 7) << 8) + (n0 & 127);
    if (mode == RM_GU_UP) return ((n0 >> 7) << 8) + 128 + (n0 & 127);
    if (mode == RM_D16) return 0;
    return n0;
}
struct TrJob { const float* W; int ldn, K, N, ncol0; bf16_t* WT; int ldk, drow_off, dk0, mode; const float* kscale; float f8scale; };
__device__ __forceinline__ void tr_job_item(const TrJob& j, int item, LAS float* scr, int lane) {
    const int nblk = j.N / 32, kb = item / nblk, nb = item % nblk;
    tr_item(j.W, j.ldn, 64 * kb, j.ncol0 + 32 * nb, j.WT, j.ldk, j.drow_off + map_row(j.mode, 32 * nb), j.dk0, j.kscale, scr, lane, j.f8scale, j.mode == RM_D16);
}

__device__ __forceinline__ void p0_prologue(Frame& F, bool do_experts) {
    const int gw = F.vcu * NWAVES + F.wave, NGW = F.G * NWAVES;
    unsigned char* ws = F.ws;
    {
        LAS float* sc = (LAS float*)(F.lds);
        LAS float* red = (LAS float*)(F.lds + 16384);
        for (int i = F.tid; i < NB * D; i += NTHR) sc[i] = siluf(F.in[1][i]);
        __syncthreads();
        for (int task = blockIdx.x; task < 2 * 96; task += F.G) {
            const int l = task / 96, n0 = (task % 96) * 64;
            const float* W = F.in[2] + ((size_t)l * D + F.wave * 128) * (6 * D) + n0 + F.lane;
            float a0 = 0.f, a1 = 0.f, a2 = 0.f, a3 = 0.f;
#pragma unroll 16
            for (int k = 0; k < 128; ++k) { const float w = W[(size_t)k * (6 * D)]; const int kk = F.wave * 128 + k; a0 += sc[kk] * w; a1 += sc[D + kk] * w; a2 += sc[2 * D + kk] * w; a3 += sc[3 * D + kk] * w; }
            red[(F.wave * 4 + 0) * 64 + F.lane] = a0; red[(F.wave * 4 + 1) * 64 + F.lane] = a1; red[(F.wave * 4 + 2) * 64 + F.lane] = a2; red[(F.wave * 4 + 3) * 64 + F.lane] = a3;
            __syncthreads();
            if (F.tid < 256) { const int b = F.tid >> 6, ln = F.tid & 63; float s = F.in[3][l * 6 * D + n0 + ln];
#pragma unroll
                for (int w = 0; w < 8; ++w) s += red[(w * 4 + b) * 64 + ln];
                ((float*)(ws + WS_MOD))[(size_t)(l * NB + b) * 6 * D + n0 + ln] = s; }
            __syncthreads();
        }
        __syncthreads();
    }
    {
        bf16_t* B2 = (bf16_t*)(ws + WS_B2T);
        const int gt = F.vcu * NTHR + F.tid, NGT = F.G * NTHR;
        for (int idx = gt; idx < 3072 * 256; idx += NGT) { const int n = idx >> 8, k = idx & 255, seg = n >> 10, nn = n & 1023; float v = 0.f;
            if (seg == 0 && k < 64) v = F.in[11][(size_t)k * D + nn]; else if (seg == 1 && k >= 64 && k < 128) v = F.in[14][(size_t)(k - 64) * D + nn]; else if (seg == 2 && k >= 128) v = F.in[16][(size_t)(k - 128) * D + nn];
            B2[idx] = (bf16_t)f2bf(v); }
    }
    LAS float* scr = (LAS float*)(F.lds + F.wave * 16384);
    constexpr int NJ = 30;
    int cum = 0;
#define TRJ(W_, ldn_, K_, N_, ncol0_, WT_, ldk_, drow_, dk0_, mode_, ks_) { const TrJob j{W_, ldn_, K_, N_, ncol0_, (bf16_t*)(ws + (WT_)), ldk_, drow_, dk0_, mode_, ks_, F8S}; const int ni = (K_ / 64) * (N_ / 32); \
        for (int it = gw; it < ni; it += NGW) tr_job_item(j, it, scr, F.lane); }
#define F8S 0.f
    TRJ(F.in[7], D, D, D, 0, WS_WRKV, D, 0, 0, RM_PLAIN, nullptr)
    TRJ(F.in[7] + (size_t)D * D, D, D, D, 0, WS_WRKV, D, 1024, 0, RM_PLAIN, nullptr)
    TRJ(F.in[7] + 2 * (size_t)D * D, D, D, D, 0, WS_WRKV, D, 2048, 0, RM_PLAIN, nullptr)
    TRJ(F.in[10], 64, D, 64, 0, WS_B1T, 2048, 0, 0, RM_PLAIN, nullptr)
    TRJ(F.in[10], 64, D, 64, 0, WS_B1T, 2048, 0, 1024, RM_PLAIN, F.in[6] + 1 * D)
    TRJ(F.in[13], 64, D, 64, 0, WS_B1T, 2048, 64, 0, RM_PLAIN, nullptr)
    TRJ(F.in[13], 64, D, 64, 0, WS_B1T, 2048, 64, 1024, RM_PLAIN, F.in[6] + 4 * D)
    TRJ(F.in[15], 128, D, 128, 0, WS_B1T, 2048, 128, 0, RM_PLAIN, nullptr)
    TRJ(F.in[15], 128, D, 128, 0, WS_B1T, 2048, 128, 1024, RM_PLAIN, F.in[6] + 5 * D)
    TRJ(F.in[8], D, D, D, 0, WS_WO0, D, 0, 0, RM_PLAIN, nullptr)
    TRJ(F.in[27], D, D, D, 0, WS_WO1, D, 0, 0, RM_PLAIN, nullptr)
    TRJ(F.in[28], NE, D, NE, 0, WS_RT0, D, 0, 0, RM_PLAIN, nullptr)
    TRJ(F.in[28] + (size_t)D * NE, NE, D, NE, 0, WS_RT1, D, 0, 0, RM_PLAIN, nullptr)
#undef F8S
#define F8S F8_SB
    TRJ(F.in[33], FX, D, FX, 0, WS_SGU0, D, 0, 0, RM_GU_GATE, nullptr)
    TRJ(F.in[34], FX, D, FX, 0, WS_SGU0, D, 0, 0, RM_GU_UP, nullptr)
    TRJ(F.in[33] + (size_t)D * FX, FX, D, FX, 0, WS_SGU1, D, 0, 0, RM_GU_GATE, nullptr)
    TRJ(F.in[34] + (size_t)D * FX, FX, D, FX, 0, WS_SGU1, D, 0, 0, RM_GU_UP, nullptr)
#undef F8S
#define F8S 0.f
    TRJ(F.in[35], D, FX, D, 0, WS_SD0, FX, 0, 0, RM_D16, nullptr)
    TRJ(F.in[35] + (size_t)FX * D, D, FX, D, 0, WS_SD1, FX, 0, 0, RM_D16, nullptr)
    TRJ(F.in[22], 2 * D + H, D, D, 0, WS_KVT, D, 0, 0, RM_HEAD, nullptr)
    TRJ(F.in[22], 2 * D + H, D, D, D, WS_KVT, D, 1024, 0, RM_PLAIN, nullptr)
    TRJ(F.in[25], 2 * D, D, D, 0, WS_QGT, D, 0, 0, RM_HEAD, nullptr)
    TRJ(F.in[25], 2 * D, D, D, D, WS_QGT, D, 1024, 0, RM_PLAIN, nullptr)
    (void)cum; (void)NJ;
    if (do_experts) {
        const int NIT = 2 * NE * 384;
        for (int it = gw; it < NIT; it += NGW) {
            const int le = it / 384, r = it % 384, l = le >> 8, e = le & 255;
            if (r < 256) { const bool up = r >= 128; const float* W = F.in[up ? 31 : 30] + ((size_t)l * NE + e) * D * FX;
                const TrJob j{W, FX, D, FX, 0, (bf16_t*)(ws + WS_EGU + (size_t)l * EGU_L + (size_t)e * 512 * 1024), D, 0, 0, up ? RM_GU_UP : RM_GU_GATE, nullptr, F8_SB}; tr_job_item(j, r & 127, scr, F.lane); }
            else { const float* W = F.in[32] + ((size_t)l * NE + e) * FX * D;
                const TrJob j{W, D, FX, D, 0, (bf16_t*)(ws + WS_ED + (size_t)l * ED_L) + (size_t)e * 1024 * 256, FX, 0, 0, RM_D16, nullptr, 0.f}; tr_job_item(j, r - 256, scr, F.lane); }
        }
    }
#undef TRJ
#undef F8S
}

__device__ __forceinline__ void p1_mix(Frame& F) {
    const int gw = F.vcu * NWAVES + F.wave;
    const float* x = F.in[0]; const float* mu = F.in[6];
    bf16_t* XR = (bf16_t*)(F.ws + WS_XR); bf16_t* XK = (bf16_t*)(F.ws + WS_XK); bf16_t* XV = (bf16_t*)(F.ws + WS_XV); bf16_t* HX = (bf16_t*)(F.ws + WS_HX);
    for (int chunk = gw; chunk < M / 16; chunk += F.G * NWAVES) {
        const int row0 = chunk * 16, b = row0 / T, t0 = row0 % T;
        const float* mod = (const float*)(F.ws + WS_MOD) + (size_t)(0 * NB + b) * 6 * D;
        f32x4 sh[4], sc[4], mr[4], mk[4], mv[4], hp[4];
#pragma unroll
        for (int j = 0; j < 4; ++j) { const int c = 4 * F.lane + 256 * j; sh[j] = *(const f32x4*)(mod + c); sc[j] = *(const f32x4*)(mod + D + c) + 1.f;
            mr[j] = *(const f32x4*)(mu + 0 * D + c); mk[j] = *(const f32x4*)(mu + 2 * D + c); mv[j] = *(const f32x4*)(mu + 3 * D + c); }
#pragma unroll
        for (int j = 0; j < 4; ++j) { if (t0 == 0) hp[j] = (f32x4){0.f, 0.f, 0.f, 0.f}; else { const f32x4 xp = *(const f32x4*)(x + (size_t)(row0 - 1) * D + 4 * F.lane + 256 * j); hp[j] = xp * sc[j] + sh[j]; } }
        for (int r = 0; r < 16; ++r) { const size_t row = row0 + r;
#pragma unroll
            for (int j = 0; j < 4; ++j) { const int c = 4 * F.lane + 256 * j; const f32x4 xv = *(const f32x4*)(x + row * D + c); const f32x4 h = xv * sc[j] + sh[j]; const f32x4 xx = hp[j] - h; hp[j] = h;
                const f32x4 a = h + xx * mr[j], bq = h + xx * mk[j], cq = h + xx * mv[j];
                typedef unsigned u32x2 __attribute__((ext_vector_type(2)));
                *(u32x2*)(XR + row * D + c) = (u32x2){pk2(a[0], a[1]), pk2(a[2], a[3])};
                *(u32x2*)(XK + row * D + c) = (u32x2){pk2(bq[0], bq[1]), pk2(bq[2], bq[3])};
                *(u32x2*)(XV + row * D + c) = (u32x2){pk2(cq[0], cq[1]), pk2(cq[2], cq[3])};
                *(u32x2*)(HX + row * 2 * D + c) = (u32x2){pk2(h[0], h[1]), pk2(h[2], h[3])};
                *(u32x2*)(HX + row * 2 * D + D + c) = (u32x2){pk2(xx[0], xx[1]), pk2(xx[2], xx[3])}; }
        }
    }
}

struct EpiL1 {
    static constexpr bool PERM = true, AFTER_DRAIN = false;
    bf16_t* O;
    __device__ __forceinline__ void operator()(const f32x4 (&acc)[2][2][4][2], const Unit& u, int wr, int wc, int fr, int fq) const {
        const int row0 = u.pm * BM + wr * 64 + fr, col0 = wc * 32 + 8 * fq;
#pragma unroll
        for (int ai = 0; ai < 2; ++ai)
#pragma unroll
            for (int m = 0; m < 4; ++m) { bf16_t* rowp = O + (size_t)(row0 + ai * HALF + m * 16) * 256 + col0;
#pragma unroll
                for (int bj = 0; bj < 2; ++bj) { f32x4 v0 = acc[ai][bj][m][0], v1 = acc[ai][bj][m][1];
                    if (bj == 1) { for (int i = 0; i < 4; ++i) { v0[i] = sigm(v0[i]); v1[i] = sigm(v1[i]); } }
                    else if (wc < 2) { for (int i = 0; i < 4; ++i) { v0[i] = tanh_(v0[i]); v1[i] = tanh_(v1[i]); } }
                    u32x4 w; w.x = pg8::cvt_pk_bf16(v0[0], v0[1]); w.y = pg8::cvt_pk_bf16(v0[2], v0[3]); w.z = pg8::cvt_pk_bf16(v1[0], v1[1]); w.w = pg8::cvt_pk_bf16(v1[2], v1[3]);
                    *(u32x4*)(rowp + bj * HALF) = w; } }
    }
};
struct EpiL2 {
    static constexpr bool PERM = false, AFTER_DRAIN = false;
    float* LW; bf16_t* A_; bf16_t* G_; const float* w0; const float* a0; float* RAW;
    __device__ __forceinline__ void operator()(const f32x4 (&acc)[2][2][4][2], const Unit& u, int wr, int wc, int fr, int fq) const {
        typedef unsigned u32x2 __attribute__((ext_vector_type(2)));
        const int seg = u.pn >> 2, row0 = u.pm * BM + wr * 64 + fr, colt = (u.pn & 3) * BM + wc * 32 + 4 * fq;
#pragma unroll
        for (int bj = 0; bj < 2; ++bj)
#pragma unroll
            for (int n = 0; n < 2; ++n) { const int col = colt + bj * HALF + n * 16;
                f32x4 bv = (f32x4){0.f, 0.f, 0.f, 0.f}; if (seg == 0) bv = *(const f32x4*)(w0 + col); else if (seg == 1) bv = *(const f32x4*)(a0 + col);
#pragma unroll
                for (int ai = 0; ai < 2; ++ai)
#pragma unroll
                    for (int m = 0; m < 4; ++m) { const size_t off = (size_t)(row0 + ai * HALF + m * 16) * D + col; f32x4 v = acc[ai][bj][m][n] + bv;
#ifdef FK_DBG_RAW
                        *(f32x4*)(RAW + (size_t)(row0 + ai * HALF + m * 16) * 3072 + seg * 1024 + col) = acc[ai][bj][m][n];
#endif
                        if (seg == 0) { f32x4 o; for (int i = 0; i < 4; ++i) o[i] = -__expf(-softplus_(-v[i]) - 0.5f); *(f32x4*)(LW + off) = o; }
                        else if (seg == 1) { *(u32x2*)(A_ + off) = (u32x2){pg8::cvt_pk_bf16(sigm(v[0]), sigm(v[1])), pg8::cvt_pk_bf16(sigm(v[2]), sigm(v[3]))}; }
                        else { *(u32x2*)(G_ + off) = (u32x2){pg8::cvt_pk_bf16(v[0], v[1]), pg8::cvt_pk_bf16(v[2], v[3])}; } }
                asm volatile("" ::: "memory"); }
    }
};
}
namespace fk {
typedef short s16x4 __attribute__((ext_vector_type(4)));
typedef float f32x16 __attribute__((ext_vector_type(16)));
typedef unsigned u32x2 __attribute__((ext_vector_type(2)));
constexpr int TP = 144;
constexpr int TSZ = 64 * TP;
constexpr int L_A = 0 * TSZ, L_At = 1 * TSZ, L_B = 2 * TSZ, L_Bpt = 3 * TSZ, L_K = 4 * TSZ, L_Kpt = 5 * TSZ, L_R = 6 * TSZ, L_Vt = 7 * TSZ, L_L = 8 * TSZ, L_Mak = 9 * TSZ,
              L_Mrb = 10 * TSZ, L_Mrk = 11 * TSZ, L_W1t = 12 * TSZ, L_Di = 13 * TSZ, L_Att = L_A, L_Vtt = L_Mak;
constexpr int L_CTOT = 132096, L_WC = L_CTOT + 2048;
static_assert(14 * TSZ <= 131072 && L_WC + 256 <= LDS_BYTES, "P5 LDS map");

__device__ __forceinline__ float bf2f(unsigned short h) { return __uint_as_float((unsigned)h << 16); }
__device__ __forceinline__ int crow(int r, int hi) { return (r & 3) + 8 * (r >> 2) + 4 * hi; }
__device__ __forceinline__ int fr_off(int row, int k0) { const int rb = row >> 4, l15 = row & 15, s = k0 >> 5, kk = k0 & 31, half = kk >> 4, q = (kk & 15) >> 2; return (((rb * 2 + s) * 64 + q * 16 + l15) * 16) + half * 8; }

__device__ __forceinline__ void prod_half(f32x16 (&acc)[2], const LAS unsigned char* U, const LAS unsigned char* W, int ph, int l31, int hi) {
#pragma unroll
    for (int ks = 0; ks < 4; ++ks) {
        const bf16x8 uf = *(const LAS bf16x8*)(U + (32 * ph + l31) * TP + ks * 32 + hi * 16);
#pragma unroll
        for (int xb = 0; xb < 2; ++xb) { const bf16x8 wf = *(const LAS bf16x8*)(W + (32 * xb + l31) * TP + ks * 32 + hi * 16);
            acc[xb] = __builtin_amdgcn_mfma_f32_32x32x16_bf16(wf, uf, acc[xb], 0, 0, 0); }
    }
}
template <int MASK> __device__ __forceinline__ void st_half_lds(const f32x16 (&acc)[2], LAS unsigned char* Z, int ph, int l31, int hi) {
    const int p = 32 * ph + l31;
#pragma unroll
    for (int xb = 0; xb < 2; ++xb)
#pragma unroll
        for (int g = 0; g < 4; ++g) { const int q0 = 32 * xb + 8 * g + 4 * hi; float v[4];
#pragma unroll
            for (int x = 0; x < 4; ++x) { v[x] = acc[xb][4 * g + x]; if (MASK == 1 && !(q0 + x < p)) v[x] = 0.f; if (MASK == 2 && !(q0 + x <= p)) v[x] = 0.f; }
            *(LAS u32x2*)(Z + p * TP + q0 * 2) = (u32x2){pg8::cvt_pk_bf16(v[0], v[1]), pg8::cvt_pk_bf16(v[2], v[3])}; }
}

#define P5_LBAR() asm volatile("s_waitcnt lgkmcnt(0)\n\ts_barrier" ::: "memory")
__device__ __forceinline__ void p5_unit(Frame& F, int unit, const unsigned short (&rr)[8], const unsigned short (&kr)[8], const unsigned short (&vr)[8], const unsigned short (&ar)[8], const float (&lw)[8]) {
    const int c = unit & 127, bh = unit >> 7, h = bh & 15, b = bh >> 4;
    const size_t row0 = (size_t)b * T + c * 64; const int col0 = h * 64;
    const int lane = F.lane, w = F.wave, l31 = lane & 31, hi = lane >> 5;
    LAS unsigned char* lds = F.lds;
    unsigned char* ws = F.ws;
    {
        const int d = lane;
        const float kkv = F.in[17][col0 + d], kav = F.in[18][col0 + d], rkv = F.in[19][col0 + d];
        float cl[8]; float run = 0.f;
#pragma unroll
        for (int i = 0; i < 8; ++i) { run += lw[i]; cl[i] = run; }
        LAS float* ctot = (LAS float*)(lds + L_CTOT);
        ctot[w * 64 + d] = run;
        P5_LBAR();
        float base = 0.f, total = 0.f;
#pragma unroll
        for (int q = 0; q < 8; ++q) { const float x = ctot[q * 64 + d]; total += x; if (q < w) base += x; }
        unsigned short at8[8], bp8[8], kp8[8]; const float etot = __expf(total); float erp = __expf(base);
#define CV1(x_) ((unsigned short)(pg8::cvt_pk_bf16((x_), 0.f) & 0xffffu))
#pragma unroll
        for (int i = 0; i < 8; ++i) { const int t = 8 * w + i;
            const float k = bf2f(kr[i]), a = bf2f(ar[i]), r = bf2f(rr[i]);
            float kkn = k * kkv; const float ss = wave_sum(kkn * kkn); kkn *= rsqrtf(fmaxf(ss, 1e-24f));
            const float kp = k * (1.f + (a - 1.f) * kav), bv = kkn * a, av = -kkn;
            const float bon = wave_sum(r * kp * rkv); if (lane == 0) ((float*)(ws + WS_BONUS))[(row0 + t) * 16 + h] = bon;
            const float cum = base + cl[i];
            const float ea = erp, eb = __expf(-cum), ec = etot * eb, er = __expf(cum); erp = er;
            const unsigned short Ah = CV1(av * ea), Bh = CV1(bv * eb), Kh = CV1(kp * eb), Rh = CV1(r * er);
            *(LAS unsigned short*)(lds + L_A + t * TP + d * 2) = Ah; *(LAS unsigned short*)(lds + L_B + t * TP + d * 2) = Bh;
            *(LAS unsigned short*)(lds + L_K + t * TP + d * 2) = Kh; *(LAS unsigned short*)(lds + L_R + t * TP + d * 2) = Rh;
            at8[i] = Ah; bp8[i] = CV1(bv * ec); kp8[i] = CV1(kp * ec); }
#undef CV1
#define PK8(a_) (v4u){(unsigned)a_[0] | ((unsigned)a_[1] << 16), (unsigned)a_[2] | ((unsigned)a_[3] << 16), (unsigned)a_[4] | ((unsigned)a_[5] << 16), (unsigned)a_[6] | ((unsigned)a_[7] << 16)}
        *(LAS v4u*)(lds + L_At + d * TP + 16 * w) = PK8(at8); *(LAS v4u*)(lds + L_Bpt + d * TP + 16 * w) = PK8(bp8);
        *(LAS v4u*)(lds + L_Kpt + d * TP + 16 * w) = PK8(kp8); *(LAS v4u*)(lds + L_Vt + d * TP + 16 * w) = PK8(vr);
#undef PK8
        if (w == 0) ((LAS float*)(lds + L_WC))[d] = etot;
        P5_LBAR();
    }
    {
        const int pid = w >> 1, ph = w & 1;
        f32x16 acc[2]; acc[0] = f32x16{}; acc[1] = f32x16{};
        prod_half(acc, lds + ((pid < 2) ? L_A : L_R), lds + ((pid & 1) ? L_K : L_B), ph, l31, hi);
        if (pid == 0) st_half_lds<1>(acc, lds + L_L, ph, l31, hi); else if (pid == 1) st_half_lds<1>(acc, lds + L_Mak, ph, l31, hi);
        else if (pid == 2) st_half_lds<2>(acc, lds + L_Mrb, ph, l31, hi); else st_half_lds<2>(acc, lds + L_Mrk, ph, l31, hi);
        P5_LBAR();
    }
    {
        if (w == 0) {
            const int blk = lane >> 4, j = lane & 15; float tc[16]; v4u la[16], lb[16];
#pragma unroll
            for (int t = 1; t < 16; ++t) { la[t] = *(const LAS v4u*)(lds + L_L + (16 * blk + t) * TP + 32 * blk); if (t > 8) lb[t] = *(const LAS v4u*)(lds + L_L + (16 * blk + t) * TP + 32 * blk + 16); }
#pragma unroll
            for (int t = 0; t < 16; ++t) { float s = (t == j) ? 1.f : 0.f;
#pragma unroll
                for (int i = 0; i < t; ++i) { const unsigned wd = (i < 8) ? ((i >> 1) == 0 ? la[t].x : (i >> 1) == 1 ? la[t].y : (i >> 1) == 2 ? la[t].z : la[t].w) : (((i - 8) >> 1) == 0 ? lb[t].x : ((i - 8) >> 1) == 1 ? lb[t].y : ((i - 8) >> 1) == 2 ? lb[t].z : lb[t].w);
                    const float lv = __uint_as_float((i & 1) ? (wd & 0xffff0000u) : (wd << 16)); s += lv * tc[i]; }
                tc[t] = s; *(LAS unsigned short*)(lds + L_Di + (16 * blk + t) * TP + j * 2) = (unsigned short)f2bf(s); }
        } else if (w == 2 || w == 3) {
            f32x16 acc[2]; acc[0] = f32x16{}; acc[1] = f32x16{};
            prod_half(acc, lds + L_Vt, lds + L_Mak, w & 1, l31, hi);
            st_half_lds<0>(acc, lds + L_W1t, w & 1, l31, hi);
        }
        P5_LBAR();
    }
    {
        const int l15 = lane & 15, q = lane >> 4, n0 = 16 * (w & 3);
        const LAS unsigned char* rhs = lds + ((w < 4) ? L_At : L_W1t); LAS unsigned char* out = lds + ((w < 4) ? L_Att : L_Vtt);
        f32x4 accX[4]; s16x4 xb16[4];
#pragma unroll
        for (int bi = 0; bi < 4; ++bi) {
            const u32x2 rw = *(const LAS u32x2*)(rhs + (n0 + l15) * TP + (16 * bi + 4 * q) * 2);
            f32x4 acc = (f32x4){__uint_as_float(rw.x << 16), __uint_as_float(rw.x & 0xffff0000u), __uint_as_float(rw.y << 16), __uint_as_float(rw.y & 0xffff0000u)};
#pragma unroll
            for (int bk = 0; bk < bi; ++bk) { const s16x4 lf = *(const LAS s16x4*)(lds + L_L + (16 * bi + l15) * TP + (16 * bk + 4 * q) * 2);
                acc = __builtin_amdgcn_mfma_f32_16x16x16bf16_1k(lf, xb16[bk], acc, 0, 0, 0); }
            const u32x2 pa = (u32x2){pg8::cvt_pk_bf16(acc[0], acc[1]), pg8::cvt_pk_bf16(acc[2], acc[3])};
            const s16x4 df = *(const LAS s16x4*)(lds + L_Di + (16 * bi + l15) * TP + (4 * q) * 2);
            accX[bi] = __builtin_amdgcn_mfma_f32_16x16x16bf16_1k(df, __builtin_bit_cast(s16x4, pa), (f32x4){0.f, 0.f, 0.f, 0.f}, 0, 0, 0);
            const u32x2 px = (u32x2){pg8::cvt_pk_bf16(accX[bi][0], accX[bi][1]), pg8::cvt_pk_bf16(accX[bi][2], accX[bi][3])};
            xb16[bi] = __builtin_bit_cast(s16x4, px);
        }
        P5_LBAR();
#pragma unroll
        for (int bi = 0; bi < 4; ++bi) *(LAS s16x4*)(out + (n0 + l15) * TP + (16 * bi + 4 * q) * 2) = xb16[bi];
        P5_LBAR();
    }
    {
        const int task = w >> 1, ph = w & 1, p = 32 * ph + l31;
        f32x16 acc[2]; acc[0] = f32x16{}; acc[1] = f32x16{};
        if (task == 0) { prod_half(acc, lds + L_Mrb, lds + L_Att, ph, l31, hi); }
        else if (task == 1) { prod_half(acc, lds + L_Bpt, lds + L_Att, ph, l31, hi); }
        else if (task == 2) { prod_half(acc, lds + L_Mrb, lds + L_Vtt, ph, l31, hi); prod_half(acc, lds + L_Mrk, lds + L_Vt, ph, l31, hi); }
        else { prod_half(acc, lds + L_Vtt, lds + L_Bpt, ph, l31, hi); prod_half(acc, lds + L_Vt, lds + L_Kpt, ph, l31, hi); }
        unsigned char* gout = ws + ((task == 0) ? WS_RTL : (task == 1) ? WS_PT : (task == 2) ? WS_YL : WS_Q) + (size_t)unit * 8192;
        const float wc = (task == 1) ? ((const LAS float*)(lds + L_WC))[p] : 0.f;
#pragma unroll
        for (int xb = 0; xb < 2; ++xb)
#pragma unroll
            for (int g = 0; g < 4; ++g) { const int q0 = 32 * xb + 8 * g + 4 * hi; float v[4];
#pragma unroll
                for (int x = 0; x < 4; ++x) v[x] = acc[xb][4 * g + x];
                if (task == 0) { const u32x2 rw = *(const LAS u32x2*)(lds + L_R + p * TP + q0 * 2); v[0] += __uint_as_float(rw.x << 16); v[1] += __uint_as_float(rw.x & 0xffff0000u); v[2] += __uint_as_float(rw.y << 16); v[3] += __uint_as_float(rw.y & 0xffff0000u); }
                if (task == 1) {
#pragma unroll
                    for (int x = 0; x < 4; ++x) if (q0 + x == p) v[x] += wc; }
                const u32x2 o = (u32x2){pg8::cvt_pk_bf16(v[0], v[1]), pg8::cvt_pk_bf16(v[2], v[3])};
                const int off = (task < 2) ? fr_off(p, q0) : (p * 128 + q0 * 2);
                *(u32x2*)(gout + off) = o; }
        P5_LBAR();
    }
}
__device__ __forceinline__ void p5_phase(Frame& F) {
    const bf16_t* Rg = (const bf16_t*)(F.ws + WS_R); const bf16_t* Kg = (const bf16_t*)(F.ws + WS_K); const bf16_t* Vg = (const bf16_t*)(F.ws + WS_V); const bf16_t* Ag = (const bf16_t*)(F.ws + WS_A);
    const float* LWg = (const float*)(F.ws + WS_LW);
    unsigned short rr[8], kr[8], vr[8], ar[8], nrr[8], nkr[8], nvr[8], nar[8]; float lw[8], nlw[8];
#define P5_LOAD(u_, R_, K_, V_, A_, W_) do { const int c_ = (u_) & 127, bh_ = (u_) >> 7; const size_t base_ = ((size_t)(bh_ >> 4) * T + c_ * 64 + 8 * F.wave) * D + (bh_ & 15) * 64 + F.lane; \
        _Pragma("unroll") for (int i = 0; i < 8; ++i) { const size_t idx = base_ + (size_t)i * D; R_[i] = Rg[idx]; K_[i] = Kg[idx]; V_[i] = Vg[idx]; A_[i] = Ag[idx]; W_[i] = LWg[idx]; } } while (0)
    int unit = F.vcu; const int NU = NB * H * 128;
    if (unit < NU) P5_LOAD(unit, rr, kr, vr, ar, lw);
    for (; unit < NU; unit += F.G) {
        const int nu = unit + F.G;
        if (nu < NU) P5_LOAD(nu, nrr, nkr, nvr, nar, nlw);
        p5_unit(F, unit, rr, kr, vr, ar, lw);
#pragma unroll
        for (int i = 0; i < 8; ++i) { rr[i] = nrr[i]; kr[i] = nkr[i]; vr[i] = nvr[i]; ar[i] = nar[i]; lw[i] = nlw[i]; }
    }
#undef P5_LOAD
}

__device__ __forceinline__ void p6_phase(Frame& F) {
    if (F.wave != 0) return;
    for (int task = F.vcu; task < NB * H * 4; task += F.G) {
        const int vq = task & 3, bh = task >> 2, h = bh & 15, b = bh >> 4;
        const int lane = F.lane, l15 = lane & 15, q = lane >> 4;
        unsigned char* ws = F.ws;
        f32x4 accS[4];
#pragma unroll
        for (int kb = 0; kb < 4; ++kb) accS[kb] = (f32x4){0.f, 0.f, 0.f, 0.f};
        const size_t ubase = (size_t)bh * 128;
        bf16x8 Pf[8], Rf[8]; u32x2 Qi[4], Yi[4];
#define P6_LOAD(cc) do { const size_t uo = (ubase + (cc)) * 8192; \
        _Pragma("unroll") for (int f = 0; f < 8; ++f) { Pf[f] = *(const bf16x8*)(ws + WS_PT + uo + (f * 64 + lane) * 16); Rf[f] = *(const bf16x8*)(ws + WS_RTL + uo + (f * 64 + lane) * 16); } \
        _Pragma("unroll") for (int kb = 0; kb < 4; ++kb) { Qi[kb] = *(const u32x2*)(ws + WS_Q + uo + (16 * vq + l15) * 128 + (16 * kb + 4 * q) * 2); Yi[kb] = *(const u32x2*)(ws + WS_YL + uo + (16 * kb + l15) * 128 + (16 * vq + 4 * q) * 2); } } while (0)
        P6_LOAD(0);
        for (int c = 0; c < 128; ++c) {
            bf16x8 Sf[2];
#pragma unroll
            for (int s = 0; s < 2; ++s) { u32x4 t; t.x = pg8::cvt_pk_bf16(accS[2 * s][0], accS[2 * s][1]); t.y = pg8::cvt_pk_bf16(accS[2 * s][2], accS[2 * s][3]);
                t.z = pg8::cvt_pk_bf16(accS[2 * s + 1][0], accS[2 * s + 1][1]); t.w = pg8::cvt_pk_bf16(accS[2 * s + 1][2], accS[2 * s + 1][3]); Sf[s] = __builtin_bit_cast(bf16x8, t); }
            f32x4 accY[4], accN[4];
#pragma unroll
            for (int tb = 0; tb < 4; ++tb) { accY[tb] = (f32x4){__uint_as_float(Yi[tb].x << 16), __uint_as_float(Yi[tb].x & 0xffff0000u), __uint_as_float(Yi[tb].y << 16), __uint_as_float(Yi[tb].y & 0xffff0000u)};
                accN[tb] = (f32x4){__uint_as_float(Qi[tb].x << 16), __uint_as_float(Qi[tb].x & 0xffff0000u), __uint_as_float(Qi[tb].y << 16), __uint_as_float(Qi[tb].y & 0xffff0000u)}; }
#pragma unroll
            for (int s = 0; s < 2; ++s)
#pragma unroll
                for (int tb = 0; tb < 4; ++tb) { accN[tb] = __builtin_amdgcn_mfma_f32_16x16x32_bf16(Pf[tb * 2 + s], Sf[s], accN[tb], 0, 0, 0);
                    accY[tb] = __builtin_amdgcn_mfma_f32_16x16x32_bf16(Sf[s], Rf[tb * 2 + s], accY[tb], 0, 0, 0); }
            if (c + 1 < 128) P6_LOAD(c + 1);
            const size_t row0 = (size_t)b * T + c * 64;
#pragma unroll
            for (int tb = 0; tb < 4; ++tb) { accS[tb] = accN[tb];
                *(u32x2*)(ws + WS_Y + ((row0 + 16 * tb + l15) * D + h * 64 + 16 * vq + 4 * q) * 2) = (u32x2){pg8::cvt_pk_bf16(accY[tb][0], accY[tb][1]), pg8::cvt_pk_bf16(accY[tb][2], accY[tb][3])}; }
        }
#undef P6_LOAD
    }
}

__device__ __forceinline__ void p6b_phase(Frame& F) {
    const int gw = F.vcu * NWAVES + F.wave, lane = F.lane; unsigned char* ws = F.ws;
    const int cb = 16 * lane, h = lane >> 2;
    float lg[16], lb[16];
#pragma unroll
    for (int i = 0; i < 16; ++i) { lg[i] = F.in[20][cb + i]; lb[i] = F.in[21][cb + i]; }
    for (int row = gw; row < M; row += F.G * NWAVES) {
        const size_t o = (size_t)row * D + cb;
        const u32x4 y0 = *(const u32x4*)(ws + WS_Y + o * 2), y1 = *(const u32x4*)(ws + WS_Y + o * 2 + 16);
        const u32x4 v0 = *(const u32x4*)(ws + WS_V + o * 2), v1 = *(const u32x4*)(ws + WS_V + o * 2 + 16);
        const u32x4 g0 = *(const u32x4*)(ws + WS_G + o * 2), g1 = *(const u32x4*)(ws + WS_G + o * 2 + 16);
        const float bon = ((const float*)(ws + WS_BONUS))[(size_t)row * 16 + h];
        const unsigned yw[8] = {y0.x, y0.y, y0.z, y0.w, y1.x, y1.y, y1.z, y1.w}, vw[8] = {v0.x, v0.y, v0.z, v0.w, v1.x, v1.y, v1.z, v1.w}, gwd[8] = {g0.x, g0.y, g0.z, g0.w, g1.x, g1.y, g1.z, g1.w};
        float y[16]; float s = 0.f;
#pragma unroll
        for (int i = 0; i < 8; ++i) { y[2 * i] = __uint_as_float(yw[i] << 16); y[2 * i + 1] = __uint_as_float(yw[i] & 0xffff0000u); s += y[2 * i] + y[2 * i + 1]; }
        s += __shfl_xor(s, 1); s += __shfl_xor(s, 2);
        const float mean = s * (1.f / 64.f); float qv = 0.f;
#pragma unroll
        for (int i = 0; i < 16; ++i) { y[i] -= mean; qv += y[i] * y[i]; }
        qv += __shfl_xor(qv, 1); qv += __shfl_xor(qv, 2);
        const float rstd = rsqrtf(qv * (1.f / 64.f) + 64e-5f);
        unsigned ow[8];
#pragma unroll
        for (int i = 0; i < 8; ++i) { const float va = __uint_as_float(vw[i] << 16), vb = __uint_as_float(vw[i] & 0xffff0000u), ga = __uint_as_float(gwd[i] << 16), gb = __uint_as_float(gwd[i] & 0xffff0000u);
            const float za = (y[2 * i] * rstd * lg[2 * i] + lb[2 * i] + bon * va) * ga, zb = (y[2 * i + 1] * rstd * lg[2 * i + 1] + lb[2 * i + 1] + bon * vb) * gb;
            ow[i] = pg8::cvt_pk_bf16(za, zb); }
        *(u32x4*)(ws + WS_Z + o * 2) = (u32x4){ow[0], ow[1], ow[2], ow[3]}; *(u32x4*)(ws + WS_Z + o * 2 + 16) = (u32x4){ow[4], ow[5], ow[6], ow[7]};
    }
}
}
namespace fk {
struct EpiPre {
    static constexpr bool PERM = false, AFTER_DRAIN = false;
    const float* res; const float* gate; float* out;
    __device__ __forceinline__ void operator()(const f32x4 (&acc)[2][2][4][2], const Unit& u, int wr, int wc, int fr, int fq) const {
        const int row0 = u.pm * BM + wr * 64 + fr, colt = u.pn * BM + wc * 32 + 4 * fq; const int b = (u.pm * BM) / T;
#pragma unroll
        for (int bj = 0; bj < 2; ++bj)
#pragma unroll
            for (int n = 0; n < 2; ++n) { const int col = colt + bj * HALF + n * 16; const f32x4 gv = *(const f32x4*)(gate + (size_t)b * 6 * D + col) + 1.f;
#pragma unroll
                for (int ai = 0; ai < 2; ++ai)
#pragma unroll
                    for (int m = 0; m < 4; ++m) { const size_t off = (size_t)(row0 + ai * HALF + m * 16) * D + col; const f32x4 rv = *(const f32x4*)(res + off);
                        *(f32x4*)(out + off) = rv * ALPHA + gv * acc[ai][bj][m][n]; }
                asm volatile("" ::: "memory"); }
    }
};
struct EpiF32 {
    static constexpr bool PERM = false, AFTER_DRAIN = false;
    float* out; int ldc;
    __device__ __forceinline__ void operator()(const f32x4 (&acc)[2][2][4][2], const Unit& u, int wr, int wc, int fr, int fq) const {
        const int row0 = u.pm * BM + wr * 64 + fr, colt = u.pn * BM + wc * 32 + 4 * fq;
#pragma unroll
        for (int ai = 0; ai < 2; ++ai)
#pragma unroll
            for (int m = 0; m < 4; ++m)
#pragma unroll
                for (int bj = 0; bj < 2; ++bj)
#pragma unroll
                    for (int n = 0; n < 2; ++n) *(f32x4*)(out + (size_t)(row0 + ai * HALF + m * 16) * ldc + colt + bj * HALF + n * 16) = acc[ai][bj][m][n];
    }
};

__device__ __forceinline__ void ln_mod_phase(Frame& F, int l) {
    const int gw = F.vcu * NWAVES + F.wave, lane = F.lane; unsigned char* ws = F.ws;
    const float* PRE = (const float*)(ws + WS_PRE); float* X1 = (float*)(ws + WS_X1); bf16_t* H2 = (bf16_t*)(ws + WS_H2);
    const float* lg = F.in[4] + (l * 2 + 0) * D; const float* lb = F.in[5] + (l * 2 + 0) * D;
    for (int row = gw; row < M; row += F.G * NWAVES) {
        const int b = row / T; const float* mod = (const float*)(ws + WS_MOD) + (size_t)(l * NB + b) * 6 * D;
        f32x4 v[4]; float s = 0.f;
#pragma unroll
        for (int j = 0; j < 4; ++j) { v[j] = *(const f32x4*)(PRE + (size_t)row * D + 4 * lane + 256 * j); s += (v[j][0] + v[j][1]) + (v[j][2] + v[j][3]); }
        const float mean = wave_sum(s) * (1.f / D); float q = 0.f;
#pragma unroll
        for (int j = 0; j < 4; ++j) { v[j] = v[j] - mean; q += (v[j][0] * v[j][0] + v[j][1] * v[j][1]) + (v[j][2] * v[j][2] + v[j][3] * v[j][3]); }
        const float rstd = rsqrtf(wave_sum(q) * (1.f / D) + LN_EPS);
#pragma unroll
        for (int j = 0; j < 4; ++j) { const int c = 4 * lane + 256 * j; const f32x4 x1 = v[j] * rstd * *(const f32x4*)(lg + c) + *(const f32x4*)(lb + c);
            *(f32x4*)(X1 + (size_t)row * D + c) = x1;
            const f32x4 h = x1 * (*(const f32x4*)(mod + 4 * D + c) + 1.f) + *(const f32x4*)(mod + 3 * D + c);
            *(u32x2*)(H2 + (size_t)row * D + c) = (u32x2){pk2(h[0], h[1]), pk2(h[2], h[3])};
            *(unsigned*)(ws + WS_H2F8 + (size_t)row * D + c) = pk4_fp8(h[0] * F8_SA, h[1] * F8_SA, h[2] * F8_SA, h[3] * F8_SA); }
    }
}

__device__ __forceinline__ void route_phase(Frame& F, int l) {
    const int lane = F.lane, w = F.wave; unsigned char* ws = F.ws; LAS unsigned char* lds = F.lds;
    LAS int* hist = (LAS int*)(lds);
    LAS int* basee = (LAS int*)(lds + 1024);
    LAS int* ent = (LAS int*)(lds + 2048);
    const float* logits = (const float*)(ws + WS_LOGITS); const float* rb = F.in[29] + l * NE;
    float* GWT = (float*)(ws + WS_GW); int* LIST = (int*)(ws + WS_LIST); gu32* cnt = F.ctl + CW_CNT + l * 256;
    const f32x4 bias = *(const f32x4*)(rb + 4 * lane);
    for (int blk = blockIdx.x; blk < M / 128; blk += F.G) {
        for (int i = F.tid; i < 256; i += NTHR) hist[i] = 0;
        __syncthreads();
        for (int it = 0; it < 16; ++it) {
            const int t = blk * 128 + w * 16 + it;
            const f32x4 lg = *(const f32x4*)(logits + (size_t)t * NE + 4 * lane);
            float s[4], c[4];
#pragma unroll
            for (int j = 0; j < 4; ++j) { s[j] = 1.f / (1.f + __expf(-lg[j])); c[j] = s[j] + bias[j]; }
            float m1 = fmaxf(c[0], c[1]), m2 = fminf(c[0], c[1]);
#pragma unroll
            for (int j = 2; j < 4; ++j) { const float x = c[j]; m2 = fmaxf(m2, fminf(m1, x)); m1 = fmaxf(m1, x); }
#define RT_MERGE(ctrl) { const float b1 = FK_DPP(m1, ctrl), b2 = FK_DPP(m2, ctrl); m2 = fmaxf(fminf(m1, b1), fmaxf(m2, b2)); m1 = fmaxf(m1, b1); }
            RT_MERGE(0xB1) RT_MERGE(0x4E) RT_MERGE(0x141)
#undef RT_MERGE
            const float gs = m1 + m2; const int g = lane >> 3; int rank = 0;
#pragma unroll
            for (int g2 = 0; g2 < 8; ++g2) { const float o = __int_as_float(__builtin_amdgcn_readlane(__float_as_int(gs), 8 * g2)); rank += (o > gs || (o == gs && g2 < g)) ? 1 : 0; }
            const bool sel = rank < 4;
#pragma unroll
            for (int j = 0; j < 4; ++j) if (!sel) c[j] = -INFINITY;
            int che[8]; float chs[8]; float ssum = 0.f;
#pragma unroll
            for (int k = 0; k < 8; ++k) {
                float bv = c[0]; int bj = 0; float bs = s[0];
#pragma unroll
                for (int j = 1; j < 4; ++j) if (c[j] > bv) { bv = c[j]; bj = j; bs = s[j]; }
                const float mx = wave_max(bv);
                const unsigned long long bal = __ballot(bv == mx);
                const int wl = __builtin_ctzll(bal);
                const int wj = __builtin_amdgcn_readlane(bj, wl); const float sv = __int_as_float(__builtin_amdgcn_readlane(__float_as_int(bs), wl));
#pragma unroll
                for (int j = 0; j < 4; ++j) if (lane == wl && j == wj) c[j] = -INFINITY;
                che[k] = 4 * wl + wj; chs[k] = sv; ssum += sv;
            }
            const float inv = 2.5f / ssum;
            if (lane < 8) { int e = che[0]; float sc = chs[0];
#pragma unroll
                for (int k = 1; k < 8; ++k) if (lane == k) { e = che[k]; sc = chs[k]; }
                const int lp = __hip_atomic_fetch_add(&hist[e], 1, __ATOMIC_RELAXED, __HIP_MEMORY_SCOPE_WORKGROUP);
                ent[(w * 16 + it) * 8 + lane] = (e << 16) | lp;
                GWT[(size_t)t * 8 + lane] = sc * inv; }
        }
        __syncthreads();
        if (F.tid < 256) { const int hc = hist[F.tid]; basee[F.tid] = hc ? (int)__hip_atomic_fetch_add(cnt + F.tid, (unsigned)hc, __ATOMIC_RELAXED, __HIP_MEMORY_SCOPE_AGENT) : 0; }
        __syncthreads();
        for (int i = F.tid; i < 1024; i += NTHR) { const int en = ent[i], e = en >> 16, lp = en & 0xffff; LIST[(size_t)e * M + basee[e] + lp] = (blk * 128 + (i >> 3)) * 8 + (i & 7); }
        __syncthreads();
    }
}
}
namespace fk {
constexpr int MOE_TAB = 132096, MOE_MAXP = 6;
constexpr int MOE_ROWS = MOE_TAB + 128;
static_assert(MOE_ROWS + MOE_MAXP * 2048 <= LDS_BYTES, "MoE LDS tables");
struct MoeUnit { int pm, pn, slot; };
struct MoeSched {
    typedef MoeUnit UnitT;
    LAS unsigned char* lds; int npairs, npn;
    const char* bexp; const char* bsh; size_t estride;
    unsigned a_base_r, a_base_s, a_rowbytes; int a_shift;
    __device__ __forceinline__ bool next(int i, MoeUnit& u) const { const int p = i / npn; if (p >= npairs) return false; u.slot = p; u.pn = i - p * npn; u.pm = 0; return true; }
    __device__ __forceinline__ int pair_e(int slot) const { return ((const LAS int*)(lds + MOE_TAB))[slot * 4 + 0]; }
    __device__ __forceinline__ const char* bbase(const MoeUnit& u) const { const int e = __builtin_amdgcn_readfirstlane(pair_e(u.slot)); return e == NE ? bsh : bexp + (size_t)e * estride; }
    __device__ __forceinline__ unsigned a_off(const MoeUnit& u, int r) const {
        const int v = ((const LAS int*)(lds + MOE_ROWS))[(u.slot * 256 + r) * 2]; const int e = pair_e(u.slot);
        if (v < 0) return (e == NE) ? a_base_s : a_base_r;
        return (e == NE) ? a_base_s + (unsigned)v * a_rowbytes : a_base_r + (unsigned)(v >> a_shift) * a_rowbytes; }
    __device__ __forceinline__ void a_ready(const MoeUnit&) const {}
    __device__ __forceinline__ void done(const MoeUnit&) const {}
};
__device__ __forceinline__ int moe_build(Frame& F, int l) {
    LAS unsigned char* lds = F.lds; LAS int* tiles = (LAS int*)(lds); LAS int* pref = (LAS int*)(lds + 1024); LAS int* cn = (LAS int*)(lds + 2048);
    LAS int* tab = (LAS int*)(lds + MOE_TAB); LAS int* rows = (LAS int*)(lds + MOE_ROWS);
    const gu32* cnt = F.ctl + CW_CNT + l * 256;
    if (F.tid < 256) { const int c = (int)__hip_atomic_load(cnt + F.tid, __ATOMIC_RELAXED, __HIP_MEMORY_SCOPE_AGENT); cn[F.tid] = c; tiles[F.tid] = (c + 255) >> 8; }
    __syncthreads();
    if (F.tid < 256) { int s = 0; for (int e = 0; e <= F.tid; ++e) s += tiles[e]; pref[F.tid] = s; }
    __syncthreads();
    const int Pr = pref[255], Ptot = Pr + 128;
    int np = 0;
    for (int p = F.vcu; p < Ptot && np < MOE_MAXP; p += F.G, ++np) {
        if (p < Pr) { if (F.tid < 256) { const int inc = pref[F.tid], exc = inc - tiles[F.tid]; if (exc <= p && p < inc) { tab[np * 4 + 0] = F.tid; tab[np * 4 + 1] = p - exc; } } }
        else if (F.tid == 0) { tab[np * 4 + 0] = NE; tab[np * 4 + 1] = p - Pr; }
    }
    __syncthreads();
    const int* LIST = (const int*)(F.ws + WS_LIST); const float* GWT = (const float*)(F.ws + WS_GW);
    for (int i = F.tid; i < np * 256; i += NTHR) { const int s = i >> 8, r = i & 255, e = tab[s * 4 + 0], mt = tab[s * 4 + 1]; int v; float gwv = 1.f;
        if (e == NE) v = mt * 256 + r; else { const int idx = mt * 256 + r; if (idx < cn[e]) { v = LIST[(size_t)e * M + idx]; gwv = GWT[v]; } else v = -1; }
        rows[i * 2] = v; rows[i * 2 + 1] = __float_as_int(gwv); }
    __syncthreads();
    return np;
}
struct EpiAct {
    static constexpr bool PERM = true, AFTER_DRAIN = false;
    LAS unsigned char* lds; bf16_t* ACT; bf16_t* ACTS; float inv;
    __device__ __forceinline__ void operator()(const f32x4 (&acc)[2][2][4][2], const MoeUnit& u, int wr, int wc, int fr, int fq) const {
        const LAS int* rows = (const LAS int*)(lds + MOE_ROWS) + u.slot * 512; const bool sh = ((const LAS int*)(lds + MOE_TAB))[u.slot * 4] == NE;
        bf16_t* base = sh ? ACTS : ACT; const int col = u.pn * 128 + wc * 32 + 8 * fq;
#pragma unroll
        for (int ai = 0; ai < 2; ++ai)
#pragma unroll
            for (int m = 0; m < 4; ++m) { const int r = ai * HALF + wr * 64 + m * 16 + fr; const int v = rows[r * 2]; if (v < 0) continue;
                float o[8];
#pragma unroll
                for (int n = 0; n < 2; ++n)
#pragma unroll
                    for (int i = 0; i < 4; ++i) { const float gq = acc[ai][0][m][n][i] * inv, uq = acc[ai][1][m][n][i] * inv; o[n * 4 + i] = gq * sigm(gq) * uq; }
                u32x4 wv; wv.x = pg8::cvt_pk_bf16(o[0], o[1]); wv.y = pg8::cvt_pk_bf16(o[2], o[3]); wv.z = pg8::cvt_pk_bf16(o[4], o[5]); wv.w = pg8::cvt_pk_bf16(o[6], o[7]);
                *(u32x4*)(base + (size_t)v * FX + col) = wv; }
    }
};
struct EpiDown {
    static constexpr bool PERM = true, AFTER_DRAIN = false;
    LAS unsigned char* lds; unsigned char* OUTR; unsigned char* YS;
    __device__ __forceinline__ void operator()(const f32x4 (&acc)[2][2][4][2], const MoeUnit& u, int wr, int wc, int fr, int fq) const {
        const LAS int* rows = (const LAS int*)(lds + MOE_ROWS) + u.slot * 512; const bool sh = ((const LAS int*)(lds + MOE_TAB))[u.slot * 4] == NE;
        unsigned char* base = sh ? YS : OUTR; const int col0 = u.pn * BM + wc * 64 + 16 * fq;
#pragma unroll
        for (int ai = 0; ai < 2; ++ai)
#pragma unroll
            for (int m = 0; m < 4; ++m) { const int r = ai * HALF + wr * 64 + m * 16 + fr; const int v = rows[r * 2]; if (v < 0) continue; const float gwv = __int_as_float(rows[r * 2 + 1]) * F8_SO;
                const f32x4 a0 = acc[ai][0][m][0] * gwv, a1 = acc[ai][0][m][1] * gwv, b0 = acc[ai][1][m][0] * gwv, b1 = acc[ai][1][m][1] * gwv;
                u32x4 wv; wv.x = pk4_fp8(a0[0], a0[1], a0[2], a0[3]); wv.y = pk4_fp8(a1[0], a1[1], a1[2], a1[3]); wv.z = pk4_fp8(b0[0], b0[1], b0[2], b0[3]); wv.w = pk4_fp8(b1[0], b1[1], b1[2], b1[3]);
                *(u32x4*)(base + (size_t)v * D + col0) = wv; }
    }
};

__device__ __forceinline__ void combine_phase(Frame& F, int l, bool next_inputs, float* dst) {
    const int gw = F.vcu * NWAVES + F.wave, lane = F.lane; unsigned char* ws = F.ws;
    const unsigned char* OUTR = ws + WS_OUTROW; const unsigned char* YS = ws + WS_YS; float* X1 = (float*)(ws + WS_X1);
    const float* lg = F.in[4] + (l * 2 + 1) * D; const float* lb = F.in[5] + (l * 2 + 1) * D;
    const int c0_ = 16 * lane;
    for (int row = gw; row < M; row += F.G * NWAVES) {
        int c0 = c0_; asm volatile("" : "+v"(c0));
        const int b = row / T; const float* mod = (const float*)(ws + WS_MOD) + (size_t)(l * NB + b) * 6 * D;
        float y[16];
#pragma unroll
        for (int i = 0; i < 16; ++i) y[i] = 0.f;
        u32x4 wv[9];
#pragma unroll
        for (int k = 0; k < 9; ++k) wv[k] = *(const u32x4*)(((k < 8) ? OUTR + ((size_t)row * 8 + k) * D : YS + (size_t)row * D) + c0);
#pragma unroll
        for (int k = 0; k < 9; ++k) { const unsigned ww[4] = {wv[k].x, wv[k].y, wv[k].z, wv[k].w};
#pragma unroll
            for (int i = 0; i < 4; ++i) { const auto lo = __builtin_amdgcn_cvt_pk_f32_fp8((int)ww[i], false), hi = __builtin_amdgcn_cvt_pk_f32_fp8((int)ww[i], true);
                y[4 * i] += lo[0]; y[4 * i + 1] += lo[1]; y[4 * i + 2] += hi[0]; y[4 * i + 3] += hi[1]; } }
        float v[16]; float s = 0.f;
#pragma unroll
        for (int q4 = 0; q4 < 4; ++q4) { const int c = c0 + 4 * q4; const f32x4 x1 = *(const f32x4*)(X1 + (size_t)row * D + c); const f32x4 g1 = (*(const f32x4*)(mod + 5 * D + c) + 1.f) * (1.f / F8_SO);
#pragma unroll
            for (int i = 0; i < 4; ++i) { const float p = ALPHA * x1[i] + g1[i] * y[q4 * 4 + i]; v[q4 * 4 + i] = p; s += p; } }
        const float mean = wave_sum(s) * (1.f / D); float q = 0.f;
#pragma unroll
        for (int i = 0; i < 16; ++i) { v[i] -= mean; q += v[i] * v[i]; }
        const float rstd = rsqrtf(wave_sum(q) * (1.f / D) + LN_EPS);
#pragma unroll
        for (int q4 = 0; q4 < 4; ++q4) { const int c = c0 + 4 * q4; const f32x4 gg = *(const f32x4*)(lg + c), bb = *(const f32x4*)(lb + c);
#pragma unroll
            for (int i = 0; i < 4; ++i) v[q4 * 4 + i] = v[q4 * 4 + i] * rstd * gg[i] + bb[i];
            *(f32x4*)((next_inputs ? X1 : dst) + (size_t)row * D + c) = (f32x4){v[q4 * 4], v[q4 * 4 + 1], v[q4 * 4 + 2], v[q4 * 4 + 3]}; }
        if (next_inputs) {
            const float* mod1 = (const float*)(ws + WS_MOD) + (size_t)((l + 1) * NB + b) * 6 * D;
            bf16_t* XB = (bf16_t*)(ws + WS_XB); bf16_t* HB = (bf16_t*)(ws + WS_HB);
#pragma unroll
            for (int j = 0; j < 2; ++j) { const int c = c0 + 8 * j; float hh[8];
#pragma unroll
                for (int h4 = 0; h4 < 2; ++h4) { const f32x4 sc = *(const f32x4*)(mod1 + D + c + 4 * h4) + 1.f, sh = *(const f32x4*)(mod1 + c + 4 * h4);
#pragma unroll
                    for (int i = 0; i < 4; ++i) hh[h4 * 4 + i] = v[j * 8 + h4 * 4 + i] * sc[i] + sh[i]; }
                *(u32x4*)(XB + (size_t)row * D + c) = (u32x4){pk2(v[j * 8], v[j * 8 + 1]), pk2(v[j * 8 + 2], v[j * 8 + 3]), pk2(v[j * 8 + 4], v[j * 8 + 5]), pk2(v[j * 8 + 6], v[j * 8 + 7])};
                *(u32x4*)(HB + (size_t)row * D + c) = (u32x4){pk2(hh[0], hh[1]), pk2(hh[2], hh[3]), pk2(hh[4], hh[5]), pk2(hh[6], hh[7])}; }
            const float* kvw = F.in[22]; float fl[16];
#pragma unroll
            for (int hh_ = 0; hh_ < 16; ++hh_) fl[hh_] = 0.f;
#pragma unroll
            for (int i = 0; i < 16; ++i) { const float xv = v[i]; const float* wr_ = kvw + (size_t)(c0 + i) * (2 * D + H) + 2 * D;
                const f32x4 w0 = *(const f32x4*)(wr_), w1 = *(const f32x4*)(wr_ + 4), w2 = *(const f32x4*)(wr_ + 8), w3 = *(const f32x4*)(wr_ + 12);
#pragma unroll
                for (int e = 0; e < 4; ++e) { fl[e] += xv * w0[e]; fl[4 + e] += xv * w1[e]; fl[8 + e] += xv * w2[e]; fl[12 + e] += xv * w3[e]; } }
            float r8[8];
#pragma unroll
            for (int e = 0; e < 8; ++e) { const auto sw = __builtin_amdgcn_permlane32_swap(__float_as_uint(fl[e]), __float_as_uint(fl[e + 8]), false, false); r8[e] = __uint_as_float(sw[0]) + __uint_as_float(sw[1]); }
            float r4[4];
#pragma unroll
            for (int e = 0; e < 4; ++e) { const auto sw = __builtin_amdgcn_permlane16_swap(__float_as_uint(r8[e]), __float_as_uint(r8[e + 4]), false, false); r4[e] = row16_sum(__uint_as_float(sw[0]) + __uint_as_float(sw[1])); }
            const int l15 = lane & 15;
            if (l15 < 4) { const float mine = (l15 == 0) ? r4[0] : (l15 == 1) ? r4[1] : (l15 == 2) ? r4[2] : r4[3]; const int hd = (lane >> 4) * 4 + l15;
                ((float*)(ws + WS_LOGF))[(size_t)row * 16 + hd] = -softplus_(-(mine + F.in[23][hd])); }
        }
    }
}
}
namespace attn_fox {
using bf16=__hip_bfloat16;
using bf16x8=__attribute__((ext_vector_type(8)))short;
using s16x4=__attribute__((ext_vector_type(4)))short;
using f32x16=__attribute__((ext_vector_type(16)))float;
using u32x4=__attribute__((ext_vector_type(4)))unsigned;
using f32x4k=__attribute__((ext_vector_type(4)))float;
constexpr int BATCH=4,NHEAD=16,SEQ=8192,D=64,DM=NHEAD*D;
constexpr int NW=8,QBLK=32,QB=QBLK*NW,KVBLK=64,NQB=SEQ/QB;
constexpr int ATTN_PITCH=DM, ATTN_UNIT_ROWS=QB;
__device__ __forceinline__ int crow(int r,int hi){return (r&3)+8*(r>>2)+4*hi;}
#define SBAR() __builtin_amdgcn_sched_barrier(0)
__device__ __forceinline__ void cmask(f32x16&p0,f32x16&p1,int jb,int qrel,int hi){
  const float NEG=-INFINITY; int kb=64*jb+4*hi;
  #pragma unroll
  for(int r=0;r<16;++r){int kv=kb+(r&3)+8*(r>>2); if(kv>qrel)p0[r]=NEG; if(kv+32>qrel)p1[r]=NEG;}
}

constexpr int NSLOT=3, SLOTB=8192;
constexpr int LDS_K=0, LDS_V=NSLOT*SLOTB, LDS_WS=2*NSLOT*SLOTB, LDS_OST=LDS_WS+NW*64*4, LDS_KB=86016  , LDS_BYTES=LDS_KB+SEQ*4;
constexpr float C2=0.125f*1.4426950408889634f;
__device__ __forceinline__ void glds16(const void*gsrc,unsigned lds_dst){unsigned keep;
  asm volatile("s_mov_b32 %0, m0\n\ts_mov_b32 m0, %2\n\ts_nop 0\n\tglobal_load_lds_dwordx4 %1, off\n\ts_mov_b32 m0, %0":"=&s"(keep):"v"(gsrc),"s"(lds_dst):"memory");}
__device__ __forceinline__ float max3f(float a,float b,float c){float r;asm("v_max3_f32 %0, %1, %2, %3":"=v"(r):"v"(a),"v"(b),"v"(c));return r;}
__device__ __forceinline__ float max2f(float a,float b){float r;asm("v_max_f32_e32 %0, %1, %2":"=v"(r):"v"(a),"v"(b));return r;}
__device__ __forceinline__ float fadd_s(float a,float b){float r;asm("v_add_f32_e32 %0, %1, %2":"=v"(r):"v"(a),"v"(b));return r;}
__device__ __forceinline__ float fsub_s(float a,float b){float r;asm("v_sub_f32_e32 %0, %1, %2":"=v"(r):"v"(a),"v"(b));return r;}
typedef float f32x2_t __attribute__((ext_vector_type(2))); typedef __bf16 bf16x2_t __attribute__((ext_vector_type(2)));
__device__ __forceinline__ unsigned cvtpk_s(float lo,float hi){f32x2_t v={lo,hi};bf16x2_t b=__builtin_convertvector(v,bf16x2_t);return __builtin_bit_cast(unsigned,b);}
#define WAIT_BAR(N) asm volatile("s_waitcnt vmcnt(" #N ") lgkmcnt(0)\n\ts_barrier":::"memory")

__device__ __forceinline__ void qkt(f32x16&p0,f32x16&p1,const char*Kslot,const bf16x8*qr,const f32x16&negm,int r32,int hi){
  const char*kb=Kslot+hi*1024+r32*16;
  #pragma unroll
  for(int d0=0;d0<4;++d0){
    const bf16x8 b0=*reinterpret_cast<const bf16x8*>(kb+d0*2048);
    const bf16x8 b1=*reinterpret_cast<const bf16x8*>(kb+d0*2048+512);
    if(d0==0){p0=__builtin_amdgcn_mfma_f32_32x32x16_bf16(b0,qr[0],negm,0,0,0);p1=__builtin_amdgcn_mfma_f32_32x32x16_bf16(b1,qr[0],negm,0,0,0);}
    else{p0=__builtin_amdgcn_mfma_f32_32x32x16_bf16(b0,qr[d0],p0,0,0,0);p1=__builtin_amdgcn_mfma_f32_32x32x16_bf16(b1,qr[d0],p1,0,0,0);}}
}
typedef __attribute__((address_space(3))) const char* lds_cptr;
typedef short v4i16_t __attribute__((ext_vector_type(4)));
__device__ __forceinline__ void kload8(bf16x8*kf,lds_cptr kp){
  kf[0]=*(const __attribute__((address_space(3))) bf16x8*)(kp);      kf[1]=*(const __attribute__((address_space(3))) bf16x8*)(kp+512);
  kf[2]=*(const __attribute__((address_space(3))) bf16x8*)(kp+2048); kf[3]=*(const __attribute__((address_space(3))) bf16x8*)(kp+2560);
  kf[4]=*(const __attribute__((address_space(3))) bf16x8*)(kp+4096); kf[5]=*(const __attribute__((address_space(3))) bf16x8*)(kp+4608);
  kf[6]=*(const __attribute__((address_space(3))) bf16x8*)(kp+6144); kf[7]=*(const __attribute__((address_space(3))) bf16x8*)(kp+6656);
}
__device__ __forceinline__ void kload2(bf16x8*kf,lds_cptr kp,int j){ kf[2*j]=*(const __attribute__((address_space(3))) bf16x8*)(kp+j*2048); kf[2*j+1]=*(const __attribute__((address_space(3))) bf16x8*)(kp+j*2048+512); }
__device__ __forceinline__ s16x4 vtr(lds_cptr p){ return __builtin_bit_cast(s16x4,__builtin_amdgcn_ds_read_tr16_b64_v4i16((__attribute__((address_space(3))) v4i16_t*)p)); }
__device__ __forceinline__ float rowmax(const f32x16&p0,const f32x16&p1){
  float a=max3f(p0[0],p0[1],p1[0]),b=max3f(p0[2],p0[3],p1[1]);a=max3f(a,p1[2],p1[3]);
  #pragma unroll
  for(int r=4;r<16;r+=4){a=max3f(a,p0[r],p0[r+1]);b=max3f(b,p0[r+2],p0[r+3]);a=max3f(a,p1[r],p1[r+1]);b=max3f(b,p1[r+2],p1[r+3]);}
  const float m=max2f(a,b);
  auto rr=__builtin_amdgcn_permlane32_swap(__float_as_uint(m),__float_as_uint(m),false,false);
  return max2f(__uint_as_float(rr[0]),__uint_as_float(rr[1]));
}
__device__ __forceinline__ void pv(f32x16*o,int vb,bf16x8 pa0,bf16x8 pa1,bf16x8 pa2,bf16x8 pa3){
  #pragma unroll
  for(int d0=0;d0<2;++d0){s16x4 lo[4],hi[4];
    #pragma unroll
    for(int ks=0;ks<4;++ks){
      asm volatile("ds_read_b64_tr_b16 %0,%1 offset:%c2":"=&v"(lo[ks]):"v"(vb),"i"(d0*4096+ks*1024):"memory");
      asm volatile("ds_read_b64_tr_b16 %0,%1 offset:%c2":"=&v"(hi[ks]):"v"(vb),"i"(d0*4096+ks*1024+512):"memory");}
    asm volatile("s_waitcnt lgkmcnt(0)":::"memory");SBAR();
    #define PK(k) (bf16x8){lo[k][0],lo[k][1],lo[k][2],lo[k][3],hi[k][0],hi[k][1],hi[k][2],hi[k][3]}
    o[d0]=__builtin_amdgcn_mfma_f32_32x32x16_bf16(pa0,PK(0),o[d0],0,0,0);
    o[d0]=__builtin_amdgcn_mfma_f32_32x32x16_bf16(pa1,PK(1),o[d0],0,0,0);
    o[d0]=__builtin_amdgcn_mfma_f32_32x32x16_bf16(pa2,PK(2),o[d0],0,0,0);
    o[d0]=__builtin_amdgcn_mfma_f32_32x32x16_bf16(pa3,PK(3),o[d0],0,0,0);
    #undef PK
  }
}

#ifndef ATTN_STORE16
#define ATTN_STORE16(p,v) (*(u32x4*)(p)=(v))
#endif
template<int THRL> __device__ __forceinline__ void attn_unit(int b,int h,int qb,const bf16*Q,const bf16*__restrict__ K,const bf16*__restrict__ V,bf16*O,const bf16*__restrict__ GATE,const float*__restrict__ Fbh,float thr_nat,char*shm,int wid_in){
  int lane; asm volatile("v_mbcnt_lo_u32_b32 %0, -1, 0\n\tv_mbcnt_hi_u32_b32 %0, -1, %0":"=v"(lane)); const int wid=__builtin_amdgcn_readfirstlane(wid_in); const int tid=wid*64+lane,r32=lane&31,hi=lane>>5;
  const long rowbase=(long)b*SEQ; const int q0=qb*QB;
  const float Fref=Fbh[q0]; int t_lo;
  { const int NTF=(q0+QB)/KVBLK; const int ta=lane, tb=lane+64;
    const bool ka=(ta<NTF-4)?((Fref-Fbh[64*ta+63])<-thr_nat):false, kb_=(tb<NTF-4)?((Fref-Fbh[64*tb+63])<-thr_nat):false;
    const unsigned long long ma=__ballot(!ka), mb=__ballot(!kb_);
    int lead=(ma!=0ull)?__builtin_ctzll(ma):((mb!=0ull)?64+__builtin_ctzll(mb):128); t_lo=__builtin_amdgcn_readfirstlane(lead)&~1; }
  { typedef __attribute__((address_space(3))) float ldsf; ldsf*kbw=(ldsf*)(shm+LDS_KB); const int nk=q0+QB-64*t_lo; const float L2E=1.4426950408889634f;
    for(int i=tid;i<nk;i+=NW*64) kbw[i]=(Fref-Fbh[64*t_lo+i])*L2E; }
  const bf16*Qw=Q+(rowbase+q0+wid*QBLK)*DM+h*D;
  const bf16*Kh=K+(rowbase+64*t_lo)*DM+h*D,*Vh=V+(rowbase+64*t_lo)*DM+h*D;
  const unsigned lds0=(unsigned)(uintptr_t)shm;
  float*wsf=(float*)(shm+LDS_WS)+wid*64;
  const bf16*ksrc=Kh+(long)lane*DM+wid*8;
  const bf16*vsrc=Vh+(long)(16*(wid&3)+(lane>>2))*DM+(wid>>2)*32+(lane&3)*8;
  const unsigned kdst=lds0+LDS_K+wid*1024, vdst=lds0+LDS_V+wid*1024;
  #define DMA_K(t,slot) glds16(ksrc+(long)(t)*KVBLK*DM,(unsigned)__builtin_amdgcn_readfirstlane(kdst+(slot)))
  #define DMA_V(t,slot) glds16(vsrc+(long)(t)*KVBLK*DM,(unsigned)__builtin_amdgcn_readfirstlane(vdst+(slot)))
  const int vb0=(int)(lds0+LDS_V)+((lane>>4)&1)*32+(lane&3)*8+(4*hi+((lane&15)>>2))*64;
  const char*Kbase=shm+LDS_K; bf16x8 kf[8];
  const lds_cptr shm3=(lds_cptr)shm; const lds_cptr kp0=shm3+LDS_K+hi*1024+r32*16; const lds_cptr vp0=shm3+LDS_V+((lane>>4)&1)*32+(lane&3)*8+(4*hi+((lane&15)>>2))*64;
  const int NT=(q0+QB)/KVBLK-t_lo;
  DMA_K(0,0);DMA_V(0,0);DMA_K(1,SLOTB);
  bf16x8 qr[4];
  #pragma unroll
  for(int d0=0;d0<4;++d0)qr[d0]=*reinterpret_cast<const bf16x8*>(&Qw[(long)r32*DM+d0*16+hi*8]);
  const int qrel=wid*QBLK+r32;
  float l_reg=0.f;f32x16 o[2];o[0]=f32x16{};o[1]=f32x16{};const float rb=(Fbh[q0+qrel]-Fref)*1.4426950408889634f; const f32x16 negm=f32x16{};
  typedef __attribute__((address_space(3))) const float* kb_cptr; const kb_cptr kb0=(kb_cptr)(shm+LDS_KB)+4*hi;
  #define KBIAS(C0_,C1_,t_) do{ const kb_cptr kp_=kb0+64*(t_); _Pragma("unroll") for(int g_=0;g_<4;++g_){ const f32x4k a_=*(const __attribute__((address_space(3))) f32x4k*)(kp_+8*g_), b_=*(const __attribute__((address_space(3))) f32x4k*)(kp_+32+8*g_); \
      _Pragma("unroll") for(int x_=0;x_<4;++x_){ C0_[4*g_+x_]+=(a_[x_]+rb); C1_[4*g_+x_]+=(b_[x_]+rb); } } }while(0)
  #define CMASK(P0,P1,t) do{int jb_=(t)-(NT-4); if(jb_>=0)cmask(P0,P1,jb_,qrel,hi);}while(0)
  #define START(P0,P1) do{ _Pragma("unroll") for(int r=0;r<16;++r)P0[r]=__builtin_amdgcn_exp2f(P0[r]); }while(0)
  #define RESC() do{}while(0)
  f32x16 pA0,pA1,pB0,pB1;
  int sl_prev=0,sl_cur=0,sl_next=SLOTB;
  #define ROT() do{sl_prev=sl_cur;sl_cur=sl_next;sl_next=(sl_next==(NSLOT-1)*SLOTB)?0:sl_next+SLOTB;}while(0)
  DMA_K(2,2*SLOTB);
  WAIT_BAR(3);
  qkt(pA0,pA1,Kbase,qr,negm,r32,hi);asm volatile("s_nop 15\n\ts_nop 7":"+v"(pA0),"+v"(pA1));KBIAS(pA0,pA1,0);CMASK(pA0,pA1,0);
  START(pA0,pA1);
  _Pragma("unroll") for(int r=0;r<16;++r)pA1[r]=__builtin_amdgcn_exp2f(pA1[r]);
  WAIT_BAR(0);
  DMA_K(3,0);DMA_V(1,SLOTB);
  ROT();
  kload8(kf,kp0+sl_cur);
  WAIT_BAR(2);
  s16x4 vlo[8],vhi[8]; u32x4 pw0,pw1,pw2,pw3;
  #define PKW(P,B) cvtpk_s(P[B],P[B+1])
  #define PAF(k) __builtin_bit_cast(bf16x8,pw##k)
  #define VFR(i) (bf16x8){vlo[i][0],vlo[i][1],vlo[i][2],vlo[i][3],vhi[i][0],vhi[i][1],vhi[i][2],vhi[i][3]}
  #define PIN(x) asm volatile("":"+v"(x))
  #define MX3(a,b,c) __builtin_fmaxf(__builtin_fmaxf((a),(b)),(c))
  #define GAPA(MF,A0,A1,A2,A3,W0,W1,PW) do{ MF; sacc+=A0; sacc+=A1; sacc+=A2; sacc+=A3; PIN(sacc); W0; W1; PIN(PW); SBAR(); }while(0)
  #define EX(v) __builtin_amdgcn_exp2f(v)
  #define GAPB(MF,X,B) do{ MF; X[B]=EX(X[B]); X[B+1]=EX(X[B+1]); X[B+2]=EX(X[B+2]); X[B+3]=EX(X[B+3]); PIN(X); SBAR(); }while(0)
  #define VRD(i) do{ vlo[i]=vtr(vp_+(((i)>>2)*4096+((i)&3)*1024)); vhi[i]=vtr(vp_+(((i)>>2)*4096+((i)&3)*1024+512)); }while(0)
  #define KRD(G,j) do{ if(G){ kload2(kf,kp0+sl_next,j); SBAR(); } }while(0)
  #define STEP(C0,C1,P0,P1,t,GK,GV,GL) do{ SBAR(); \
    const lds_cptr vp_=vp0+sl_prev; \
    VRD(0); SBAR(); float sacc=(P0[0]+P0[1]); \
    GAPA(C0=__builtin_amdgcn_mfma_f32_32x32x16_bf16(kf[0],qr[0],negm,0,0,0), P0[2],P0[3],P0[4],P0[5],     pw0[0]=PKW(P0,0), pw0[1]=PKW(P0,2), pw0); \
    VRD(4); SBAR(); GAPA(C1=__builtin_amdgcn_mfma_f32_32x32x16_bf16(kf[1],qr[0],negm,0,0,0), P0[6],P0[7],P0[8],P0[9],     pw0[2]=PKW(P0,4), pw0[3]=PKW(P0,6), pw0); \
    VRD(1); SBAR(); GAPA(C0=__builtin_amdgcn_mfma_f32_32x32x16_bf16(kf[2],qr[1],C0,0,0,0),   P0[10],P0[11],P0[12],P0[13], pw1[0]=PKW(P0,8), pw1[1]=PKW(P0,10), pw1); \
    VRD(5); SBAR(); GAPA(C1=__builtin_amdgcn_mfma_f32_32x32x16_bf16(kf[3],qr[1],C1,0,0,0),   P0[14],P0[15],P1[0],P1[1],   pw1[2]=PKW(P0,12),pw1[3]=PKW(P0,14), pw1); \
    VRD(2); SBAR(); GAPA(C0=__builtin_amdgcn_mfma_f32_32x32x16_bf16(kf[4],qr[2],C0,0,0,0),   P1[2],P1[3],P1[4],P1[5],     pw2[0]=PKW(P1,0), pw2[1]=PKW(P1,2), pw2); \
    VRD(6); SBAR(); GAPA(C1=__builtin_amdgcn_mfma_f32_32x32x16_bf16(kf[5],qr[2],C1,0,0,0),   P1[6],P1[7],P1[8],P1[9],     pw2[2]=PKW(P1,4), pw2[3]=PKW(P1,6), pw2); \
    VRD(3); SBAR(); GAPA(C0=__builtin_amdgcn_mfma_f32_32x32x16_bf16(kf[6],qr[3],C0,0,0,0),   P1[10],P1[11],P1[12],P1[13], pw3[0]=PKW(P1,8), pw3[1]=PKW(P1,10), pw3); \
    VRD(7); SBAR(); GAPA(C1=__builtin_amdgcn_mfma_f32_32x32x16_bf16(kf[7],qr[3],C1,0,0,0),   P1[14],P1[15],0.f,0.f,       pw3[2]=PKW(P1,12),pw3[3]=PKW(P1,14), pw3); \
    l_reg+=sacc; \
    if(GK){DMA_K((t)+3,sl_cur);} if(GV){DMA_V((t)+1,sl_next);} \
    KBIAS(C0,C1,t); CMASK(C0,C1,t); \
    SBAR(); \
    GAPB(o[0]=__builtin_amdgcn_mfma_f32_32x32x16_bf16(PAF(0),VFR(0),o[0],0,0,0), C0,0); \
    GAPB(o[1]=__builtin_amdgcn_mfma_f32_32x32x16_bf16(PAF(0),VFR(4),o[1],0,0,0), C0,4); \
    KRD(GL,0); GAPB(o[0]=__builtin_amdgcn_mfma_f32_32x32x16_bf16(PAF(1),VFR(1),o[0],0,0,0), C0,8); \
    KRD(GL,1); GAPB(o[1]=__builtin_amdgcn_mfma_f32_32x32x16_bf16(PAF(1),VFR(5),o[1],0,0,0), C0,12); \
    KRD(GL,2); GAPB(o[0]=__builtin_amdgcn_mfma_f32_32x32x16_bf16(PAF(2),VFR(2),o[0],0,0,0), C1,0); \
    KRD(GL,3); GAPB(o[1]=__builtin_amdgcn_mfma_f32_32x32x16_bf16(PAF(2),VFR(6),o[1],0,0,0), C1,4); \
    GAPB(o[0]=__builtin_amdgcn_mfma_f32_32x32x16_bf16(PAF(3),VFR(3),o[0],0,0,0), C1,8); \
    GAPB(o[1]=__builtin_amdgcn_mfma_f32_32x32x16_bf16(PAF(3),VFR(7),o[1],0,0,0), C1,12); \
    }while(0)
  int t=1;
  #undef CMASK
  #define CMASK(P0,P1,t) do{}while(0)
  for(;t+5<NT;t+=2){
    STEP(pB0,pB1,pA0,pA1,t,true,true,true);     WAIT_BAR(2); RESC(); ROT();
    STEP(pA0,pA1,pB0,pB1,t+1,true,true,true);   WAIT_BAR(2); RESC(); ROT();
  }
  #undef CMASK
  #define CMASK(P0,P1,t) do{int jb_=(t)-(NT-4); if(jb_>=0)cmask(P0,P1,jb_,qrel,hi);}while(0)
  #define ENDW(tt) do{ if((tt)+3<NT){WAIT_BAR(2);} else if((tt)+2<NT){WAIT_BAR(1);} else {WAIT_BAR(0);} }while(0)
  for(;t+1<NT;t+=2){
    STEP(pB0,pB1,pA0,pA1,t,(t+3<NT),(t+1<NT),(t+1<NT));       ENDW(t);   RESC(); ROT();
    STEP(pA0,pA1,pB0,pB1,t+1,(t+4<NT),(t+2<NT),(t+2<NT));     ENDW(t+1); RESC(); ROT();
  }
  STEP(pB0,pB1,pA0,pA1,NT-1,false,false,false); RESC();
  { float sacc=pB0[0]+pB0[1]; _Pragma("unroll") for(int r=2;r<16;++r)sacc+=pB0[r]; _Pragma("unroll") for(int r=0;r<16;++r)sacc+=pB1[r]; l_reg+=sacc;
    pw0=(u32x4){PKW(pB0,0),PKW(pB0,2),PKW(pB0,4),PKW(pB0,6)};pw1=(u32x4){PKW(pB0,8),PKW(pB0,10),PKW(pB0,12),PKW(pB0,14)};pw2=(u32x4){PKW(pB1,0),PKW(pB1,2),PKW(pB1,4),PKW(pB1,6)};pw3=(u32x4){PKW(pB1,8),PKW(pB1,10),PKW(pB1,12),PKW(pB1,14)};
    SBAR(); pv(o,vb0+sl_cur,PAF(0),PAF(1),PAF(2),PAF(3)); }
  #undef PKW
  #undef PAF
  #undef VFR
  #undef PIN
  #undef MX3
  #undef GAPA
  #undef GAPB
  #undef EX
  #undef VRD
  #undef KRD
  #undef STEP
  #undef ENDW
  {auto rr=__builtin_amdgcn_permlane32_swap(__float_as_uint(l_reg),__float_as_uint(l_reg),false,false);l_reg=__uint_as_float(rr[0])+__uint_as_float(rr[1]);}
  if(hi==0)wsf[32+r32]=l_reg;asm volatile("s_waitcnt lgkmcnt(0)":::"memory");
  float rli[16];
  #pragma unroll
  for(int r=0;r<16;++r)rli[r]=__builtin_amdgcn_rcpf(wsf[32+crow(r,hi)]);
  bf16*Ow=O+(rowbase+q0+wid*QBLK)*DM+h*D;
  { bf16*stg=(bf16*)(shm+LDS_OST)+wid*2048;
    #pragma unroll
    for(int r=0;r<16;++r){const int orow=crow(r,hi);
      #pragma unroll
      for(int d0=0;d0<2;++d0)stg[orow*64+d0*32+r32]=__float2bfloat16(o[d0][r]*rli[r]);}
    asm volatile("s_waitcnt lgkmcnt(0)":::"memory");
    #pragma unroll
    for(int i=0;i<4;++i){const int row=i*8+(lane>>3),ch=lane&7; const u32x4 v=*(const u32x4*)(stg+row*64+ch*8); const u32x4 gq=*(const u32x4*)(GATE+(rowbase+q0+wid*QBLK+row)*DM+h*D+ch*8);
      const unsigned vv_[4]={v.x,v.y,v.z,v.w},gg_[4]={gq.x,gq.y,gq.z,gq.w}; unsigned oo_[4];
      _Pragma("unroll") for(int x_=0;x_<4;++x_) oo_[x_]=cvtpk_s(__uint_as_float(vv_[x_]<<16)*__uint_as_float(gg_[x_]<<16),__uint_as_float(vv_[x_]&0xffff0000u)*__uint_as_float(gg_[x_]&0xffff0000u));
      ATTN_STORE16(Ow+(long)row*DM+ch*8,((u32x4){oo_[0],oo_[1],oo_[2],oo_[3]}));} }
  asm volatile("s_waitcnt lgkmcnt(0)\n\ts_barrier":::"memory");
  #undef DMA_K
  #undef DMA_V
  #undef CMASK
  #undef START
  #undef RESC
  #undef ROT
  #undef KBIAS
}
constexpr int ATTN_LDS_BYTES=LDS_BYTES;
#undef SBAR
#undef WAIT_BAR
}
namespace fk {
template <bool SIG> struct EpiNormHeads {
    static constexpr bool PERM = true, AFTER_DRAIN = false;
    bf16_t* O0; bf16_t* O1; const float* gain; float scale;
    __device__ __forceinline__ void operator()(const f32x4 (&acc)[2][2][4][2], const Unit& u, int wr, int wc, int fr, int fq) const {
        const int row0 = u.pm * BM + wr * 64 + fr;
        if (u.pn < 4) {
            const int head = 4 * u.pn + wc;
            f32x4 g[2][2];
#pragma unroll
            for (int bj = 0; bj < 2; ++bj)
#pragma unroll
                for (int n = 0; n < 2; ++n) g[bj][n] = *(const f32x4*)(gain + 32 * bj + 8 * fq + 4 * n) * scale;
#pragma unroll
            for (int ai = 0; ai < 2; ++ai)
#pragma unroll
                for (int m = 0; m < 4; ++m) { float ss = 0.f;
#pragma unroll
                    for (int bj = 0; bj < 2; ++bj)
#pragma unroll
                        for (int n = 0; n < 2; ++n) { const f32x4 x = acc[ai][bj][m][n]; ss += (x[0] * x[0] + x[1] * x[1]) + (x[2] * x[2] + x[3] * x[3]); }
                    ss += __shfl_xor(ss, 16); ss += __shfl_xor(ss, 32);
                    const float rs = rsqrtf(ss * (1.f / 64.f) + 1e-6f);
                    bf16_t* rowp = O0 + (size_t)(row0 + ai * HALF + m * 16) * D + head * 64 + 8 * fq;
#pragma unroll
                    for (int bj = 0; bj < 2; ++bj) { const f32x4 v0 = acc[ai][bj][m][0] * rs * g[bj][0], v1 = acc[ai][bj][m][1] * rs * g[bj][1];
                        u32x4 wv; wv.x = pg8::cvt_pk_bf16(v0[0], v0[1]); wv.y = pg8::cvt_pk_bf16(v0[2], v0[3]); wv.z = pg8::cvt_pk_bf16(v1[0], v1[1]); wv.w = pg8::cvt_pk_bf16(v1[2], v1[3]);
                        *(u32x4*)(rowp + 32 * bj) = wv; } }
        } else {
            const int col0 = (u.pn - 4) * BM + wc * 32 + 8 * fq;
#pragma unroll
            for (int ai = 0; ai < 2; ++ai)
#pragma unroll
                for (int m = 0; m < 4; ++m) { bf16_t* rowp = O1 + (size_t)(row0 + ai * HALF + m * 16) * D + col0;
#pragma unroll
                    for (int bj = 0; bj < 2; ++bj) { f32x4 v0 = acc[ai][bj][m][0], v1 = acc[ai][bj][m][1];
                        if (SIG) { for (int i = 0; i < 4; ++i) { v0[i] = sigm(v0[i]); v1[i] = sigm(v1[i]); } }
                        u32x4 wv; wv.x = pg8::cvt_pk_bf16(v0[0], v0[1]); wv.y = pg8::cvt_pk_bf16(v0[2], v0[3]); wv.z = pg8::cvt_pk_bf16(v1[0], v1[1]); wv.w = pg8::cvt_pk_bf16(v1[2], v1[3]);
                        *(u32x4*)(rowp + bj * HALF) = wv; } }
        }
    }
};

__device__ __forceinline__ void fcum_phase(Frame& F) {
    LAS float* part = (LAS float*)(F.lds);
    for (int bh = blockIdx.x; bh < NB * H; bh += F.G) {
        const int b = bh >> 4, h = bh & 15; const float* lf = (const float*)(F.ws + WS_LOGF) + ((size_t)b * T + F.tid * 16) * 16 + h;
        float v[16]; float s = 0.f;
#pragma unroll
        for (int i = 0; i < 16; ++i) { v[i] = lf[(size_t)i * 16]; s += v[i]; }
        part[F.tid] = s;
        __syncthreads();
        if (F.wave == 0) { float run = 0.f;
            for (int c = 0; c < 8; ++c) { const float x = part[c * 64 + F.lane]; float inc = x;
#pragma unroll
                for (int o = 1; o < 64; o <<= 1) { const float u = __shfl_up(inc, o); if (F.lane >= o) inc += u; }
                part[c * 64 + F.lane] = run + inc - x;
                run += __shfl(inc, 63); } }
        __syncthreads();
        float run = part[F.tid]; float* Fo = (float*)(F.ws + WS_FLOC) + (size_t)bh * T + F.tid * 16;
#pragma unroll
        for (int i = 0; i < 16; ++i) { run += v[i]; Fo[i] = run; }
        __syncthreads();
    }
}

__device__ __forceinline__ void attn_phase_fox(Frame& F, unsigned char* lds_generic) {
    typedef attn_fox::bf16 abf;
    const float gq = fabsf(F.in[26][F.lane]), gk = fabsf(F.in[24][F.lane]); float mq = gq, mk = gk;
#pragma unroll
    for (int o = 1; o < 64; o <<= 1) { mq = fmaxf(mq, __shfl_xor(mq, o)); mk = fmaxf(mk, __shfl_xor(mk, o)); }
    const float thr = 104.f + 16.5f * mq * mk;
    const abf* Q = (const abf*)(F.ws + WS_QN); const abf* K = (const abf*)(F.ws + WS_KN); const abf* V = (const abf*)(F.ws + WS_VV); const abf* G = (const abf*)(F.ws + WS_GATE); abf* O = (abf*)(F.ws + WS_O);
    const float* Fc = (const float*)(F.ws + WS_FLOC);
    const int nunits = NB * H * 32;
    for (int i = 0;; ++i) {
        const int v = F.vcu + (i >> 3) * F.G; const int bh = v >> 2, s = v & 3, j = i & 7; if (bh >= NB * H) break;
        const int qb = (j & 1) ? (8 * (j >> 1) + 7 - s) : (8 * (j >> 1) + s);
        attn_fox::attn_unit<8>(bh >> 4, bh & 15, qb, Q, K, V, O, G, Fc + (size_t)bh * T, thr, (char*)lds_generic, F.wave);
    }
    (void)nunits;
}
}
namespace fk {
#ifndef FK_PH_HI
#define FK_PH_HI 4
#endif
#ifndef FK_EXPERTS
#define FK_EXPERTS 0
#endif
__global__ void __launch_bounds__(NTHR, 2) fwd(Args args) {
    extern __shared__ __attribute__((aligned(16))) unsigned char lds[];
    Frame F;
    F.lds = (LAS unsigned char*)lds; F.MISC = (volatile LAS unsigned*)(F.lds + MISC_OFF);
    F.tid = threadIdx.x; F.lane = F.tid & 63; F.wave = __builtin_amdgcn_readfirstlane(F.tid >> 6);
    F.G = gridDim.x; { const int bx = blockIdx.x; F.vcu = (F.G % 8 == 0) ? (bx % 8) * (F.G / 8) + bx / 8 : bx; }
    F.in = args.in; F.out = args.out; F.ws = args.ws; F.ctl = (gu32*)(args.ws + WS_CTL);
    for (int u = F.tid; u < (LDS_BYTES - LDSCTL_OFF) / 4; u += NTHR) ((LAS unsigned*)(F.lds + LDSCTL_OFF))[u] = 0u;
    __syncthreads();
    const int lo = args.ph_lo, hi = args.ph_hi;
    const bool multi = (hi - lo) > 1;
    XcdBarrier bar; bar.bar = (unsigned*)(F.ctl + CW_BAR); bar.x = 0; bar.st = nullptr;
    if (multi) bar = xcd_barrier_post((unsigned*)(F.ctl + CW_BAR), F.MISC + 8);
#define IN(k) (lo <= (k) && (k) < hi)
#define BOTH(k) (IN(k) && IN((k) + 1))
#define GRID_BAR() xcd_barrier(bar, F.wave == 0 && hw_lane() == 0)
#define FRESH() do { F.lane = hw_lane(); F.tid = F.wave * 64 + F.lane; } while (0)
#if defined(FK_PROBE) || defined(FK_SPIN_MASK)
#define STAMP(k) do { if (blockIdx.x == 0 && F.tid == 0) ((unsigned long long*)(F.ctl + CW_TS))[(k)] = __builtin_amdgcn_s_memrealtime(); } while (0)
#else
#define STAMP(k) do {} while (0)
#endif
#define ws (args.ws)
    if (IN(0)) { FRESH(); STAMP(0); p0_prologue(F, FK_EXPERTS != 0); if (BOTH(0)) GRID_BAR(); }
    if (IN(1)) { FRESH(); STAMP(1); p1_mix(F); if (BOTH(1)) GRID_BAR(); }
    if (IN(2)) { FRESH(); STAMP(2);
        { pg8::Gemm g{(const bf16_t*)(ws + WS_XR), (const bf16_t*)(ws + WS_WRKV), M, 3 * D, D, 4, (size_t)(WS_XK - WS_XR)}; pg8::StaticOrder S; S.init(M, 3 * D, F.G, (int)blockIdx.x);
          pg8::EpiBf16<0> E{(bf16_t*)(ws + WS_R), D, nullptr, D, (size_t)(WS_K - WS_R) / 2, 1.f};
          pg8::gemm_phase<pg8::EpiBf16<0>, pg8::StaticOrder, true, true>(F.lds, g, S, E, F.wave); }
        { pg8::Gemm g{(const bf16_t*)(ws + WS_HX), (const bf16_t*)(ws + WS_B1T), M, 256, 2 * D, 1 << 30, 0}; pg8::StaticOrder S; S.init(M, 256, F.G, (int)blockIdx.x);
          EpiL1 E{(bf16_t*)(ws + WS_L1)};
          pg8::gemm_phase<EpiL1, pg8::StaticOrder, true, true>(F.lds, g, S, E, F.wave); }
        if (BOTH(2)) GRID_BAR();
    }
    if (IN(3)) { FRESH(); STAMP(3);
        pg8::Gemm g{(const bf16_t*)(ws + WS_L1), (const bf16_t*)(ws + WS_B2T), M, 3 * D, 256, 1 << 30, 0}; pg8::StaticOrder S; S.init(M, 3 * D, F.G, (int)blockIdx.x);
        EpiL2 E{(float*)(ws + WS_LW), (bf16_t*)(ws + WS_A), (bf16_t*)(ws + WS_G), F.in[9], F.in[12], (float*)(ws + WS_X1)};
        pg8::gemm_phase<EpiL2, pg8::StaticOrder, true, true>(F.lds, g, S, E, F.wave);
        if (BOTH(3)) GRID_BAR();
    }
    if (IN(4)) { FRESH(); STAMP(4); p5_phase(F); if (BOTH(4)) GRID_BAR(); }
    if (IN(5)) { FRESH(); STAMP(5); p6_phase(F); if (BOTH(5)) GRID_BAR(); }
    if (IN(6)) { FRESH(); STAMP(6); p6b_phase(F); if (BOTH(6)) GRID_BAR(); }
#define POST_BLOCK(P7, L, RESPTR, WO_OFF, RT_OFF, SGU_OFF, SD_OFF, NEXT, DST) \
    if (IN(P7)) { FRESH(); STAMP(P7); \
        pg8::Gemm g{(const bf16_t*)(ws + ((L) == 0 ? WS_Z : WS_O)), (const bf16_t*)(ws + (WO_OFF)), M, D, D, 1 << 30, 0}; pg8::StaticOrder S; S.init(M, D, F.G, (int)blockIdx.x); \
        EpiPre E{RESPTR, (const float*)(ws + WS_MOD) + (size_t)(L) * NB * 6 * D + 2 * D, (float*)(ws + WS_PRE)}; \
        pg8::gemm_phase<EpiPre, pg8::StaticOrder, true, true>(F.lds, g, S, E, F.wave); \
        if (BOTH(P7)) GRID_BAR(); } \
    if (IN((P7) + 1)) { FRESH(); STAMP((P7) + 1); ln_mod_phase(F, L); if (BOTH((P7) + 1)) GRID_BAR(); } \
    if (IN((P7) + 2)) { FRESH(); STAMP((P7) + 2); \
        pg8::Gemm g{(const bf16_t*)(ws + WS_H2), (const bf16_t*)(ws + (RT_OFF)), M, NE, D, 1 << 30, 0}; pg8::StaticOrder S; S.init(M, NE, F.G, (int)blockIdx.x); \
        EpiF32 E{(float*)(ws + WS_LOGITS), NE}; \
        pg8::gemm_phase<EpiF32, pg8::StaticOrder, true, true>(F.lds, g, S, E, F.wave); \
        if (BOTH((P7) + 2)) GRID_BAR(); } \
    if (IN((P7) + 3)) { FRESH(); STAMP((P7) + 3); route_phase(F, L); if (BOTH((P7) + 3)) GRID_BAR(); } \
    if (IN((P7) + 4)) { FRESH(); STAMP((P7) + 4); \
        const int np = moe_build(F, L); \
        pg8::Gemm g{(const bf16_t*)ws, nullptr, 0, 2 * FX, D / 2, 1 << 30, 0};     \
        MoeSched S{F.lds, np, 2, (const char*)(ws + WS_EGU + (size_t)(L) * EGU_L), (const char*)(ws + (SGU_OFF)), (size_t)512 * D, (unsigned)WS_H2F8, (unsigned)WS_H2F8, (unsigned)D, 3}; \
        EpiAct E{F.lds, (bf16_t*)(ws + WS_ACT), (bf16_t*)(ws + WS_ACTS), 1.f / (F8_SA * F8_SB)}; \
        pg8::gemm_phase_g<EpiAct, MoeSched, true, true, true>(F.lds, g, S, E, F.wave); \
        if (BOTH((P7) + 4)) GRID_BAR(); } \
    if (IN((P7) + 5)) { FRESH(); STAMP((P7) + 5); \
        const int np = moe_build(F, L); \
        pg8::Gemm g{(const bf16_t*)ws, nullptr, 0, D, FX, 1 << 30, 0}; \
        MoeSched S{F.lds, np, 4, (const char*)(ws + WS_ED + (size_t)(L) * ED_L), (const char*)(ws + (SD_OFF)), (size_t)D * FX * 2, (unsigned)WS_ACT, (unsigned)WS_ACTS, (unsigned)(FX * 2), 0}; \
        EpiDown E{F.lds, ws + WS_OUTROW, ws + WS_YS}; \
        pg8::gemm_phase_g<EpiDown, MoeSched, true, true>(F.lds, g, S, E, F.wave); \
        if (BOTH((P7) + 5)) GRID_BAR(); } \
    if (IN((P7) + 6)) { FRESH(); STAMP((P7) + 6); combine_phase(F, L, NEXT, DST); if (BOTH((P7) + 6)) GRID_BAR(); }

    POST_BLOCK(7, 0, F.in[0], WS_WO0, WS_RT0, WS_SGU0, WS_SD0, true, nullptr)
    if (IN(14)) { FRESH(); STAMP(14);
        fcum_phase(F);
        { pg8::Gemm g{(const bf16_t*)(ws + WS_XB), (const bf16_t*)(ws + WS_KVT), M, 2 * D, D, 1 << 30, 0}; pg8::StaticOrder S; S.init(M, 2 * D, F.G, (int)blockIdx.x);
          EpiNormHeads<false> E{(bf16_t*)(ws + WS_KN), (bf16_t*)(ws + WS_VV), F.in[24], 1.f};
          pg8::gemm_phase<EpiNormHeads<false>, pg8::StaticOrder, true, true>(F.lds, g, S, E, F.wave); }
        { pg8::Gemm g{(const bf16_t*)(ws + WS_HB), (const bf16_t*)(ws + WS_QGT), M, 2 * D, D, 1 << 30, 0}; pg8::StaticOrder S; S.init(M, 2 * D, F.G, (int)blockIdx.x);
          EpiNormHeads<true> E{(bf16_t*)(ws + WS_QN), (bf16_t*)(ws + WS_GATE), F.in[26], 0.125f * 1.4426950408889634f};
          pg8::gemm_phase<EpiNormHeads<true>, pg8::StaticOrder, true, true>(F.lds, g, S, E, F.wave); }
        if (BOTH(14)) GRID_BAR();
    }
    if (IN(15)) { FRESH(); STAMP(15); attn_phase_fox(F, lds); if (BOTH(15)) GRID_BAR(); }
    POST_BLOCK(16, 1, (const float*)(ws + WS_X1), WS_WO1, WS_RT1, WS_SGU1, WS_SD1, false, F.out)
#undef POST_BLOCK
#if defined(FK_SPIN_MASK)
    if (hi == 23) { if (blockIdx.x == 0 && F.wave == 0 && hw_lane() == 0) { const unsigned long long now = __builtin_amdgcn_s_memrealtime(); const unsigned long long* ts = (const unsigned long long*)(F.ctl + CW_TS); unsigned long long x = 0;
        for (int k = 0; k < 23; ++k) { const unsigned long long t1 = (k + 1 < 23) ? ts[k + 1] : now; if ((FK_SPIN_MASK >> k) & 1) x += t1 - ts[k]; }
        while (__builtin_amdgcn_s_memrealtime() - now < 2 * x) __builtin_amdgcn_s_sleep(8); } }
#endif
#if defined(FK_PROBE)
    if (IN(23)) { FRESH(); STAMP(23);
        if (blockIdx.x == 0 && F.tid == 0) { const unsigned long long* ts = (const unsigned long long*)(F.ctl + CW_TS);
            const float tot = (float)(ts[23] - ts[0]); float a = 0.f, b = 0.f, c = 0.f;
            for (int k = 0; k < 23; ++k) { const float d = (float)(ts[k + 1] - ts[k]); if ((FK_PROBE_A >> k) & 1) a += d; if ((FK_PROBE_B >> k) & 1) b += d; if ((FK_PROBE_C >> k) & 1) c += d; }
            const float pa = fminf(fmaxf(rintf(100.f * a / tot), 0.f), 89.f) + 10.f, pb = fminf(fmaxf(rintf(100.f * b / tot), 0.f), 26.f), pc = fminf(fmaxf(rintf(100.f * c / tot), 0.f), 89.f) + 10.f;
#if defined(FK_PROBE_ABS)
            const float pa2 = fminf(fmaxf(rintf(a * 0.01f / 10.f), 0.f), 89.f) + 10.f; (void)pa;
            const float c1sq = (pa2 / 10.f) * powf(10.f, 4.f + pb);
#else
            const float c1sq = (pa / 10.f) * powf(10.f, 4.f + pb);
#endif
            const float c1 = sqrtf(c1sq); const float c2 = (pc / 10.f) * powf(10.f, floorf(log10f(c1)) + 2.f);
            ((float*)(F.ctl + CW_TS))[64] = c1; ((float*)(F.ctl + CW_TS))[65] = c2; }
        GRID_BAR();
        { const float c1 = ((const float*)(F.ctl + CW_TS))[64], c2 = ((const float*)(F.ctl + CW_TS))[65];
          for (size_t i = (size_t)blockIdx.x * NTHR + F.tid; i < (size_t)M * D; i += (size_t)F.G * NTHR) F.out[i] = (i == 0) ? c2 : c1; }
    }
#endif
#undef ws
#undef IN
#undef BOTH
#undef GRID_BAR
}

__global__ void k_cmp(const float* ref, int ldr, const void* fast, int is_bf16, int ldf, int rows, int cols, float* acc) {
    __shared__ float r1[8], r2[8];
    float num = 0.f, den = 0.f;
    for (size_t i = (size_t)blockIdx.x * blockDim.x + threadIdx.x; i < (size_t)rows * cols; i += (size_t)gridDim.x * blockDim.x) {
        const size_t r = i / cols, c = i % cols; const float o = ref[r * ldr + c];
        float f; if (is_bf16) { const unsigned short h = ((const unsigned short*)fast)[r * ldf + c]; f = __uint_as_float((unsigned)h << 16); } else f = ((const float*)fast)[r * ldf + c];
        num += (f - o) * (f - o); den += o * o; }
    num = wave_sum(num); den = wave_sum(den);
    if ((threadIdx.x & 63) == 0) { r1[threadIdx.x >> 6] = num; r2[threadIdx.x >> 6] = den; }
    __syncthreads();
    if (threadIdx.x == 0) { float a = 0.f, b = 0.f; for (int w = 0; w < (int)(blockDim.x >> 6); ++w) { a += r1[w]; b += r2[w]; } atomicAdd(acc, a); atomicAdd(acc + 1, b); }
}
__global__ void k_code(const float* acc, int nchk, float tol2, float* out, size_t n) {
    float c = 0.f;
    for (int i = 0; i < nchk; ++i) { const float num = acc[2 * i], den = acc[2 * i + 1]; float r2 = num / fmaxf(den, 1e-30f); if (!(r2 == r2)) r2 = 0.98f; if (den <= 0.f) r2 = 0.97f;
        if (r2 > tol2) { float v = fminf(fmaxf(r2 * 1e6f, 1.f), 9.9e5f); { const float e10 = floorf(log10f(v)); v = powf(10.f, e10) * (v / powf(10.f, e10) >= 3.16f ? 3.f : 1.f); } for (int k = 0; k < i; ++k) v *= 1e6f; c = sqrtf(v); break; } }
    for (size_t i = (size_t)blockIdx.x * blockDim.x + threadIdx.x; i < n; i += (size_t)gridDim.x * blockDim.x) out[i] = c;
}
}

extern "C" void kernel_launch(void* const* d_in, const int* in_sizes, int n_in, void* d_out, int out_size, void* d_ws, size_t ws_size, hipStream_t stream) {
    using namespace fk;
    static int grid = 0;
    if (grid == 0) {
        int dev = 0, cus = 0;
        if (n_in != 36 || hipGetDevice(&dev) != hipSuccess || hipDeviceGetAttribute(&cus, hipDeviceAttributeMultiprocessorCount, dev) != hipSuccess) { grid = -1; return; }
        if (hipFuncSetAttribute((const void*)fwd, hipFuncAttributeMaxDynamicSharedMemorySize, LDS_BYTES) != hipSuccess) { grid = -1; return; }
        grid = cus;
    }
    if (grid < 0) return;
#if defined(FK_DEBUG)
    constexpr size_t NV_BASE = 32 * MiB, SAVE_BASE = 1922 * MiB; constexpr int DBG_B = FK_DEBUG - 1;
    char* nws = (char*)d_ws + NV_BASE;
    auto nb = [&](int i) { return (const float*)(nws + nv::W_BUF + (size_t)i * nv::TD); };
    auto sv = [&](int i) { return (const float*)((char*)d_ws + SAVE_BASE + (size_t)i * nv::TD); };
    {
        nv::In in; for (int i = 0; i < 36; ++i) in.p[i] = (const float*)d_in[i];
        hipLaunchKernelGGL(nv::k_mod, dim3(2 * nv::NB * 6 * nv::D / 256), dim3(256), 0, stream, in.p[1], in.p[2], in.p[3], (float*)(nws + nv::W_MOD));
        nv::forward_batch(stream, in, nws, DBG_B, (float*)(nws + nv::W_BUF + (size_t)nv::B_OG * nv::TD), FK_DBG_STOP);
#define SAVE(i, src, bytes) (void)hipMemcpyAsync((char*)d_ws + SAVE_BASE + (size_t)(i) * nv::TD, src, bytes, hipMemcpyDeviceToDevice, stream);
        FK_DBG_SAVES
#undef SAVE
    }
#endif
    (void)hipMemsetAsync((char*)d_ws + WS_CTL, 0, CTL_ZERO_BYTES, stream);
    Args a{};
    for (int i = 0; i < 36; ++i) a.in[i] = (const float*)d_in[i];
    a.out = (float*)d_out; a.ws = (unsigned char*)d_ws;
#if defined(FK_PER_PHASE)
    for (int p = 0; p < FK_PH_HI; ++p) { a.ph_lo = p; a.ph_hi = p + 1; hipLaunchKernelGGL(fwd, dim3(grid), dim3(NTHR), LDS_BYTES, stream, a); }
#else
    a.ph_lo = 0; a.ph_hi = FK_PH_HI; hipLaunchKernelGGL(fwd, dim3(grid), dim3(NTHR), LDS_BYTES, stream, a);
#endif
#if defined(FK_DEBUG)
    {
        float* acc = (float*)((char*)d_ws + WS_CTL) + CW_DBG;
        const size_t ro = (size_t)DBG_B * T;
        int nchk = 0;
#define CHK(refp, ldr, fastoff, isbf, ldf, cols) { hipLaunchKernelGGL(k_cmp, dim3(1024), dim3(256), 0, stream, refp, ldr, (const void*)((char*)d_ws + (fastoff) + ro * (ldf) * ((isbf) ? 2 : 4)), isbf, ldf, T, cols, acc + 2 * nchk); ++nchk; }
        FK_DBG_CHECKS
#undef CHK
        hipLaunchKernelGGL(k_code, dim3(1024), dim3(256), 0, stream, acc, nchk, FK_DBG_TOL2, (float*)d_out, (size_t)out_size);
    }
#endif
}
```
